# Optimizing an MI355X kernel written in HIP

```python
import jax, jax.numpy as jnp
from jax import lax
import numpy as np

D_MODEL = 1024
BATCH = 1
SEQ = 16384
DEPTH = 1

GRID_W = 64
CTX_LEN = 256
N_MLA_HEADS = 8
MLA_Q_RANK = 256
MLA_KV_RANK = 128
MLA_NOPE_DIM = 64
MLA_ROPE_DIM = 32
MLA_QK_DIM = MLA_NOPE_DIM + MLA_ROPE_DIM
MLA_V_DIM = 64
N_GLA_HEADS = 4
GLA_DK = 64
GLA_DV = 128
GLA_GATE_RANK = 16
GLA_GATE_NORM = 16.0
GLA_CHUNK = 64
D_FF = 2816
MACARON_WEIGHT = 0.5
Q_BLOCK = 128
ROPE_BASE = 10000.0
EPS = 1e-6
N_MOD = 9

D_MLA_OUT = N_MLA_HEADS * MLA_V_DIM
D_GLA_OUT = N_GLA_HEADS * GLA_DV
D_MIX = D_MLA_OUT + D_GLA_OUT
IN_SPLITS = (MLA_Q_RANK, MLA_KV_RANK + MLA_ROPE_DIM, N_GLA_HEADS * GLA_DK, N_GLA_HEADS * GLA_DK,
             D_GLA_OUT, D_GLA_OUT, 2 * GLA_GATE_RANK)
D_IN = 256 + 160 + 256 + 256 + 512 + 512 + 32

kernel_name = "hybrid_mla_gla_macaron_dit_block"


def split_cols(t, sizes):
    out, start = [], 0
    for s in sizes:
        out.append(t[..., start:start + s])
        start += s
    return out


def rmsnorm(x, g):
    xf = x.astype(jnp.float32)
    y = xf * lax.rsqrt(jnp.mean(xf * xf, axis=-1, keepdims=True) + EPS)
    return (y * g.astype(jnp.float32)).astype(x.dtype)


def modulate(h, shift, scale):
    return h * (1 + scale[:, None, :]) + shift[:, None, :]


def ffn_sublayer(x, g_pre, g_post, shift, scale, gate, w_in, w_out):
    h = modulate(rmsnorm(x, g_pre), shift, scale)
    a, b = jnp.split(h @ w_in, 2, axis=-1)
    y = (jax.nn.silu(a) * b) @ w_out
    return x + MACARON_WEIGHT * gate[:, None, :] * rmsnorm(y, g_post)


def axial_rope_angles(n):
    rows = n // GRID_W
    row = jnp.repeat(jnp.arange(rows, dtype=jnp.float32), GRID_W)
    col = jnp.tile(jnp.arange(GRID_W, dtype=jnp.float32), rows)
    axis_dim = MLA_ROPE_DIM // 2
    inv_freq = ROPE_BASE ** (-jnp.arange(0, axis_dim, 2, dtype=jnp.float32) / axis_dim)
    return row[:, None] * inv_freq, col[:, None] * inv_freq


def rotate_axis(x, ang):
    x1, x2 = jnp.split(x, 2, axis=-1)
    cos, sin = jnp.cos(ang), jnp.sin(ang)
    return jnp.concatenate([x1 * cos - x2 * sin, x2 * cos + x1 * sin], axis=-1)


def apply_rope_2d(x, ang_row, ang_col):
    xr, xc = jnp.split(x.astype(jnp.float32), 2, axis=-1)
    return jnp.concatenate([rotate_axis(xr, ang_row), rotate_axis(xc, ang_col)], axis=-1).astype(x.dtype)


def gla_log_decay(a_low, w_b, b_b):
    b, t, _ = a_low.shape
    la = jax.nn.log_sigmoid((a_low @ w_b + b_b).astype(jnp.float32)) / GLA_GATE_NORM
    return la.reshape(b, t, N_GLA_HEADS, GLA_DK)


def mixer_inputs(h, p, angles=None):
    b, t, _ = h.shape
    q_a, kv_a, gq, gk, gv, gg, ga = split_cols(h @ p["w_in"], IN_SPLITS)
    q = (rmsnorm(q_a, p["mla_q_norm"]) @ p["mla_w_qb"]).reshape(b, t, N_MLA_HEADS, MLA_QK_DIM)
    q_nope, q_rope = q[..., :MLA_NOPE_DIM], q[..., MLA_NOPE_DIM:]
    kv = (rmsnorm(kv_a[..., :MLA_KV_RANK], p["mla_kv_norm"]) @ p["mla_w_kvb"]).reshape(
        b, t, N_MLA_HEADS, MLA_NOPE_DIM + MLA_V_DIM)
    k_nope, v = kv[..., :MLA_NOPE_DIM], kv[..., MLA_NOPE_DIM:]
    k_rope = kv_a[..., MLA_KV_RANK:]
    if angles is not None:
        ang_row, ang_col = angles
        q_rope = apply_rope_2d(q_rope, ang_row[:, None, :], ang_col[:, None, :])
        k_rope = apply_rope_2d(k_rope, ang_row, ang_col)
    q = jnp.concatenate([q_nope, q_rope], axis=-1)
    k = jnp.concatenate(
        [k_nope, jnp.broadcast_to(k_rope[:, :, None, :], (b, t, N_MLA_HEADS, MLA_ROPE_DIM))], axis=-1)
    gla = (gq.reshape(b, t, N_GLA_HEADS, GLA_DK) * (GLA_DK ** -0.5),
           gk.reshape(b, t, N_GLA_HEADS, GLA_DK),
           gv.reshape(b, t, N_GLA_HEADS, GLA_DV),
           gg,
           gla_log_decay(ga[..., :GLA_GATE_RANK], p["gla_w_a_fwd"], p["gla_b_a_fwd"]),
           gla_log_decay(ga[..., GLA_GATE_RANK:], p["gla_w_a_bwd"], p["gla_b_a_bwd"]))
    return q, k, v, gla


def softmax_attend(q, k, v):
    s = jnp.einsum('bqhd,bkhd->bhqk', q, k).astype(jnp.float32) * (MLA_QK_DIM ** -0.5)
    probs = jax.nn.softmax(s, axis=-1).astype(v.dtype)
    return jnp.einsum('bhqk,bkhd->bqhd', probs, v)


def blocked_attend(q, k, v):
    b, n, h, d = q.shape
    nb = n // Q_BLOCK
    qb = jnp.moveaxis(q.reshape(b, nb, Q_BLOCK, h, d), 1, 0)
    out = lax.map(lambda blk: softmax_attend(blk, k, v), qb)
    return jnp.moveaxis(out, 0, 1).reshape(b, n, h, v.shape[-1])


def gla_chunked(q, k, v, log_a, s0):
    b, t, h, dk = q.shape
    dv = v.shape[-1]
    nc = t // GLA_CHUNK

    def to_chunks(a):
        return a.reshape(b, nc, GLA_CHUNK, h, a.shape[-1]).transpose(1, 0, 3, 2, 4)

    lower = jnp.tril(jnp.ones((GLA_CHUNK, GLA_CHUNK), dtype=bool))

    def step(state, inp):
        qc, kc, vc, gc = inp
        qc, kc, vc = qc.astype(jnp.float32), kc.astype(jnp.float32), vc.astype(jnp.float32)
        cum = jnp.cumsum(gc, axis=-2)
        o_inter = jnp.einsum('bhcd,bhde->bhce', qc * jnp.exp(cum), state)
        diff = cum[..., :, None, :] - cum[..., None, :, :]
        decay = jnp.exp(jnp.where(lower[:, :, None], diff, -jnp.inf))
        attn = jnp.einsum('bhid,bhjd,bhijd->bhij', qc, kc, decay)
        o_intra = jnp.einsum('bhij,bhje->bhie', attn, vc)
        last = cum[..., -1:, :]
        new_state = jnp.exp(last)[..., 0, :, None] * state + jnp.einsum(
            'bhjd,bhje->bhde', kc * jnp.exp(last - cum), vc)
        return new_state, o_inter + o_intra

    s_final, o = lax.scan(step, s0, (to_chunks(q), to_chunks(k), to_chunks(v), to_chunks(log_a)))
    o = o.transpose(1, 0, 3, 2, 4).reshape(b, t, h, dv)
    return o.astype(v.dtype), s_final


def gla_bidirectional(gq, gk, gv, la_f, la_b, s_f, s_b):
    flip = lambda a: jnp.flip(a, axis=1)
    o_f, s_f_new = gla_chunked(gq, gk, gv, la_f, s_f)
    o_b, s_b_new = gla_chunked(flip(gq), flip(gk), flip(gv), flip(la_b), s_b)
    return o_f + flip(o_b), s_f_new, s_b_new


def gla_output(o, gg, gain):
    b, t = o.shape[:2]
    gate = jax.nn.silu(gg.reshape(b, t, N_GLA_HEADS, GLA_DV))
    return (rmsnorm(o, gain) * gate).reshape(b, t, D_GLA_OUT)


def token_mixing(a_lat, a_ctx, angles, p, need_ctx_out):
    b, n, _ = a_lat.shape
    q_c, k_c, v_c, gla_c = mixer_inputs(a_ctx, p)
    q_l, k_l, v_l, gla_l = mixer_inputs(a_lat, p, angles)
    k_all = jnp.concatenate([k_c, k_l], axis=1)
    v_all = jnp.concatenate([v_c, v_l], axis=1)
    mla_lat = blocked_attend(q_l, k_all, v_all).reshape(b, n, D_MLA_OUT)
    s0 = jnp.zeros((a_ctx.shape[0], N_GLA_HEADS, GLA_DK, GLA_DV), jnp.float32)
    cq, ck, cv, cg, cla_f, cla_b = gla_c
    o_c, s_cf, s_cb = gla_bidirectional(cq, ck, cv, cla_f, cla_b, s0, s0)
    lq, lk, lv, lg, lla_f, lla_b = gla_l
    o_l, _, _ = gla_bidirectional(lq, lk, lv, lla_f, lla_b, s_cf, s_cb)
    gla_lat = gla_output(o_l, lg, p["gla_norm"])
    y_lat = jnp.concatenate([mla_lat, gla_lat], axis=-1) @ p["w_out"]
    if need_ctx_out:
        m = a_ctx.shape[1]
        mla_ctx = softmax_attend(q_c, k_c, v_c).reshape(a_ctx.shape[0], m, D_MLA_OUT)
        gla_ctx = gla_output(o_c, cg, p["gla_norm"])
        y_ctx = jnp.concatenate([mla_ctx, gla_ctx], axis=-1) @ p["w_out"]
    else:
        y_ctx = None
    return y_lat, y_ctx


def setup_inputs(seed: int = 0) -> dict:
    key = jax.random.key(seed)
    ks = jax.random.split(key, 24)
    f32 = jnp.float32
    nrm = lambda k, shape, s: jax.random.normal(k, shape, f32) * s
    L, D = DEPTH, D_MODEL
    return {
        "x": nrm(ks[0], (BATCH, SEQ, D), 1.0),
        "c": nrm(ks[1], (BATCH, D), 1.0),
        "ctx": nrm(ks[2], (BATCH, CTX_LEN, D), 1.0),
        "c_ctx": nrm(ks[3], (D,), 1.0),
        "w_ada": nrm(ks[4], (L, D, N_MOD * D), 0.5 * D ** -0.5),
        "b_ada": nrm(ks[5], (L, N_MOD * D), 0.02),
        "norm_pre": 1.0 + nrm(ks[6], (L, 3, D), 0.05),
        "norm_post": 1.0 + nrm(ks[7], (L, 3, D), 0.05),
        "ffn1_w_in": nrm(ks[8], (L, D, 2 * D_FF), D ** -0.5),
        "ffn1_w_out": nrm(ks[9], (L, D_FF, D), D_FF ** -0.5),
        "ffn2_w_in": nrm(ks[10], (L, D, 2 * D_FF), D ** -0.5),
        "ffn2_w_out": nrm(ks[11], (L, D_FF, D), D_FF ** -0.5),
        "w_in": nrm(ks[12], (L, D, D_IN), D ** -0.5),
        "mla_q_norm": 1.0 + nrm(ks[13], (L, MLA_Q_RANK), 0.05),
        "mla_w_qb": nrm(ks[14], (L, MLA_Q_RANK, N_MLA_HEADS * MLA_QK_DIM), MLA_Q_RANK ** -0.5),
        "mla_kv_norm": 1.0 + nrm(ks[15], (L, MLA_KV_RANK), 0.05),
        "mla_w_kvb": nrm(ks[16], (L, MLA_KV_RANK, N_MLA_HEADS * (MLA_NOPE_DIM + MLA_V_DIM)), MLA_KV_RANK ** -0.5),
        "gla_w_a_fwd": nrm(ks[17], (L, GLA_GATE_RANK, N_GLA_HEADS * GLA_DK), GLA_GATE_RANK ** -0.5),
        "gla_b_a_fwd": nrm(ks[18], (L, N_GLA_HEADS * GLA_DK), 0.1),
        "gla_w_a_bwd": nrm(ks[19], (L, GLA_GATE_RANK, N_GLA_HEADS * GLA_DK), GLA_GATE_RANK ** -0.5),
        "gla_b_a_bwd": nrm(ks[20], (L, N_GLA_HEADS * GLA_DK), 0.1),
        "gla_norm": 1.0 + nrm(ks[21], (L, GLA_DV), 0.05),
        "w_out": nrm(ks[22], (L, D_MIX, D), D_MIX ** -0.5),
    }


def reference(x, c, ctx, c_ctx, w_ada, b_ada, norm_pre, norm_post, ffn1_w_in, ffn1_w_out,
              ffn2_w_in, ffn2_w_out, w_in, mla_q_norm, mla_w_qb, mla_kv_norm, mla_w_kvb,
              gla_w_a_fwd, gla_b_a_fwd, gla_w_a_bwd, gla_b_a_bwd, gla_norm, w_out):
    n = x.shape[1]
    angles = axial_rope_angles(n)
    h_lat, h_ctx = x, ctx
    for l in range(DEPTH):
        last = l == DEPTH - 1
        m_lat = jnp.split(jax.nn.silu(c) @ w_ada[l] + b_ada[l], N_MOD, axis=-1)
        m_ctx = jnp.split((jax.nn.silu(c_ctx) @ w_ada[l] + b_ada[l])[None], N_MOD, axis=-1)
        h_lat = ffn_sublayer(h_lat, norm_pre[l, 0], norm_post[l, 0], m_lat[0], m_lat[1], m_lat[2],
                             ffn1_w_in[l], ffn1_w_out[l])
        h_ctx = ffn_sublayer(h_ctx, norm_pre[l, 0], norm_post[l, 0], m_ctx[0], m_ctx[1], m_ctx[2],
                             ffn1_w_in[l], ffn1_w_out[l])
        p = {"w_in": w_in[l], "mla_q_norm": mla_q_norm[l], "mla_w_qb": mla_w_qb[l],
             "mla_kv_norm": mla_kv_norm[l], "mla_w_kvb": mla_w_kvb[l],
             "gla_w_a_fwd": gla_w_a_fwd[l], "gla_b_a_fwd": gla_b_a_fwd[l],
             "gla_w_a_bwd": gla_w_a_bwd[l], "gla_b_a_bwd": gla_b_a_bwd[l],
             "gla_norm": gla_norm[l], "w_out": w_out[l]}
        a_lat = modulate(rmsnorm(h_lat, norm_pre[l, 1]), m_lat[3], m_lat[4])
        a_ctx = modulate(rmsnorm(h_ctx, norm_pre[l, 1]), m_ctx[3], m_ctx[4])
        y_lat, y_ctx = token_mixing(a_lat, a_ctx, angles, p, not last)
        h_lat = h_lat + m_lat[5][:, None, :] * rmsnorm(y_lat, norm_post[l, 1])
        h_lat = ffn_sublayer(h_lat, norm_pre[l, 2], norm_post[l, 2], m_lat[6], m_lat[7], m_lat[8],
                             ffn2_w_in[l], ffn2_w_out[l])
        if not last:
            h_ctx = h_ctx + m_ctx[5][:, None, :] * rmsnorm(y_ctx, norm_post[l, 1])
            h_ctx = ffn_sublayer(h_ctx, norm_pre[l, 2], norm_post[l, 2], m_ctx[6], m_ctx[7], m_ctx[8],
                                 ffn2_w_in[l], ffn2_w_out[l])
    return h_lat
```

```cpp
#include <hip/hip_runtime.h>
#include <cstdio>
#include <cstdint>

#define GAS __attribute__((address_space(1)))
#define LAS __attribute__((address_space(3)))
typedef unsigned short bf16;
typedef short bf16x8 __attribute__((ext_vector_type(8)));
typedef short s16x4 __attribute__((ext_vector_type(4)));
typedef float f32x4 __attribute__((ext_vector_type(4)));
typedef float f32x2 __attribute__((ext_vector_type(2)));
typedef float f32x16 __attribute__((ext_vector_type(16)));
typedef unsigned u32x4 __attribute__((ext_vector_type(4)));
typedef unsigned u32x2 __attribute__((ext_vector_type(2)));

constexpr int DM = 1024, SEQ = 16384, CTX = 256, ROWS = SEQ + CTX, DFF = 2816, NMODV = 9 * DM;
constexpr int NCH = ROWS / 64;
constexpr float EPS = 1e-6f;
constexpr int KVP = 1280, KVH = 160;
constexpr int QP = 768, QH = 96;

constexpr size_t MiB = 1u << 20;
constexpr size_t WS_CTL = 0, CTL_ZERO_BYTES = 64 * 1024;
constexpr size_t WS_MOD = 1 * MiB;
constexpr size_t WS_ROPE = 1 * MiB + 128 * 1024;
constexpr size_t WS_W1IN = 2 * MiB;
constexpr size_t WS_W1OUT = WS_W1IN + 11 * MiB;
constexpr size_t WS_W2IN = WS_W1OUT + 5 * MiB + 512 * 1024;
constexpr size_t WS_W2OUT = WS_W2IN + 11 * MiB;
constexpr size_t WS_WIN = WS_W2OUT + 5 * MiB + 512 * 1024;
constexpr size_t WS_WQB = WS_WIN + 4 * MiB;
constexpr size_t WS_WKVB = WS_WQB + 384 * 1024;
constexpr size_t WS_WOUT = WS_WKVB + 512 * 1024;
constexpr size_t WS_A = 42 * MiB;
constexpr size_t WS_QN = WS_A;
constexpr size_t WS_KVN = WS_A + 8 * MiB;
constexpr size_t WS_MIX = WS_A;
constexpr size_t WS_B = WS_A + (size_t)ROWS * DM * 2;
constexpr size_t WS_ZQ = WS_B;
constexpr size_t WS_Z1F = WS_ZQ + (size_t)ROWS * 256 * 2;
constexpr size_t WS_Q = WS_B;
constexpr size_t WS_C = WS_Z1F + (size_t)ROWS * 256 * 4;
constexpr size_t WS_ZGQK = WS_C;
constexpr size_t WS_ZGV = WS_ZGQK + (size_t)ROWS * 512 * 2;
constexpr size_t WS_LS = WS_C;
constexpr size_t WS_ZGG = WS_ZGV + (size_t)ROWS * 512 * 2;
constexpr size_t WS_KV = WS_ZGG + (size_t)ROWS * 512 * 2;
constexpr size_t WS_QT = WS_KV + (size_t)ROWS * KVP * 2;
constexpr size_t WS_KT = WS_QT + (size_t)2 * ROWS * 256 * 2;
constexpr size_t WS_KTT = WS_KT + (size_t)2 * ROWS * 256 * 2;
constexpr size_t WS_VT = WS_KTT + (size_t)2 * ROWS * 256 * 2;
constexpr size_t WS_AUX = WS_VT + (size_t)ROWS * 512 * 2;
constexpr size_t AUX_N = (size_t)2 * NCH * 256;
constexpr size_t WS_AUX_END = WS_AUX + 3 * AUX_N * 4;
constexpr size_t WS_ACT = WS_B;
constexpr size_t WS_Y = 164 * MiB;
constexpr size_t WS_END = 256 * MiB;
static_assert(WS_WOUT + 2 * MiB <= WS_A, "weights");
static_assert(WS_KVN + (size_t)ROWS * 256 * 2 <= WS_B, "qn/kvn in A");
static_assert(WS_Q + (size_t)SEQ * QP * 2 <= WS_C, "Q in B");
static_assert(WS_LS + (size_t)8 * NCH * 8192 * 2 <= WS_ZGG, "LS in C");
static_assert(WS_AUX_END <= WS_END, "aux");
static_assert(WS_ACT + (size_t)ROWS * DFF * 2 <= WS_Y && WS_Y + (size_t)ROWS * DM * 4 <= WS_END, "ffn map");
static_assert(WS_MIX + (size_t)SEQ * DM * 2 <= WS_Y, "mix below y");

typedef __bf16 bf16x2_t __attribute__((ext_vector_type(2)));
__device__ __forceinline__ unsigned cvt_pk_bf16(float lo, float hi) { f32x2 v = {lo, hi}; bf16x2_t b = __builtin_convertvector(v, bf16x2_t); return __builtin_bit_cast(unsigned, b); }
__device__ __forceinline__ unsigned f2bf(float f) { unsigned u = __builtin_bit_cast(unsigned, f); return (u + 0x7fffu + ((u >> 16) & 1u)) >> 16; }
__device__ __forceinline__ float bf2f(unsigned short b) { return __builtin_bit_cast(float, (unsigned)b << 16); }
__device__ __forceinline__ float bflo(unsigned w) { return __builtin_bit_cast(float, w << 16); }
__device__ __forceinline__ float bfhi(unsigned w) { return __builtin_bit_cast(float, w & 0xffff0000u); }
__device__ __forceinline__ float fast_silu(float a) { return a * __builtin_amdgcn_rcpf(1.0f + __builtin_amdgcn_exp2f(-a * 1.4426950408889634f)); }
template <int M> __device__ __forceinline__ float swz_xor(float v) { return __builtin_bit_cast(float, __builtin_amdgcn_ds_swizzle(__builtin_bit_cast(int, v), (M << 10) | 0x1f)); }
__device__ __forceinline__ float half_sum(float v) {
    v += swz_xor<1>(v); v += swz_xor<2>(v); v += swz_xor<4>(v); v += swz_xor<8>(v); v += swz_xor<16>(v); return v;
}
__device__ __forceinline__ float wave_sum(float v) {
    v = half_sum(v);
    auto rr = __builtin_amdgcn_permlane32_swap(__float_as_uint(v), __float_as_uint(v), false, false);
    return __uint_as_float(rr[0]) + __uint_as_float(rr[1]);
}
__device__ __forceinline__ int lane_id_opaque() { int l; asm volatile("v_mbcnt_lo_u32_b32 %0, -1, 0\n\tv_mbcnt_hi_u32_b32 %0, -1, %0" : "=v"(l)); return l; }
#define LDS_WAIT() asm volatile("s_waitcnt lgkmcnt(0)" ::: "memory")
#define VM_WAIT() asm volatile("s_waitcnt vmcnt(0)" ::: "memory")

namespace pg8 {
typedef unsigned short bf16_t;
constexpr int BM = 256, BK = 64, HALF = 128, HTB = HALF * BK * 2, STAGE_BYTES = 8 * HTB, NXCD = 8, WGM = 8;
__host__ __device__ __forceinline__ int lds_byte(int r, int c) { const int st = (r >> 4) * 2 + (c >> 5), rr = r & 15, cc = c & 31, ob = rr * 64 + cc * 2; return st * 1024 + (ob ^ (((ob >> 9) & 1) << 5)); }
__host__ __device__ __forceinline__ void stage_rc(int b, int& R, int& C) { const int st = b / 1024, sb = b % 1024, swz = sb ^ (((sb >> 9) & 1) << 5); R = (st >> 1) * 16 + swz / 64; C = (st & 1) * 32 + (swz % 64) / 2; }

struct Unit { int pm, pn; };
struct Gemm { const bf16_t* A; const bf16_t* Bt; int M, N, K, lda, ldb; };

struct StaticOrder {
    int nM, nN, nwg, G, c;
    __host__ __device__ void init(int M, int N, int G_, int c_) { nM = M / BM; nN = N / BM; nwg = nM * nN; G = G_; c = c_; }
    __host__ __device__ bool next(int i, Unit& u) const {
        const long L = (long)i * G + c; if (L >= nwg) return false;
        int wgid = (int)L; { const int q = nwg / NXCD, r = nwg % NXCD, xcd = wgid % NXCD, off = wgid / NXCD; wgid = (xcd < r ? xcd * (q + 1) : r * (q + 1) + (xcd - r) * q) + off; }
        const int nig = WGM * nN, gid = wgid / nig, fm = gid * WGM, gsz = (nM - fm) < WGM ? (nM - fm) : WGM;
        u.pm = fm + ((wgid % nig) % gsz); u.pn = (wgid % nig) / gsz; return true;
    }
};

typedef f32x4 Acc[2][2][4][2];

struct EpiF32 {
    float* C; int ldc;
    __device__ __forceinline__ void operator()(const Acc& acc, const Unit& u, int wr, int wc, int fr, int fq) const {
        const int row0 = u.pm * BM + wr * 64 + fr, col0 = u.pn * BM + wc * 32 + 4 * fq;
#pragma unroll
        for (int ai = 0; ai < 2; ++ai)
#pragma unroll
            for (int m = 0; m < 4; ++m) { float* rowp = C + (size_t)(row0 + ai * HALF + m * 16) * ldc + col0;
#pragma unroll
                for (int bj = 0; bj < 2; ++bj)
#pragma unroll
                    for (int n = 0; n < 2; ++n) *(f32x4*)(rowp + bj * HALF + n * 16) = acc[ai][bj][m][n]; }
    }
};
struct EpiSwiGLU {
    bf16_t* O; int ldo;
    __device__ __forceinline__ void operator()(const Acc& acc, const Unit& u, int wr, int wc, int fr, int fq) const {
        const int row0 = u.pm * BM + wr * 64 + fr, col0 = u.pn * HALF + wc * 32 + 4 * fq;
#pragma unroll
        for (int ai = 0; ai < 2; ++ai)
#pragma unroll
            for (int m = 0; m < 4; ++m) { bf16_t* rowp = O + (size_t)(row0 + ai * HALF + m * 16) * ldo + col0;
#pragma unroll
                for (int n = 0; n < 2; ++n) { const f32x4 a = acc[ai][0][m][n], b = acc[ai][1][m][n];
                    u32x2 w; w.x = cvt_pk_bf16(fast_silu(a[0]) * b[0], fast_silu(a[1]) * b[1]); w.y = cvt_pk_bf16(fast_silu(a[2]) * b[2], fast_silu(a[3]) * b[3]);
                    *(u32x2*)(rowp + n * 16) = w; } }
    }
};
struct EpiZ {
    bf16_t *Zq, *Zgqk, *Zgv, *Zgg; float* Z1f;
    __device__ __forceinline__ void operator()(const Acc& acc, const Unit& u, int wr, int wc, int fr, int fq) const {
        const int row0 = u.pm * BM + wr * 64 + fr, cl = wc * 32 + 4 * fq, pn = u.pn;
        if (pn == 1) {
#pragma unroll
            for (int ai = 0; ai < 2; ++ai)
#pragma unroll
                for (int m = 0; m < 4; ++m) { float* rowp = Z1f + (size_t)(row0 + ai * HALF + m * 16) * 256 + cl;
#pragma unroll
                    for (int bj = 0; bj < 2; ++bj)
#pragma unroll
                        for (int n = 0; n < 2; ++n) *(f32x4*)(rowp + bj * HALF + n * 16) = acc[ai][bj][m][n]; }
        } else {
            bf16_t* base; int ld, cb;
            if (pn == 0) { base = Zq; ld = 256; cb = 0; }
            else if (pn < 4) { base = Zgqk; ld = 512; cb = (pn - 2) * 256; }
            else if (pn < 6) { base = Zgv; ld = 512; cb = (pn - 4) * 256; }
            else { base = Zgg; ld = 512; cb = (pn - 6) * 256; }
#pragma unroll
            for (int ai = 0; ai < 2; ++ai)
#pragma unroll
                for (int m = 0; m < 4; ++m) { bf16_t* rowp = base + (size_t)(row0 + ai * HALF + m * 16) * ld + cb + cl;
#pragma unroll
                    for (int bj = 0; bj < 2; ++bj)
#pragma unroll
                        for (int n = 0; n < 2; ++n) { const f32x4 v = acc[ai][bj][m][n]; u32x2 w; w.x = cvt_pk_bf16(v[0], v[1]); w.y = cvt_pk_bf16(v[2], v[3]);
                            *(u32x2*)(rowp + bj * HALF + n * 16) = w; } }
        }
    }
};
struct EpiQ {
    bf16_t* Q;
    __device__ __forceinline__ void operator()(const Acc& acc, const Unit& u, int wr, int wc, int fr, int fq) const {
        const int row0 = u.pm * BM + wr * 64 + fr, col0 = u.pn * BM + wc * 32 + 4 * fq;
#pragma unroll
        for (int ai = 0; ai < 2; ++ai)
#pragma unroll
            for (int m = 0; m < 4; ++m) { bf16_t* rowp = Q + (size_t)(row0 + ai * HALF + m * 16) * QP + col0;
#pragma unroll
                for (int bj = 0; bj < 2; ++bj)
#pragma unroll
                    for (int n = 0; n < 2; ++n) { const f32x4 v = acc[ai][bj][m][n]; u32x2 w; w.x = cvt_pk_bf16(v[0], v[1]); w.y = cvt_pk_bf16(v[2], v[3]);
                        *(u32x2*)(rowp + bj * HALF + n * 16) = w; } }
    }
};
struct EpiKV {
    bf16_t* KV;
    __device__ __forceinline__ void operator()(const Acc& acc, const Unit& u, int wr, int wc, int fr, int fq) const {
        const int row0 = u.pm * BM + wr * 64 + fr, col0 = u.pn * BM + wc * 32 + 4 * fq;
#pragma unroll
        for (int bj = 0; bj < 2; ++bj)
#pragma unroll
            for (int n = 0; n < 2; ++n) { const int c = col0 + bj * HALF + n * 16, h = c >> 7, part = (c >> 6) & 1, idx = c & 63, dc = h * KVH + (part ? 96 + idx : idx);
#pragma unroll
                for (int ai = 0; ai < 2; ++ai)
#pragma unroll
                    for (int m = 0; m < 4; ++m) { const int t = row0 + ai * HALF + m * 16; const f32x4 v = acc[ai][bj][m][n];
                        u32x2 w; w.x = cvt_pk_bf16(v[0], v[1]); w.y = cvt_pk_bf16(v[2], v[3]);
                        *(u32x2*)(KV + (size_t)t * KVP + dc) = w; } }
    }
};

template <class Epi, bool ALIGN_EPI>
__device__ __forceinline__ void gemm_phase(LAS unsigned char* lds, const Gemm g, const StaticOrder& S, const Epi& E, int wave) {
    const int wid = wave, lane = lane_id_opaque(), tid = wid * 64 + lane, wr = wid >> 2, wc = wid & 3, fr = lane & 15, fq = lane >> 4;
    const int K = g.K, nt = K / BK;
    unsigned voffA[2], voffB[2];
#pragma unroll
    for (int i = 0; i < 2; ++i) { int R, C; stage_rc(tid * 16 + i * 8192, R, C);
        voffA[i] = (unsigned)(R * g.lda + C) * 2u; voffB[i] = (unsigned)(R * g.ldb + C) * 2u; }
    const size_t kstep = (size_t)(BK * 2);
    const size_t hstepA = (size_t)HALF * g.lda * 2, hstepB = (size_t)HALF * g.ldb * 2;
    const size_t tstepA = 2 * hstepA, tstepB = 2 * hstepB;
    const unsigned ldsw = (unsigned)wid * 1024u;
    const int aoff = lds_byte(wr * 64 + fr, fq * 8), boff = lds_byte(wc * 32 + fr, fq * 8);
#define PG8_SA(b, h) (((b) * 2 + (h)) * HTB)
#define PG8_SB(b, h) ((4 + (b) * 2 + (h)) * HTB)
#define PG8_STAGE(bufoff, gbase, voff) do { _Pragma("unroll") for (int _i = 0; _i < 2; ++_i) \
        __builtin_amdgcn_global_load_lds((const unsigned*)((const char*)(gbase) + (voff)[_i]), (LAS unsigned*)(lds + (bufoff) + ldsw + _i * 8192), 16, 0, 0); } while (0)
#define PG8_LDA(dst, b, h) do { _Pragma("unroll") for (int m = 0; m < 4; ++m) _Pragma("unroll") for (int k = 0; k < 2; ++k) dst[m][k] = *(const LAS bf16x8*)(lds + PG8_SA(b, h) + aoff + m * 2048 + k * 1024); } while (0)
#define PG8_LDB(dst, b, h) do { _Pragma("unroll") for (int n = 0; n < 2; ++n) _Pragma("unroll") for (int k = 0; k < 2; ++k) dst[n][k] = *(const LAS bf16x8*)(lds + PG8_SB(b, h) + boff + n * 2048 + k * 1024); } while (0)
#define PG8_MMA(ai, bj, At, Bt) do { __builtin_amdgcn_s_setprio(1); _Pragma("unroll") for (int m = 0; m < 4; ++m) _Pragma("unroll") for (int n = 0; n < 2; ++n) _Pragma("unroll") for (int k = 0; k < 2; ++k) \
        acc[ai][bj][m][n] = __builtin_amdgcn_mfma_f32_16x16x32_bf16(Bt[n][k], At[m][k], acc[ai][bj][m][n], 0, 0, 0); __builtin_amdgcn_s_setprio(0); } while (0)
#define PG8_WAIT_V(n) asm volatile("s_waitcnt vmcnt(" #n ")" ::: "memory")
#define PG8_WAIT_L(n) asm volatile("s_waitcnt lgkmcnt(" #n ")" ::: "memory")
#define PG8_BAR __builtin_amdgcn_s_barrier()
#define PG8_SCHED __builtin_amdgcn_sched_barrier(0)
    Unit cur, nxt; int ui = 0;
    if (!S.next(0, cur)) return;
    Acc acc;
#pragma unroll
    for (int a = 0; a < 2; ++a)
#pragma unroll
        for (int b = 0; b < 2; ++b)
#pragma unroll
            for (int m = 0; m < 4; ++m)
#pragma unroll
                for (int n = 0; n < 2; ++n) acc[a][b][m][n] = (f32x4){0.f, 0.f, 0.f, 0.f};
    bf16x8 At[4][2], B0[2][2], B1[2][2];
    const char* cA = (const char*)g.A + (size_t)cur.pm * tstepA; const char* cB = (const char*)g.Bt + (size_t)cur.pn * tstepB;
    PG8_STAGE(PG8_SB(0, 0), cB, voffB); PG8_STAGE(PG8_SB(0, 1), cB + hstepB, voffB); PG8_STAGE(PG8_SA(0, 0), cA, voffA); PG8_STAGE(PG8_SA(0, 1), cA + hstepA, voffA);
    if (wr == 1) PG8_BAR;
    PG8_WAIT_V(2); PG8_BAR;
    PG8_STAGE(PG8_SB(1, 0), cB + kstep, voffB); PG8_STAGE(PG8_SA(1, 0), cA + kstep, voffA); PG8_STAGE(PG8_SB(1, 1), cB + hstepB + kstep, voffB);
    PG8_WAIT_V(6); PG8_BAR;
    for (;;) {
        const bool has_next = S.next(ui + 1, nxt);
        const char* nA = has_next ? (const char*)g.A + (size_t)nxt.pm * tstepA : cA; const char* nB = has_next ? (const char*)g.Bt + (size_t)nxt.pn * tstepB : cB;
        for (int t = 0; t < nt; t += 2) {
            const bool last = (t == nt - 2);
            const char* a1 = cA + (size_t)(t + 1) * kstep;
            const char* a2 = last ? nA : cA + (size_t)(t + 2) * kstep; const char* b2 = last ? nB : cB + (size_t)(t + 2) * kstep;
            const char* a3 = a2 + kstep; const char* b3 = b2 + kstep;
            PG8_LDB(B0, 0, 0); PG8_LDB(B1, 0, 1); PG8_SCHED; PG8_LDA(At, 0, 0); PG8_STAGE(PG8_SA(1, 1), a1 + hstepA, voffA);
            PG8_WAIT_V(8); PG8_WAIT_L(0); PG8_BAR; PG8_MMA(0, 0, At, B0); PG8_MMA(0, 1, At, B1); PG8_BAR; PG8_SCHED;
            PG8_LDA(At, 0, 1); PG8_STAGE(PG8_SB(0, 0), b2, voffB); PG8_STAGE(PG8_SB(0, 1), b2 + hstepB, voffB); PG8_STAGE(PG8_SA(0, 0), a2, voffA);
            PG8_WAIT_V(8); PG8_WAIT_L(0); PG8_BAR; PG8_MMA(1, 0, At, B0); PG8_MMA(1, 1, At, B1); PG8_BAR; PG8_SCHED;
            PG8_LDB(B0, 1, 0); PG8_LDB(B1, 1, 1); PG8_SCHED; PG8_LDA(At, 1, 0); PG8_STAGE(PG8_SA(0, 1), a2 + hstepA, voffA);
            PG8_WAIT_V(8); PG8_WAIT_L(0); PG8_BAR; PG8_MMA(0, 0, At, B0); PG8_MMA(0, 1, At, B1); PG8_BAR; PG8_SCHED;
            PG8_LDA(At, 1, 1); PG8_STAGE(PG8_SB(1, 0), b3, voffB); PG8_STAGE(PG8_SB(1, 1), b3 + hstepB, voffB); PG8_STAGE(PG8_SA(1, 0), a3, voffA);
            PG8_WAIT_V(8); PG8_WAIT_L(0); PG8_BAR; PG8_MMA(1, 0, At, B0); PG8_MMA(1, 1, At, B1); PG8_BAR; PG8_SCHED;
        }
        if constexpr (ALIGN_EPI) { if (wr == 0) PG8_BAR; }
        { const int l2 = lane_id_opaque(); E(acc, cur, wr, wc, l2 & 15, l2 >> 4); }
        if (!has_next) break;
#pragma unroll
        for (int a = 0; a < 2; ++a)
#pragma unroll
            for (int b = 0; b < 2; ++b)
#pragma unroll
                for (int m = 0; m < 4; ++m)
#pragma unroll
                    for (int n = 0; n < 2; ++n) acc[a][b][m][n] = (f32x4){0.f, 0.f, 0.f, 0.f};
        cur = nxt; cA = nA; cB = nB; ++ui;
        if constexpr (ALIGN_EPI) { if (wr == 1) PG8_BAR; }
    }
    PG8_WAIT_V(0);
    if constexpr (!ALIGN_EPI) { if (wr == 0) PG8_BAR; }
    PG8_BAR;
#undef PG8_SA
#undef PG8_SB
#undef PG8_STAGE
#undef PG8_LDA
#undef PG8_LDB
#undef PG8_MMA
#undef PG8_WAIT_V
#undef PG8_WAIT_L
#undef PG8_BAR
#undef PG8_SCHED
}
}

namespace att {
constexpr int NW = 8, QBLK = 32, KVBLK = 64;
constexpr float SCALE = 0.10206207261596575f;
constexpr float THR = 8.f;
constexpr int SHM_V = 16384, SHM_K = 16384, SHM_ATTN = 2 * SHM_V + 2 * SHM_K + NW * 64 * 4;
#define KSWZ(row, colB) ((row) * 256 + ((colB) ^ (((row) & 7) << 4)))
#define SBAR() __builtin_amdgcn_sched_barrier(0)
__device__ __forceinline__ int crow(int r, int hi) { return (r & 3) + 8 * (r >> 2) + 4 * hi; }

__device__ __forceinline__ void partialSM(f32x16& p0, f32x16& p1, float& m_reg, float& mn, float& alpha) {
  constexpr float C = SCALE * 1.4426950408889634f;
  float pmax = p0[0];
#pragma unroll
  for (int r = 1; r < 16; ++r) pmax = fmaxf(pmax, p0[r]);
#pragma unroll
  for (int r = 0; r < 16; ++r) pmax = fmaxf(pmax, p1[r]);
  { auto rr = __builtin_amdgcn_permlane32_swap(__float_as_uint(pmax), __float_as_uint(pmax), false, false);
    pmax = fmaxf(__uint_as_float(rr[0]), __uint_as_float(rr[1])); }
  if (__builtin_expect(__all(pmax - m_reg <= THR / SCALE), 1)) { mn = m_reg; alpha = 1.f; }
  else { mn = fmaxf(m_reg, pmax); alpha = __builtin_amdgcn_exp2f((m_reg - mn) * C); m_reg = mn; }
  float mnC = -mn * C;
#pragma unroll
  for (int r = 0; r < 16; ++r) p0[r] = fmaf(p0[r], C, mnC);
#pragma unroll
  for (int r = 0; r < 16; ++r) p1[r] = fmaf(p1[r], C, mnC);
#pragma unroll
  for (int r = 0; r < 16; ++r) p0[r] = __builtin_amdgcn_exp2f(p0[r]);
}
__device__ __forceinline__ void finishSM(f32x16& p0, f32x16& p1, float alpha, float& l_reg, bf16x8& pa0, bf16x8& pa1, bf16x8& pa2, bf16x8& pa3) {
#pragma unroll
  for (int r = 0; r < 16; ++r) p1[r] = __builtin_amdgcn_exp2f(p1[r]);
  float ps = 0;
#pragma unroll
  for (int r = 0; r < 16; ++r) ps += p0[r];
#pragma unroll
  for (int r = 0; r < 16; ++r) ps += p1[r];
  { auto rr = __builtin_amdgcn_permlane32_swap(__float_as_uint(ps), __float_as_uint(ps), false, false);
    ps = __uint_as_float(rr[0]) + __uint_as_float(rr[1]); }
  l_reg = l_reg * alpha + ps;
#define PK4(P, BASE, OUT) do { unsigned a0 = cvt_pk_bf16(P[BASE + 0], P[BASE + 1]), a1 = cvt_pk_bf16(P[BASE + 2], P[BASE + 3]);   \
    unsigned b0 = cvt_pk_bf16(P[BASE + 4], P[BASE + 5]), b1 = cvt_pk_bf16(P[BASE + 6], P[BASE + 7]);                              \
    auto r0 = __builtin_amdgcn_permlane32_swap(a0, b0, false, false); auto r1 = __builtin_amdgcn_permlane32_swap(a1, b1, false, false); \
    u32x4 w = {r0[0], r1[0], r0[1], r1[1]}; OUT = __builtin_bit_cast(bf16x8, w); } while (0)
  PK4(p0, 0, pa0); PK4(p0, 8, pa1); PK4(p1, 0, pa2); PK4(p1, 8, pa3);
#undef PK4
}
__device__ __forceinline__ void qkt(f32x16& p0, f32x16& p1, const LAS char* Ks, const bf16x8* qr, int r32, int hi) {
  p0 = f32x16{}; p1 = f32x16{};
#pragma unroll
  for (int d0 = 0; d0 < 6; ++d0) { int cb = (d0 * 16 + hi * 8) * 2;
    bf16x8 b0 = *reinterpret_cast<const LAS bf16x8*>(Ks + KSWZ(r32, cb));
    bf16x8 b1 = *reinterpret_cast<const LAS bf16x8*>(Ks + KSWZ(32 + r32, cb));
    p0 = __builtin_amdgcn_mfma_f32_32x32x16_bf16(b0, qr[d0], p0, 0, 0, 0);
    p1 = __builtin_amdgcn_mfma_f32_32x32x16_bf16(b1, qr[d0], p1, 0, 0, 0); }
}
__device__ __forceinline__ int v_st(int k, int c) { const int kk = (k & ~0xC) | ((k & 4) << 1) | ((k & 8) >> 1); return ((kk >> 3) * 4 + (c >> 5)) * 512 + ((kk & 7) * 32 + (c & 31)) * 2; }
__device__ __forceinline__ int v_rd_base(int lane) { return ((lane & 3) << 3) | (((lane >> 2) & 3) << 6) | (((lane >> 4) & 1) << 5) | (((lane >> 5) & 1) << 8); }
constexpr int v_rd_off(int d0, int ks, int half) { return d0 * 512 + ks * 4096 + half * 2048; }
template <int OFF> __device__ __forceinline__ s16x4 tr_read(int vb) {
  s16x4 r; asm volatile("ds_read_b64_tr_b16 %0, %1 offset:%2" : "=&v"(r) : "v"(vb), "i"(OFF) : "memory"); return r;
}
template <int D0> __device__ __forceinline__ void pv_one(f32x16& od, int vb, bf16x8 pa0, bf16x8 pa1, bf16x8 pa2, bf16x8 pa3) {
  const s16x4 l0 = tr_read<v_rd_off(D0, 0, 0)>(vb), h0 = tr_read<v_rd_off(D0, 0, 1)>(vb), l1 = tr_read<v_rd_off(D0, 1, 0)>(vb), h1 = tr_read<v_rd_off(D0, 1, 1)>(vb);
  const s16x4 l2 = tr_read<v_rd_off(D0, 2, 0)>(vb), h2 = tr_read<v_rd_off(D0, 2, 1)>(vb), l3 = tr_read<v_rd_off(D0, 3, 0)>(vb), h3 = tr_read<v_rd_off(D0, 3, 1)>(vb);
  asm volatile("s_waitcnt lgkmcnt(0)" ::: "memory"); SBAR();
#define PK(L, H) (bf16x8){L[0], L[1], L[2], L[3], H[0], H[1], H[2], H[3]}
  od = __builtin_amdgcn_mfma_f32_32x32x16_bf16(pa0, PK(l0, h0), od, 0, 0, 0);
  od = __builtin_amdgcn_mfma_f32_32x32x16_bf16(pa1, PK(l1, h1), od, 0, 0, 0);
  od = __builtin_amdgcn_mfma_f32_32x32x16_bf16(pa2, PK(l2, h2), od, 0, 0, 0);
  od = __builtin_amdgcn_mfma_f32_32x32x16_bf16(pa3, PK(l3, h3), od, 0, 0, 0);
#undef PK
}
__device__ __forceinline__ void pv_d0(f32x16* o, int vb, bf16x8 pa0, bf16x8 pa1, bf16x8 pa2, bf16x8 pa3) {
  pv_one<0>(o[0], vb, pa0, pa1, pa2, pa3); pv_one<1>(o[1], vb, pa0, pa1, pa2, pa3);
}

__device__ __forceinline__ void attn_unit(const bf16* __restrict__ Qb, const bf16* __restrict__ KVh, bf16* __restrict__ Ob, int seq, LAS char* lds, int t0, const f32x2* __restrict__ tab, int wave) {
  const int wid = wave, lane = lane_id_opaque(), tid = wid * 64 + lane, r32 = lane & 31, hi = lane >> 5;
  LAS char* V_lds = lds; LAS char* K_lds = lds + 2 * SHM_V;
  LAS float* ws = (LAS float*)(lds + 2 * SHM_V + 2 * SHM_K) + wid * 64; LAS float* li_l = ws; LAS float* al_l = ws + 32;
  float m_reg = -1e30f, l_reg = 0; f32x16 o[2] = {}; bf16x8 qr[6];
  const bf16* Qw = Qb + (long)(wid * QBLK + r32) * QP + hi * 8;
#pragma unroll
  for (int d0 = 0; d0 < 6; ++d0) qr[d0] = *reinterpret_cast<const bf16x8*>(Qw + d0 * 16);
  {
    const int t = t0 + wid * QBLK + r32;
#pragma unroll
    for (int a = 0; a < 2; ++a) { const int pos = a ? (t & 63) : (t >> 6); const u32x4 w = __builtin_bit_cast(u32x4, qr[4 + a]); u32x4 o;
#pragma unroll
      for (int p = 0; p < 4; ++p) { const f32x2 cs = tab[pos * 8 + 4 * hi + p]; const float x1 = bflo(w[p]), x2 = bfhi(w[p]);
        o[p] = cvt_pk_bf16(x1 * cs.x - x2 * cs.y, x2 * cs.x + x1 * cs.y); }
      qr[4 + a] = __builtin_bit_cast(bf16x8, o); } }
  int goff[3], loff[3];
#pragma unroll
  for (int i = 0; i < 3; ++i) { int q = tid + 512 * i; if (q >= 1280) q -= 1280; const int key = q / 20, cc = q % 20;
    goff[i] = key * KVP + cc * 8;
    loff[i] = cc < 12 ? (2 * SHM_V + KSWZ(key, cc * 16)) : v_st(key, (cc - 12) * 8); }
  const bool w3 = tid < 256;
  const int vb0 = (int)(uintptr_t)V_lds + v_rd_base(lane);
  struct { bf16x8 c[3]; } sr_[2];
#define SLOAD(i, k0) do { _Pragma("unroll") for (int _j = 0; _j < 3; ++_j) sr_[i].c[_j] = *reinterpret_cast<const bf16x8*>(KVh + (long)(k0) * KVP + goff[_j]); } while (0)
#define SWRITE(b, i) do { *(LAS bf16x8*)(lds + (b) * SHM_V + loff[0]) = sr_[i].c[0]; *(LAS bf16x8*)(lds + (b) * SHM_V + loff[1]) = sr_[i].c[1]; \
    if (w3) *(LAS bf16x8*)(lds + (b) * SHM_V + loff[2]) = sr_[i].c[2]; } while (0)
#define SWAIT() asm volatile("s_waitcnt vmcnt(3)" ::: "memory")
#define RESC(a) do { if (__any((a) < 1.f)) { if (hi == 0) al_l[r32] = (a); asm volatile("s_waitcnt lgkmcnt(0)" ::: "memory"); \
    _Pragma("unroll") for (int d = 0; d < 2; ++d) _Pragma("unroll") for (int r = 0; r < 16; ++r) o[d][r] *= al_l[crow(r, hi)]; } } while (0)
  f32x16 pA0, pA1, pB0, pB1; float mnA, mnB, alA, alB; bf16x8 pa0, pa1, pa2, pa3; const int NT = seq / KVBLK;
  constexpr int SE = 0, SO = 1;
  SLOAD(SE, 0); asm volatile("s_waitcnt vmcnt(0)" ::: "memory"); SWRITE(0, SE); __syncthreads();
  qkt(pA0, pA1, K_lds, qr, r32, hi); partialSM(pA0, pA1, m_reg, mnA, alA);
  SLOAD(SO, KVBLK); if (2 < NT) SLOAD(SE, 2 * KVBLK);
  SWAIT(); SWRITE(1, SO); __syncthreads();
  for (int j = 1; j + 1 < NT; j += 2) {
    SBAR(); qkt(pB0, pB1, K_lds + SHM_K, qr, r32, hi);
    finishSM(pA0, pA1, alA, l_reg, pa0, pa1, pa2, pa3); SBAR();
    SLOAD(SO, (j + 2) * KVBLK); SBAR();
    pv_d0(o, vb0, pa0, pa1, pa2, pa3); partialSM(pB0, pB1, m_reg, mnB, alB);
    __syncthreads(); SWAIT(); SWRITE(0, SE);
    RESC(alB); __syncthreads();
    SBAR(); qkt(pA0, pA1, K_lds, qr, r32, hi);
    finishSM(pB0, pB1, alB, l_reg, pa0, pa1, pa2, pa3); SBAR();
    if (j + 3 < NT) SLOAD(SE, (j + 3) * KVBLK); SBAR();
    pv_d0(o, vb0 + SHM_V, pa0, pa1, pa2, pa3); partialSM(pA0, pA1, m_reg, mnA, alA);
    __syncthreads(); SWAIT(); SWRITE(1, SO);
    RESC(alA); __syncthreads();
  }
  SBAR(); qkt(pB0, pB1, K_lds + SHM_K, qr, r32, hi);
  finishSM(pA0, pA1, alA, l_reg, pa0, pa1, pa2, pa3); SBAR();
  pv_d0(o, vb0, pa0, pa1, pa2, pa3); partialSM(pB0, pB1, m_reg, mnB, alB);
  __syncthreads(); RESC(alB);
  finishSM(pB0, pB1, alB, l_reg, pa0, pa1, pa2, pa3); SBAR();
  pv_d0(o, vb0 + SHM_V, pa0, pa1, pa2, pa3);
  if (hi == 0) li_l[r32] = l_reg; asm volatile("s_waitcnt lgkmcnt(0)" ::: "memory");
  float rli[16];
#pragma unroll
  for (int r = 0; r < 16; ++r) rli[r] = __builtin_amdgcn_rcpf(li_l[crow(r, hi)]);
  bf16* Ow = Ob + (long)(wid * QBLK) * DM;
#pragma unroll
  for (int r = 0; r < 16; ++r) { int orow = crow(r, hi);
#pragma unroll
    for (int d0 = 0; d0 < 2; ++d0) Ow[(long)orow * DM + d0 * 32 + r32] = (bf16)f2bf(o[d0][r] * rli[r]); }
  __syncthreads();
#undef SLOAD
#undef SWRITE
#undef SWAIT
#undef RESC
}
}

typedef GAS unsigned gu32;
#define RLX_AGENT __ATOMIC_RELAXED, __HIP_MEMORY_SCOPE_AGENT
#define XB_TMO      128
#define XB_XCNT(j)  (256  + 64 * (j))
#define XB_XSUB(j)  (1280 + 64 * (j))
#define XB_XGEN(j)  (2304 + 64 * (j))
#define XB_TOP      3328
#define XB_TOPGEN   3392
#define XCD_BAR_WORDS 3456
#define XB_SPIN_CAP (1u << 21)
__device__ __forceinline__ unsigned xb_ld(unsigned* p)              { return __hip_atomic_load(p, __ATOMIC_RELAXED, __HIP_MEMORY_SCOPE_AGENT); }
__device__ __forceinline__ unsigned xb_add(unsigned* p, unsigned v) { return __hip_atomic_fetch_add(p, v, __ATOMIC_RELAXED, __HIP_MEMORY_SCOPE_AGENT); }
__device__ __forceinline__ unsigned xb_xcc_id() { return (unsigned)__builtin_amdgcn_s_getreg((3 << 11) | 20) & 0xFu; }
#define XB_CODE 192
#define XB_SPIN(cond, bar, code) do { unsigned _sp = 0; while (cond) { __builtin_amdgcn_s_sleep(1); \
    if ((++_sp & 255u) == 0u) { if (xb_ld(&(bar)[XB_TMO])) break; if (_sp > XB_SPIN_CAP) { atomicCAS(&(bar)[XB_CODE], 0u, (unsigned)(code)); atomicAdd(&(bar)[XB_TMO], 1u); break; } } } } while (0)
struct XcdBarrier { unsigned* bar; unsigned x; volatile LAS unsigned* st; };
__device__ __forceinline__ XcdBarrier xcd_barrier_post(unsigned* bar, volatile LAS unsigned* st, int tid) {
    XcdBarrier b; b.bar = bar; b.x = xb_xcc_id(); b.st = st;
    if (tid == 0) (void)xb_add(&bar[XB_XCNT(b.x)], 1u);
    return b;
}
__device__ __forceinline__ void xcd_barrier_complete(unsigned* bar, unsigned x, unsigned& nloc, unsigned& nx) {
    const unsigned G = gridDim.x * gridDim.y * gridDim.z;
    unsigned sum, cnt, mine, sp = 0u;
    for (;;) {
        sum = 0u; cnt = 0u; mine = 0u;
#pragma unroll
        for (unsigned j = 0; j < 16; ++j) { const unsigned c = xb_ld(&bar[XB_XCNT(j)]); sum += c; cnt += (c > 0u) ? 1u : 0u; mine = (j == x) ? c : mine; }
        if (sum == G) break;
        __builtin_amdgcn_s_sleep(1);
        if ((++sp & 255u) == 0u) { if (xb_ld(&bar[XB_TMO])) break; if (sp > XB_SPIN_CAP) { atomicCAS(&bar[XB_CODE], 0u, 1u); atomicAdd(&bar[XB_TMO], 1u); break; } }
    }
    nloc = mine > 0u ? mine : 1u; nx = cnt > 0u ? cnt : 1u;
}
__device__ __forceinline__ void xcd_barrier(const XcdBarrier& b, unsigned seq, int tid) {
    asm volatile("s_waitcnt vmcnt(0)" ::: "memory");
    __syncthreads();
    if (tid == 0) {
        unsigned* bar = b.bar;
        __builtin_amdgcn_s_waitcnt(0);
        unsigned nloc = b.st[0], nx = b.st[1];
        if (nloc == 0u) { xcd_barrier_complete(bar, b.x, nloc, nx); b.st[0] = nloc; b.st[1] = nx; }
        const unsigned old = xb_add(&bar[XB_XSUB(b.x)], 1u);
        const unsigned gen = old / nloc;
        if (old + 1u == (gen + 1u) * nloc) {
            __builtin_amdgcn_fence(__ATOMIC_RELEASE, "agent");
            asm volatile("s_waitcnt vmcnt(0)" ::: "memory");
            const unsigned og = xb_add(&bar[XB_TOP], 1u);
            const unsigned tg = og / nx;
            if (og + 1u == (tg + 1u) * nx) xb_add(&bar[XB_TOPGEN], 1u);
            else XB_SPIN(xb_ld(&bar[XB_TOPGEN]) == tg, bar, 10u * seq + 2u);
            __builtin_amdgcn_fence(__ATOMIC_ACQUIRE, "agent");
            xb_add(&bar[XB_XGEN(b.x)], 1u);
            asm volatile("s_waitcnt vmcnt(0)" ::: "memory");
        } else {
            XB_SPIN(xb_ld(&bar[XB_XGEN(b.x)]) == gen, bar, 10u * seq + 3u);
            __builtin_amdgcn_fence(__ATOMIC_ACQUIRE, "agent");
            asm volatile("s_waitcnt vmcnt(0)" ::: "memory");
        }
    }
    __syncthreads();
}

constexpr int NWAVES = 8;
constexpr int RING_OFF = 0, RING_BYTES = 131072;
constexpr int LDSCTL_OFF = RING_BYTES, MISC_OFF = LDSCTL_OFF + 320;
constexpr int LDS_BYTES = 147456;
static_assert(att::SHM_ATTN <= RING_BYTES, "attention LDS");

struct Frame {
    LAS unsigned char* lds;
    volatile LAS unsigned* MISC;
    int tid, lane, wave, vcu, G;
    const float* in[23]; float* out; unsigned char* ws;
};
enum { I_X = 0, I_C, I_CTX, I_CCTX, I_WADA, I_BADA, I_NPRE, I_NPOST, I_F1IN, I_F1OUT, I_F2IN, I_F2OUT, I_WIN, I_QNORM, I_WQB, I_KVNORM, I_WKVB,
       I_WAF, I_BAF, I_WAB, I_BAB, I_GNORM, I_WOUT };

template <class Map>
__device__ __forceinline__ void transpose_item(const float* W, int Ns, bf16* WT, int ldd, LAS float* scr, int k0, int n0, int lane, Map srcmap) {
    const int sc = srcmap(n0 + (lane & 31));
#pragma unroll 8
    for (int i = 0; i < 32; ++i) { const int kk = 2 * i + (lane >> 5); scr[kk * 33 + (lane & 31)] = sc >= 0 ? W[(size_t)(k0 + kk) * Ns + sc] : 0.f; }
    LDS_WAIT(); asm volatile("" ::: "memory");
    const int c = lane & 7;
#pragma unroll
    for (int j = 0; j < 4; ++j) { const int n = (lane >> 3) + 8 * j; const LAS float* s = scr + (8 * c) * 33 + n;
        u32x4 o; o.x = cvt_pk_bf16(s[0 * 33], s[1 * 33]); o.y = cvt_pk_bf16(s[2 * 33], s[3 * 33]); o.z = cvt_pk_bf16(s[4 * 33], s[5 * 33]); o.w = cvt_pk_bf16(s[6 * 33], s[7 * 33]);
        *(GAS u32x4*)(WT + (size_t)(n0 + n) * ldd + k0 + 8 * c) = o; }
    LDS_WAIT(); asm volatile("" ::: "memory");
}
struct MapId { __device__ int operator()(int n) const { return n; } };
struct MapFfnIn { __device__ int operator()(int n) const { const int pn = n >> 8, c = n & 255; return c < 128 ? 128 * pn + c : DFF + 128 * pn + (c - 128); } };
struct MapWin { __device__ int operator()(int n) const {
    if (n < 416) return n;
    if (n < 448) return 1952 + (n - 416);
    if (n < 512) return -1;
    if (n < 768) return 416 + (n - 512);
    if (n < 1024) return 672 + (n - 768);
    if (n < 1536) return 928 + (n - 1024);
    return 1440 + (n - 1536); } };
struct MapWqb { __device__ int operator()(int n) const { const int h = n / QH, j = n % QH; if (j < 64) return h * QH + j;
    const int jj = j - 64, i = jj >> 1, p = jj & 1, a = i >> 3, f = i & 7; return h * QH + 64 + 16 * a + 8 * p + f; } };

__device__ __forceinline__ void p0_prologue(Frame& F) {
    LAS float* scr = (LAS float*)(F.lds + RING_OFF + F.wave * 16384);
    const int gw = F.vcu * NWAVES + F.wave, NGW = F.G * NWAVES;
    for (int idx = F.vcu * 512 + F.tid; idx < 2048; idx += F.G * 512) {
        const int pos = idx >> 3, f = idx & 7;
        const float invf = f == 0 ? 1.0f : f == 1 ? 0.31622776601683794f : f == 2 ? 0.1f : f == 3 ? 0.031622776601683794f : f == 4 ? 0.01f : f == 5 ? 0.0031622776601683794f : f == 6 ? 0.001f : 0.00031622776601683794f;
        const float ang = (float)pos * invf;
        double t = (double)ang * 0.15915494309189535; t -= floor(t);
        const float tf = (float)t;
        f32x2 cs; cs.x = __builtin_amdgcn_cosf(tf); cs.y = __builtin_amdgcn_sinf(tf);
        ((f32x2*)(F.ws + WS_ROPE))[idx] = cs;
    }
    if (F.vcu < 144) {
        LAS float* sl = (LAS float*)(F.lds + 100 * 1024);
        LAS float* red = (LAS float*)(F.lds + 108 * 1024);
        for (int i = F.tid; i < 2048; i += 512) { const float v = i < 1024 ? F.in[I_C][i] : F.in[I_CCTX][i - 1024]; sl[i] = v / (1.0f + expf(-v)); }
        __syncthreads();
        for (int u = F.vcu; u < 144; u += F.G) {
            const int cq = F.tid & 15, kg = F.tid >> 4;
            const float* Wp = F.in[I_WADA] + (size_t)u * 64 + cq * 4;
            f32x4 al = {0.f, 0.f, 0.f, 0.f}, ac = {0.f, 0.f, 0.f, 0.f};
#pragma unroll 8
            for (int i = 0; i < 32; ++i) { const int k = kg + 32 * i; const f32x4 w = *(const f32x4*)(Wp + (size_t)k * NMODV); al += w * sl[k]; ac += w * sl[1024 + k]; }
            *(LAS f32x4*)(red + kg * 128 + cq * 4) = al; *(LAS f32x4*)(red + kg * 128 + 64 + cq * 4) = ac;
            __syncthreads();
            if (F.tid < 128) { float s = 0.f;
#pragma unroll
                for (int g = 0; g < 32; ++g) s += red[g * 128 + F.tid];
                const int ty = F.tid >> 6, col = u * 64 + (F.tid & 63);
                ((float*)(F.ws + WS_MOD))[ty * NMODV + col] = s + F.in[I_BADA][col]; }
            __syncthreads();
        }
    }
    constexpr int I_1IN = 16 * 176, I_1OUT = 44 * 32, I_WN = 16 * 64, I_QB = 4 * 24, I_KVB = 2 * 32, I_OUT = 16 * 32;
    constexpr int NITEMS = 2 * I_1IN + 2 * I_1OUT + I_WN + I_QB + I_KVB + I_OUT;
    for (int it = gw; it < NITEMS; it += NGW) {
        int r = it;
        if (r < I_1IN) { transpose_item(F.in[I_F1IN], 2 * DFF, (bf16*)(F.ws + WS_W1IN), DM, scr, 64 * (r / 176), 32 * (r % 176), F.lane, MapFfnIn()); continue; } r -= I_1IN;
        if (r < I_1IN) { transpose_item(F.in[I_F2IN], 2 * DFF, (bf16*)(F.ws + WS_W2IN), DM, scr, 64 * (r / 176), 32 * (r % 176), F.lane, MapFfnIn()); continue; } r -= I_1IN;
        if (r < I_1OUT) { transpose_item(F.in[I_F1OUT], DM, (bf16*)(F.ws + WS_W1OUT), DFF, scr, 64 * (r / 32), 32 * (r % 32), F.lane, MapId()); continue; } r -= I_1OUT;
        if (r < I_1OUT) { transpose_item(F.in[I_F2OUT], DM, (bf16*)(F.ws + WS_W2OUT), DFF, scr, 64 * (r / 32), 32 * (r % 32), F.lane, MapId()); continue; } r -= I_1OUT;
        if (r < I_WN) { transpose_item(F.in[I_WIN], 1984, (bf16*)(F.ws + WS_WIN), DM, scr, 64 * (r / 64), 32 * (r % 64), F.lane, MapWin()); continue; } r -= I_WN;
        if (r < I_QB) { transpose_item(F.in[I_WQB], QP, (bf16*)(F.ws + WS_WQB), 256, scr, 64 * (r / 24), 32 * (r % 24), F.lane, MapWqb()); continue; } r -= I_QB;
        if (r < I_KVB) { transpose_item(F.in[I_WKVB], 1024, (bf16*)(F.ws + WS_WKVB), 256, scr, 64 * (r / 32), 32 * (r % 32), F.lane, MapId()); continue; } r -= I_KVB;
        transpose_item(F.in[I_WOUT], DM, (bf16*)(F.ws + WS_WOUT), DM, scr, 64 * (r / 32), 32 * (r % 32), F.lane, MapId());
    }
    for (int i = F.vcu * 512 + F.tid; i < 1024 * 16; i += F.G * 512) { const int n = i >> 4, c = i & 15;
        *(GAS u32x4*)((bf16*)(F.ws + WS_WKVB) + (size_t)n * 256 + 128 + c * 8) = (u32x4){0u, 0u, 0u, 0u}; }
}

__device__ __forceinline__ void norm_row(int lane, const float* src, const float* y, float gsc, const float* gate, const float* gpost, float* resout,
                                         const float* gpre, const float* shift, const float* scale, bf16* hout) {
    f32x4 v[4];
#pragma unroll
    for (int j = 0; j < 4; ++j) v[j] = *((const f32x4*)src + lane + 64 * j);
    if (y) {
        f32x4 yv[4]; float s = 0.f;
#pragma unroll
        for (int j = 0; j < 4; ++j) { yv[j] = *((const f32x4*)y + lane + 64 * j); s += (yv[j].x * yv[j].x + yv[j].y * yv[j].y) + (yv[j].z * yv[j].z + yv[j].w * yv[j].w); }
        const float rstd = 1.0f / sqrtf(wave_sum(s) * (1.f / DM) + EPS);
#pragma unroll
        for (int j = 0; j < 4; ++j) { const f32x4 g = *((const f32x4*)gate + lane + 64 * j), p = *((const f32x4*)gpost + lane + 64 * j);
            v[j] = v[j] + (yv[j] * rstd) * p * g * gsc; }
    }
    if (resout) {
#pragma unroll
        for (int j = 0; j < 4; ++j) *((f32x4*)resout + lane + 64 * j) = v[j];
    }
    if (hout) {
        float s = 0.f;
#pragma unroll
        for (int j = 0; j < 4; ++j) s += (v[j].x * v[j].x + v[j].y * v[j].y) + (v[j].z * v[j].z + v[j].w * v[j].w);
        const float rstd = 1.0f / sqrtf(wave_sum(s) * (1.f / DM) + EPS);
#pragma unroll
        for (int j = 0; j < 4; ++j) { const f32x4 g = *((const f32x4*)gpre + lane + 64 * j), sh = *((const f32x4*)shift + lane + 64 * j), sc = *((const f32x4*)scale + lane + 64 * j);
            const f32x4 h = (v[j] * rstd) * g * (sc + 1.0f) + sh;
            u32x2 w; w.x = cvt_pk_bf16(h.x, h.y); w.y = cvt_pk_bf16(h.z, h.w);
            *((u32x2*)hout + lane + 64 * j) = w; }
    }
}

__device__ __forceinline__ void mixer_row(Frame& F, int row) {
    const int lane = lane_id_opaque();
    const bf16* Zq = (const bf16*)(F.ws + WS_ZQ); const float* Z1f = (const float*)(F.ws + WS_Z1F);
    bf16* KV = (bf16*)(F.ws + WS_KV);
    if (row >= CTX) {
        const u32x2 w = *((const u32x2*)(Zq + (size_t)row * 256) + lane);
        const float a = bflo(w.x), b = bfhi(w.x), c = bflo(w.y), d = bfhi(w.y);
        const float rstd = 1.0f / sqrtf(wave_sum((a * a + b * b) + (c * c + d * d)) * (1.f / 256.f) + EPS);
        const f32x4 g = *((const f32x4*)F.in[I_QNORM] + lane);
        u32x2 o; o.x = cvt_pk_bf16(a * rstd * g.x, b * rstd * g.y); o.y = cvt_pk_bf16(c * rstd * g.z, d * rstd * g.w);
        *((u32x2*)((bf16*)(F.ws + WS_QN) + (size_t)(row - CTX) * 256) + lane) = o;
    }
    {
        f32x4 v = {0.f, 0.f, 0.f, 0.f}, g = {0.f, 0.f, 0.f, 0.f};
        if (lane < 32) { v = *((const f32x4*)(Z1f + (size_t)row * 256) + lane); g = *((const f32x4*)F.in[I_KVNORM] + lane); }
        const float rstd = 1.0f / sqrtf(wave_sum((v.x * v.x + v.y * v.y) + (v.z * v.z + v.w * v.w)) * (1.f / 128.f) + EPS);
        u32x2 o; o.x = cvt_pk_bf16(v.x * rstd * g.x, v.y * rstd * g.y); o.y = cvt_pk_bf16(v.z * rstd * g.z, v.w * rstd * g.w);
        *((u32x2*)((bf16*)(F.ws + WS_KVN) + (size_t)row * 256) + lane) = o;
    }
    if (lane < 16) {
        const int i = lane, a = i >> 3, f = i & 7;
        const float x1 = Z1f[(size_t)row * 256 + 128 + 16 * a + f], x2 = Z1f[(size_t)row * 256 + 128 + 16 * a + 8 + f];
        float o1 = x1, o2 = x2;
        if (row >= CTX) { const int t = row - CTX, pos = a ? (t & 63) : (t >> 6); const f32x2 cs = ((const f32x2*)(F.ws + WS_ROPE))[pos * 8 + f];
            o1 = x1 * cs.x - x2 * cs.y; o2 = x2 * cs.x + x1 * cs.y; }
        const unsigned pk = cvt_pk_bf16(o1, o2);
#pragma unroll
        for (int h = 0; h < 8; ++h) *(unsigned*)(KV + (size_t)row * KVP + h * KVH + 64 + 2 * i) = pk;
    }
}

template <int DIR>
__device__ __forceinline__ void gla_prep_qk(Frame& F, int cn, int c, const LAS float* gal) {
    const float* wa = F.in[DIR ? I_WAB : I_WAF]; const float bb = F.in[DIR ? I_BAB : I_BAF][c];
    float w[16];
#pragma unroll
    for (int r = 0; r < 16; ++r) w[r] = wa[r * 256 + c];
    const int row0 = cn * 64;
    const bf16* Zg = (const bf16*)(F.ws + WS_ZGQK);
    float Gs[64]; float G = 0.f;
#pragma unroll
    for (int s = 0; s < 64; ++s) { const int i = DIR ? 63 - s : s;
        const LAS float* ga = gal + i * 32 + 16 * DIR;
        float lg = bb;
#pragma unroll
        for (int r = 0; r < 16; ++r) lg = fmaf(ga[r], w[r], lg);
        const float la = (fminf(lg, 0.f) - log1pf(expf(-fabsf(lg)))) * (1.0f / 16.0f);
        G += la; Gs[i] = G; }
    const float Glast = G, Gref = DIR ? Gs[32] : Gs[31];
    const size_t aidx = ((size_t)DIR * NCH + cn) * 256 + c;
    float* aux = (float*)(F.ws + WS_AUX);
    aux[aidx] = expf(Glast); aux[AUX_N + aidx] = expf(Glast - Gref); aux[2 * AUX_N + aidx] = expf(Gref);
    bf16* Qt = (bf16*)(F.ws + WS_QT) + (size_t)DIR * ROWS * 256; bf16* Kt = (bf16*)(F.ws + WS_KT) + (size_t)DIR * ROWS * 256;
    bf16* KtT = (bf16*)(F.ws + WS_KTT) + (((size_t)DIR * NCH + cn) * 256 + c) * 64;
#pragma unroll
    for (int g8 = 0; g8 < 8; ++g8) { float kt[8];
#pragma unroll
        for (int t = 0; t < 8; ++t) { const int i = g8 * 8 + t; const size_t ro = (size_t)(row0 + i);
            const float q = bf2f(Zg[ro * 512 + c]), k = bf2f(Zg[ro * 512 + 256 + c]);
            const float qt = q * 0.125f * expf(Gs[i] - Gref); kt[t] = k * expf(Gref - Gs[i]);
            Qt[ro * 256 + c] = (bf16)f2bf(qt); Kt[ro * 256 + c] = (bf16)f2bf(kt[t]); }
        u32x4 o; o.x = cvt_pk_bf16(kt[0], kt[1]); o.y = cvt_pk_bf16(kt[2], kt[3]); o.z = cvt_pk_bf16(kt[4], kt[5]); o.w = cvt_pk_bf16(kt[6], kt[7]);
        *(u32x4*)(KtT + g8 * 8) = o; }
}
__device__ __forceinline__ void gla_prep_v(Frame& F, int cn, int col) {
    const bf16* Zv = (const bf16*)(F.ws + WS_ZGV) + (size_t)cn * 64 * 512 + col;
    bf16* vT = (bf16*)(F.ws + WS_VT) + ((size_t)cn * 512 + col) * 64;
#pragma unroll
    for (int g8 = 0; g8 < 8; ++g8) { unsigned short e[8];
#pragma unroll
        for (int t = 0; t < 8; ++t) e[t] = Zv[(size_t)(g8 * 8 + t) * 512];
        u32x4 o; o.x = e[0] | ((unsigned)e[1] << 16); o.y = e[2] | ((unsigned)e[3] << 16); o.z = e[4] | ((unsigned)e[5] << 16); o.w = e[6] | ((unsigned)e[7] << 16);
        *(u32x4*)(vT + g8 * 8) = o; }
}

__device__ __forceinline__ void gla_pass_l(Frame& F, int task) {
    const int lane = lane_id_opaque(), r = lane & 31, hi = lane >> 5;
    const int cn = task % NCH, dh = task / NCH, h = dh & 3, dir = dh >> 2;
    const bf16* vTp = (const bf16*)(F.ws + WS_VT) + ((size_t)cn * 512 + h * 128) * 64;
    const bf16* kTp = (const bf16*)(F.ws + WS_KTT) + (((size_t)dir * NCH + cn) * 256 + h * 64) * 64;
    bf16* Lp = (bf16*)(F.ws + WS_LS) + (((size_t)(dir * 4 + h) * NCH + cn) * 128) * 64;
    bf16x8 bfr[2][4];
#pragma unroll
    for (int nt = 0; nt < 2; ++nt)
#pragma unroll
        for (int s = 0; s < 4; ++s) bfr[nt][s] = *(const bf16x8*)(kTp + (32 * nt + r) * 64 + 16 * s + 8 * hi);
#pragma unroll
    for (int mt = 0; mt < 4; ++mt) { bf16x8 afr[4]; bf16* pm = Lp + (4 * hi) * 64 + r + (32 * mt) * 64;
#pragma unroll
        for (int s = 0; s < 4; ++s) afr[s] = *(const bf16x8*)(vTp + (32 * mt + r) * 64 + 16 * s + 8 * hi);
#pragma unroll
        for (int nt = 0; nt < 2; ++nt) { f32x16 acc = {};
#pragma unroll
            for (int s = 0; s < 4; ++s) acc = __builtin_amdgcn_mfma_f32_32x32x16_bf16(afr[s], bfr[nt][s], acc, 0, 0, 0);
#pragma unroll
            for (int rg = 0; rg < 16; ++rg) pm[((rg & 3) + 8 * (rg >> 2)) * 64 + 32 * nt] = (bf16)f2bf(acc[rg]); } }
}

__device__ __forceinline__ void gla_pass_s(Frame& F) {
    const float* aux = (const float*)(F.ws + WS_AUX);
    for (int el = F.vcu * 256 + F.tid; F.tid < 256 && el < 65536; el += F.G * 256) {
        const int d = el & 63, e = (el >> 6) & 127, dh = el >> 13, h = dh & 3, dir = dh >> 2;
        bf16* Lp = (bf16*)(F.ws + WS_LS) + ((size_t)dh * NCH * 128 + e) * 64 + d;
        const float* ap = aux + (size_t)dir * NCH * 256 + h * 64 + d;
        float S = 0.f;
        for (int p0 = 0; p0 < NCH; p0 += 4) { float lv[4], dc[4], sc[4], er[4]; int cn[4];
#pragma unroll
            for (int u = 0; u < 4; ++u) { const int p = p0 + u; cn[u] = dir ? (p < 4 ? 3 - p : 263 - p) : p;
                lv[u] = bf2f(Lp[(size_t)cn[u] * 8192]); dc[u] = ap[cn[u] * 256]; sc[u] = ap[AUX_N + cn[u] * 256]; er[u] = ap[2 * AUX_N + cn[u] * 256]; }
#pragma unroll
            for (int u = 0; u < 4; ++u) { Lp[(size_t)cn[u] * 8192] = (bf16)f2bf(S * er[u]); S = dc[u] * S + sc[u] * lv[u]; } }
    }
}

template <int DIR, int IT>
__device__ __forceinline__ void gla_o_dir(Frame& F, f32x16 (&o)[4], int h, int cn, int r, int hi) {
    const size_t row0 = (size_t)cn * 64;
    const bf16* Qp = (const bf16*)(F.ws + WS_QT) + ((size_t)DIR * ROWS + row0) * 256 + h * 64;
    const bf16* Kp = (const bf16*)(F.ws + WS_KT) + ((size_t)DIR * ROWS + row0) * 256 + h * 64;
    const bf16* Sp = (const bf16*)(F.ws + WS_LS) + (((size_t)(DIR * 4 + h) * NCH + cn) * 128) * 64;
    const bf16* vTp = (const bf16*)(F.ws + WS_VT) + ((size_t)cn * 512 + h * 128) * 64;
    bf16x8 qf[4];
#pragma unroll
    for (int s = 0; s < 4; ++s) qf[s] = *(const bf16x8*)(Qp + (size_t)(32 * IT + r) * 256 + 16 * s + 8 * hi);
#pragma unroll
    for (int jt = 0; jt < 2; ++jt) {
        if (DIR == 0 ? (jt > IT) : (jt < IT)) continue;
        bf16x8 kf[4];
#pragma unroll
        for (int s = 0; s < 4; ++s) kf[s] = *(const bf16x8*)(Kp + (size_t)(32 * jt + r) * 256 + 16 * s + 8 * hi);
        f32x16 X = {};
#pragma unroll
        for (int s = 0; s < 4; ++s) X = __builtin_amdgcn_mfma_f32_32x32x16_bf16(kf[s], qf[s], X, 0, 0, 0);
        if (jt == IT) {
#pragma unroll
            for (int rg = 0; rg < 16; ++rg) { const int j = att::crow(rg, hi); const bool keep = DIR == 0 ? (j <= r) : (j >= r); X[rg] = keep ? X[rg] : 0.f; } }
        bf16x8 xa[2];
#pragma unroll
        for (int s2 = 0; s2 < 2; ++s2) { u32x4 w; w.x = cvt_pk_bf16(X[8 * s2 + 0], X[8 * s2 + 1]); w.y = cvt_pk_bf16(X[8 * s2 + 2], X[8 * s2 + 3]);
            w.z = cvt_pk_bf16(X[8 * s2 + 4], X[8 * s2 + 5]); w.w = cvt_pk_bf16(X[8 * s2 + 6], X[8 * s2 + 7]); xa[s2] = __builtin_bit_cast(bf16x8, w); }
#pragma unroll
        for (int nt = 0; nt < 4; ++nt)
#pragma unroll
            for (int s2 = 0; s2 < 2; ++s2) { const bf16* vp = vTp + (size_t)(32 * nt + r) * 64 + 32 * jt + 16 * s2 + 4 * hi;
                const u32x2 lo = *(const u32x2*)vp, hi8 = *(const u32x2*)(vp + 8);
                const u32x4 bw = {lo.x, lo.y, hi8.x, hi8.y};
                o[nt] = __builtin_amdgcn_mfma_f32_32x32x16_bf16(xa[s2], __builtin_bit_cast(bf16x8, bw), o[nt], 0, 0, 0); }
    }
#pragma unroll
    for (int nt = 0; nt < 4; ++nt)
#pragma unroll
        for (int s = 0; s < 4; ++s) { const bf16x8 sf = *(const bf16x8*)(Sp + (size_t)(32 * nt + r) * 64 + 16 * s + 8 * hi);
            o[nt] = __builtin_amdgcn_mfma_f32_32x32x16_bf16(qf[s], sf, o[nt], 0, 0, 0); }
}
template <int IT>
__device__ __forceinline__ void gla_pass_o(Frame& F, int h, int cn) {
    const int lane = lane_id_opaque(), r = lane & 31, hi = lane >> 5;
    f32x16 o[4];
#pragma unroll
    for (int nt = 0; nt < 4; ++nt) o[nt] = f32x16{};
    gla_o_dir<0, IT>(F, o, h, cn, r, hi);
    gla_o_dir<1, IT>(F, o, h, cn, r, hi);
    const bf16* Zgg = (const bf16*)(F.ws + WS_ZGG); bf16* mix = (bf16*)(F.ws + WS_MIX);
    float gn[4];
#pragma unroll
    for (int nt = 0; nt < 4; ++nt) gn[nt] = F.in[I_GNORM][32 * nt + r];
#pragma unroll
    for (int rg = 0; rg < 16; ++rg) {
        float ss = 0.f;
#pragma unroll
        for (int nt = 0; nt < 4; ++nt) ss += o[nt][rg] * o[nt][rg];
        ss = half_sum(ss);
        const float rstd = 1.0f / sqrtf(ss * (1.f / 128.f) + EPS);
        const int i = 32 * IT + att::crow(rg, hi); const size_t row = (size_t)cn * 64 + i;
#pragma unroll
        for (int nt = 0; nt < 4; ++nt) { const int e = 32 * nt + r; const float gg = bf2f(Zgg[row * 512 + h * 128 + e]);
            const float val = o[nt][rg] * rstd * gn[nt] * (gg / (1.0f + expf(-gg)));
            mix[(row - CTX) * DM + 512 + h * 128 + e] = (bf16)f2bf(val); } }
}

#ifndef PHM
#define PHM 0xFFFF
#endif
#define PH(k) ((PHM >> (k)) & 1)
struct Args { const float* in[23]; float* out; unsigned char* ws; };
__global__ void __launch_bounds__(NWAVES * 64, 2) fwd_megakernel(Args args) {
    extern __shared__ __attribute__((aligned(16))) unsigned char lds[];
    Frame F;
    F.lds = (LAS unsigned char*)lds;
    F.MISC = (volatile LAS unsigned*)(F.lds + MISC_OFF);
    F.wave = __builtin_amdgcn_readfirstlane((int)threadIdx.x >> 6); F.lane = lane_id_opaque(); F.tid = F.wave * 64 + F.lane;
    F.G = gridDim.x; { const int bx = blockIdx.x; F.vcu = (F.G % 8 == 0) ? (bx % 8) * (F.G / 8) + bx / 8 : bx; }
#pragma unroll
    for (int i = 0; i < 23; ++i) F.in[i] = args.in[i];
    F.out = args.out; F.ws = args.ws;
    for (int u = F.tid; u < (LDS_BYTES - LDSCTL_OFF) / 4; u += NWAVES * 64) ((LAS unsigned*)(F.lds + LDSCTL_OFF))[u] = 0u;
    __syncthreads();
    XcdBarrier bar = xcd_barrier_post((unsigned*)(F.ws + WS_CTL), F.MISC + 8, F.tid);
unsigned bseq = 0;
#define GRID_BAR() do { ++bseq; { const int l_ = lane_id_opaque(); xcd_barrier(bar, bseq, F.wave * 64 + l_); } F.lane = lane_id_opaque(); F.tid = F.wave * 64 + F.lane; } while (0)
    const int gw = F.vcu * NWAVES + F.wave, NGW = F.G * NWAVES;
    const float* modl = (const float*)(F.ws + WS_MOD); const float* modc = modl + NMODV;
    bf16* hA = (bf16*)(F.ws + WS_A); float* Y = (float*)(F.ws + WS_Y);
    const float* npre = F.in[I_NPRE]; const float* npost = F.in[I_NPOST];
    LAS unsigned char* ring = F.lds + RING_OFF;

    if (PH(0)) p0_prologue(F);
    GRID_BAR();
    if (PH(1)) for (int row = gw; row < ROWS; row += NGW) {
        const bool isc = row < CTX; const float* md = isc ? modc : modl;
        const float* src = isc ? F.in[I_CTX] + (size_t)row * DM : F.in[I_X] + (size_t)(row - CTX) * DM;
        norm_row(F.lane, src, nullptr, 0.f, nullptr, nullptr, nullptr, npre, md, md + DM, hA + (size_t)row * DM);
    }
    GRID_BAR();
    if (PH(2)) { pg8::Gemm g{hA, (const bf16*)(F.ws + WS_W1IN), ROWS, 2 * DFF, DM, DM, DM}; pg8::StaticOrder S; S.init(ROWS, 2 * DFF, F.G, (int)blockIdx.x);
      pg8::EpiSwiGLU E{(bf16*)(F.ws + WS_ACT), DFF};
      pg8::gemm_phase<pg8::EpiSwiGLU, true>(ring, g, S, E, F.wave); }
    GRID_BAR();
    if (PH(3)) { pg8::Gemm g{(const bf16*)(F.ws + WS_ACT), (const bf16*)(F.ws + WS_W1OUT), ROWS, DM, DFF, DFF, DFF}; pg8::StaticOrder S; S.init(ROWS, DM, F.G, (int)blockIdx.x);
      pg8::EpiF32 E{Y, DM};
      pg8::gemm_phase<pg8::EpiF32, true>(ring, g, S, E, F.wave); }
    GRID_BAR();
    if (PH(4)) for (int row = gw; row < ROWS; row += NGW) {
        const bool isc = row < CTX; const float* md = isc ? modc : modl;
        const float* src = isc ? F.in[I_CTX] + (size_t)row * DM : F.in[I_X] + (size_t)(row - CTX) * DM;
        float* ro = isc ? nullptr : F.out + (size_t)(row - CTX) * DM;
        norm_row(F.lane, src, Y + (size_t)row * DM, 0.5f, md + 2 * DM, npost, ro, npre + DM, md + 3 * DM, md + 4 * DM, hA + (size_t)row * DM);
    }
    GRID_BAR();
#if defined(STOPAT) && STOPAT == 4
    return;
#endif
    if (PH(5)) { pg8::Gemm g{hA, (const bf16*)(F.ws + WS_WIN), ROWS, 2048, DM, DM, DM}; pg8::StaticOrder S; S.init(ROWS, 2048, F.G, (int)blockIdx.x);
      pg8::EpiZ E{(bf16*)(F.ws + WS_ZQ), (bf16*)(F.ws + WS_ZGQK), (bf16*)(F.ws + WS_ZGV), (bf16*)(F.ws + WS_ZGG), (float*)(F.ws + WS_Z1F)};
      pg8::gemm_phase<pg8::EpiZ, true>(ring, g, S, E, F.wave); }
    GRID_BAR();
    if (PH(6)) for (int row = gw; row < ROWS; row += NGW) mixer_row(F, row);
    if (PH(6)) for (int t = F.vcu; t < 2 * NCH; t += F.G) { const int cn = t >> 1;
        if (t & 1) gla_prep_v(F, cn, F.tid);
        else { LAS float* gal = (LAS float*)ring;
            __syncthreads();
            { const int i = F.tid >> 3, q4 = F.tid & 7; *(LAS f32x4*)(gal + i * 32 + q4 * 4) = *(const f32x4*)((const float*)(F.ws + WS_Z1F) + (size_t)(cn * 64 + i) * 256 + 160 + q4 * 4); }
            __syncthreads();
            if (F.tid < 256) gla_prep_qk<0>(F, cn, F.tid, gal); else gla_prep_qk<1>(F, cn, F.tid - 256, gal); } }
    GRID_BAR();
    if (PH(7)) { pg8::Gemm g{(const bf16*)(F.ws + WS_QN), (const bf16*)(F.ws + WS_WQB), SEQ, QP, 256, 256, 256}; pg8::StaticOrder S; S.init(SEQ, QP, F.G, (int)blockIdx.x);
      pg8::EpiQ E{(bf16*)(F.ws + WS_Q)};
      pg8::gemm_phase<pg8::EpiQ, true>(ring, g, S, E, F.wave); }
    if (PH(7)) { pg8::Gemm g{(const bf16*)(F.ws + WS_KVN), (const bf16*)(F.ws + WS_WKVB), ROWS, 1024, 256, 256, 256}; pg8::StaticOrder S; S.init(ROWS, 1024, F.G, (int)((blockIdx.x + 64) % F.G));
      pg8::EpiKV E{(bf16*)(F.ws + WS_KV)};
      pg8::gemm_phase<pg8::EpiKV, true>(ring, g, S, E, F.wave); }
    if (PH(8)) for (int t = gw; t < 8 * NCH; t += NGW) gla_pass_l(F, t);
    GRID_BAR();
#if defined(STOPAT) && STOPAT == 6
    { const bf16* Qp = (const bf16*)(F.ws + WS_Q); const bf16* KVp = (const bf16*)(F.ws + WS_KV);
      for (size_t i = (size_t)blockIdx.x * 512 + F.tid; i < (size_t)SEQ * DM; i += (size_t)F.G * 512) { const size_t t = i >> 10; const int c = (int)(i & 1023);
        F.out[i] = c < 768 ? bf2f(Qp[t * QP + c]) : bf2f(KVp[(t + CTX) * KVP + (c - 768)]) + bf2f(KVp[(t + CTX) * KVP + 256 + (c - 768)]) + bf2f(KVp[t * KVP + 1024 + (c - 768)]); } }
    return;
#endif
#if defined(STOPAT) && STOPAT == 7
    { const bf16* Qt = (const bf16*)(F.ws + WS_QT); const bf16* Kt = (const bf16*)(F.ws + WS_KT); const bf16* KtT = (const bf16*)(F.ws + WS_KTT); const bf16* vT = (const bf16*)(F.ws + WS_VT);
      const bf16* LS = (const bf16*)(F.ws + WS_LS); const float* aux = (const float*)(F.ws + WS_AUX);
      for (size_t i = (size_t)blockIdx.x * 512 + F.tid; i < (size_t)SEQ * DM; i += (size_t)F.G * 512) { const size_t t = i >> 10; const int c = (int)(i & 1023);
        float v;
        if (c < 256) v = bf2f(Qt[t * 256 + c]) + bf2f(Qt[((size_t)ROWS + t) * 256 + c]);
        else if (c < 512) v = bf2f(Kt[t * 256 + c - 256]) + bf2f(Kt[((size_t)ROWS + t) * 256 + c - 256]);
        else if (c < 768) v = bf2f(KtT[i]) + bf2f(vT[i >> 1]);
        else v = bf2f(LS[i]) + bf2f(LS[i + (size_t)SEQ * DM]) + aux[i % (3 * AUX_N)];
        F.out[i] = v; } }
    return;
#endif
    if (PH(9)) gla_pass_s(F);
    if (PH(10)) for (int u = F.vcu; u < 512; u += F.G) {
        const int h = (u & 255) >> 5, qb = (u & 31) + 32 * (u >> 8);
        att::attn_unit((const bf16*)(F.ws + WS_Q) + (size_t)qb * 256 * QP + h * QH, (const bf16*)(F.ws + WS_KV) + h * KVH,
                       (bf16*)(F.ws + WS_MIX) + (size_t)qb * 256 * DM + h * 64, ROWS, (LAS char*)ring, qb * 256, (const f32x2*)(F.ws + WS_ROPE), F.wave);
    }
    GRID_BAR();
#if defined(STOPAT) && STOPAT == 9
    { const bf16* LS = (const bf16*)(F.ws + WS_LS);
      for (size_t i = (size_t)blockIdx.x * 512 + F.tid; i < (size_t)SEQ * DM; i += (size_t)F.G * 512) F.out[i] = bf2f(LS[i]); }
    return;
#endif
    if (PH(11)) for (int t = gw; t < 8 * (NCH - 4); t += NGW) { const int h = (t >> 1) & 3, cn = 4 + (t >> 3); if (t & 1) gla_pass_o<1>(F, h, cn); else gla_pass_o<0>(F, h, cn); }
    GRID_BAR();
#if defined(STOPAT) && STOPAT == 8
    { const bf16* mixp = (const bf16*)(F.ws + WS_MIX);
      for (size_t i = (size_t)blockIdx.x * 512 + F.tid; i < (size_t)SEQ * DM; i += (size_t)F.G * 512) F.out[i] = bf2f(mixp[i]); }
    return;
#endif
    if (PH(12)) { pg8::Gemm g{(const bf16*)(F.ws + WS_MIX), (const bf16*)(F.ws + WS_WOUT), SEQ, DM, DM, DM, DM}; pg8::StaticOrder S; S.init(SEQ, DM, F.G, (int)blockIdx.x);
      pg8::EpiF32 E{Y, DM};
      pg8::gemm_phase<pg8::EpiF32, true>(ring, g, S, E, F.wave); }
    GRID_BAR();
    if (PH(13)) for (int row = gw; row < SEQ; row += NGW) {
        float* hr = F.out + (size_t)row * DM;
        norm_row(F.lane, hr, Y + (size_t)row * DM, 1.0f, modl + 5 * DM, npost + DM, hr, npre + 2 * DM, modl + 6 * DM, modl + 7 * DM, hA + (size_t)row * DM);
    }
    GRID_BAR();
    if (PH(14)) { pg8::Gemm g{hA, (const bf16*)(F.ws + WS_W2IN), SEQ, 2 * DFF, DM, DM, DM}; pg8::StaticOrder S; S.init(SEQ, 2 * DFF, F.G, (int)blockIdx.x);
      pg8::EpiSwiGLU E{(bf16*)(F.ws + WS_ACT), DFF};
      pg8::gemm_phase<pg8::EpiSwiGLU, true>(ring, g, S, E, F.wave); }
    GRID_BAR();
#ifdef DIAG
    GRID_BAR();
    for (int row = gw; row < SEQ; row += NGW) { float* hr = F.out + (size_t)row * DM;
        for (int j = 0; j < 4; ++j) *((f32x4*)hr + F.lane + 64 * j) = (f32x4){0.f, 0.f, 0.f, 0.f}; }
    GRID_BAR();
    if (blockIdx.x == 0 && F.tid == 0) { unsigned* bw = (unsigned*)(F.ws + WS_CTL);
        const unsigned code = xb_ld(&bw[XB_CODE]), tmo = xb_ld(&bw[XB_TMO]);
        unsigned val = DIAG == 0 ? code : DIAG == 1 ? tmo : DIAG == 2 ? (unsigned)F.G : DIAG == 3 ? F.MISC[8] : F.MISC[9];
        F.out[(size_t)(gw) * DM] = 1.0e6f * (float)(val + 1u); }
    return;
#endif
    if (PH(15)) { pg8::Gemm g{(const bf16*)(F.ws + WS_ACT), (const bf16*)(F.ws + WS_W2OUT), SEQ, DM, DFF, DFF, DFF}; pg8::StaticOrder S; S.init(SEQ, DM, F.G, (int)blockIdx.x);
      pg8::EpiF32 E{Y, DM};
      pg8::gemm_phase<pg8::EpiF32, true>(ring, g, S, E, F.wave); }
    GRID_BAR();
    for (int row = gw; row < SEQ; row += NGW) {
        float* hr = F.out + (size_t)row * DM;
        norm_row(F.lane, hr, Y + (size_t)row * DM, 0.5f, modl + 8 * DM, npost + 2 * DM, hr, nullptr, nullptr, nullptr, nullptr);
    }
}

extern "C" void kernel_launch(void* const* d_in, const int* in_sizes, int n_in, void* d_out, int out_size, void* d_ws, size_t ws_size, hipStream_t stream) {
    static int grid = 0;
    if (grid == 0) {
        if (n_in != 23 || in_sizes[0] != SEQ * DM || out_size != SEQ * DM || ws_size < WS_END) {
            fprintf(stderr, "kernel_launch: unexpected shapes: n_in %d in0 %d out %d ws %zu\n", n_in, n_in > 0 ? in_sizes[0] : -1, out_size, ws_size); grid = -1; return; }
        int dev = 0, cus = 0, per_cu = 0;
        if (hipGetDevice(&dev) != hipSuccess || hipDeviceGetAttribute(&cus, hipDeviceAttributeMultiprocessorCount, dev) != hipSuccess) { fprintf(stderr, "kernel_launch: device query failed\n"); grid = -1; return; }
        if (hipFuncSetAttribute((const void*)fwd_megakernel, hipFuncAttributeMaxDynamicSharedMemorySize, LDS_BYTES) != hipSuccess) { fprintf(stderr, "kernel_launch: hipFuncSetAttribute failed\n"); grid = -1; return; }
        if (hipOccupancyMaxActiveBlocksPerMultiprocessor(&per_cu, (const void*)fwd_megakernel, NWAVES * 64, LDS_BYTES) != hipSuccess || per_cu < 1) {
            fprintf(stderr, "kernel_launch: occupancy query reports %d workgroups per CU\n", per_cu); (void)hipGetLastError(); grid = -1; return; }
        grid = cus;
    }
    if (grid < 0) return;
    if (hipMemsetAsync((char*)d_ws + WS_CTL, 0, CTL_ZERO_BYTES, stream) != hipSuccess) { fprintf(stderr, "kernel_launch: memset failed\n"); return; }
    Args a{};
    for (int i = 0; i < 23; ++i) a.in[i] = (const float*)d_in[i];
    a.out = (float*)d_out; a.ws = (unsigned char*)d_ws;
    hipLaunchKernelGGL(fwd_megakernel, dim3(grid), dim3(NWAVES * 64), LDS_BYTES, stream, a);
    const hipError_t le = hipPeekAtLastError();
    if (le != hipSuccess) fprintf(stderr, "kernel_launch: launch failed: %s\n", hipGetErrorName(le));
}
```

```cpp
#include <hip/hip_runtime.h>
#include <cstdio>
#include <cstdint>

#define GAS __attribute__((address_space(1)))
#define LAS __attribute__((address_space(3)))
typedef unsigned short bf16;
typedef short bf16x8 __attribute__((ext_vector_type(8)));
typedef short s16x4 __attribute__((ext_vector_type(4)));
typedef float f32x4 __attribute__((ext_vector_type(4)));
typedef float f32x2 __attribute__((ext_vector_type(2)));
typedef float f32x16 __attribute__((ext_vector_type(16)));
typedef unsigned u32x4 __attribute__((ext_vector_type(4)));
typedef unsigned u32x2 __attribute__((ext_vector_type(2)));

constexpr int DM = 1024, SEQ = 16384, CTX = 256, ROWS = SEQ + CTX, DFF = 2816, NMODV = 9 * DM;
constexpr int NCH = ROWS / 64;
constexpr float EPS = 1e-6f;
constexpr int KVP = 1280, KVH = 160;
constexpr int QP = 768, QH = 96;

constexpr size_t MiB = 1u << 20;
constexpr size_t WS_CTL = 0, CTL_ZERO_BYTES = 64 * 1024;
constexpr size_t WS_MOD = 1 * MiB;
constexpr size_t WS_ROPE = 1 * MiB + 128 * 1024;
constexpr size_t WS_W1IN = 2 * MiB;
constexpr size_t WS_W1OUT = WS_W1IN + 11 * MiB;
constexpr size_t WS_W2IN = WS_W1OUT + 5 * MiB + 512 * 1024;
constexpr size_t WS_W2OUT = WS_W2IN + 11 * MiB;
constexpr size_t WS_WIN = WS_W2OUT + 5 * MiB + 512 * 1024;
constexpr size_t WS_WQB = WS_WIN + 4 * MiB;
constexpr size_t WS_WKVB = WS_WQB + 384 * 1024;
constexpr size_t WS_WOUT = WS_WKVB + 512 * 1024;
constexpr size_t WS_A = 42 * MiB;
constexpr size_t WS_QN = WS_A;
constexpr size_t WS_KVN = WS_A + 8 * MiB;
constexpr size_t WS_MIX = WS_A;
constexpr size_t WS_B = WS_A + (size_t)ROWS * DM * 2;
constexpr size_t WS_ZQ = WS_B;
constexpr size_t WS_Z1F = WS_ZQ + (size_t)ROWS * 256 * 2;
constexpr size_t WS_Q = WS_B;
constexpr size_t WS_C = WS_Z1F + (size_t)ROWS * 256 * 4;
constexpr size_t WS_ZGQK = WS_C;
constexpr size_t WS_ZGV = WS_ZGQK + (size_t)ROWS * 512 * 2;
constexpr size_t WS_LS = WS_C;
constexpr size_t WS_ZGG = WS_ZGV + (size_t)ROWS * 512 * 2;
constexpr size_t WS_KV = WS_ZGG + (size_t)ROWS * 512 * 2;
constexpr size_t WS_QT = WS_KV + (size_t)ROWS * KVP * 2;
constexpr size_t WS_KT = WS_QT + (size_t)2 * ROWS * 256 * 2;
constexpr size_t WS_KTT = WS_KT + (size_t)2 * ROWS * 256 * 2;
constexpr size_t WS_VT = WS_KTT + (size_t)2 * ROWS * 256 * 2;
constexpr size_t WS_AUX = WS_VT + (size_t)ROWS * 512 * 2;
constexpr size_t AUX_N = (size_t)2 * NCH * 256;
constexpr size_t WS_AUX_END = WS_AUX + 3 * AUX_N * 4;
constexpr size_t WS_ACT = WS_B;
constexpr size_t WS_Y = 164 * MiB;
constexpr size_t WS_END = 256 * MiB;
static_assert(WS_WOUT + 2 * MiB <= WS_A, "weights");
static_assert(WS_KVN + (size_t)ROWS * 256 * 2 <= WS_B, "qn/kvn in A");
static_assert(WS_Q + (size_t)SEQ * QP * 2 <= WS_C, "Q in B");
static_assert(WS_LS + (size_t)8 * NCH * 8192 * 2 <= WS_ZGG, "LS in C");
static_assert(WS_AUX_END <= WS_END, "aux");
static_assert(WS_ACT + (size_t)ROWS * DFF * 2 <= WS_Y && WS_Y + (size_t)ROWS * DM * 4 <= WS_END, "ffn map");
static_assert(WS_MIX + (size_t)SEQ * DM * 2 <= WS_Y, "mix below y");

typedef __bf16 bf16x2_t __attribute__((ext_vector_type(2)));
__device__ __forceinline__ unsigned cvt_pk_bf16(float lo, float hi) { f32x2 v = {lo, hi}; bf16x2_t b = __builtin_convertvector(v, bf16x2_t); return __builtin_bit_cast(unsigned, b); }
__device__ __forceinline__ unsigned f2bf(float f) { unsigned u = __builtin_bit_cast(unsigned, f); return (u + 0x7fffu + ((u >> 16) & 1u)) >> 16; }
__device__ __forceinline__ float bf2f(unsigned short b) { return __builtin_bit_cast(float, (unsigned)b << 16); }
__device__ __forceinline__ float bflo(unsigned w) { return __builtin_bit_cast(float, w << 16); }
__device__ __forceinline__ float bfhi(unsigned w) { return __builtin_bit_cast(float, w & 0xffff0000u); }
__device__ __forceinline__ float fast_silu(float a) { return a * __builtin_amdgcn_rcpf(1.0f + __builtin_amdgcn_exp2f(-a * 1.4426950408889634f)); }
template <int M> __device__ __forceinline__ float swz_xor(float v) { return __builtin_bit_cast(float, __builtin_amdgcn_ds_swizzle(__builtin_bit_cast(int, v), (M << 10) | 0x1f)); }
__device__ __forceinline__ float half_sum(float v) {
    v += swz_xor<1>(v); v += swz_xor<2>(v); v += swz_xor<4>(v); v += swz_xor<8>(v); v += swz_xor<16>(v); return v;
}
__device__ __forceinline__ float wave_sum(float v) {
    v = half_sum(v);
    auto rr = __builtin_amdgcn_permlane32_swap(__float_as_uint(v), __float_as_uint(v), false, false);
    return __uint_as_float(rr[0]) + __uint_as_float(rr[1]);
}
__device__ __forceinline__ int lane_id_opaque() { int l; asm volatile("v_mbcnt_lo_u32_b32 %0, -1, 0\n\tv_mbcnt_hi_u32_b32 %0, -1, %0" : "=v"(l)); return l; }
#define LDS_WAIT() asm volatile("s_waitcnt lgkmcnt(0)" ::: "memory")
#define VM_WAIT() asm volatile("s_waitcnt vmcnt(0)" ::: "memory")

namespace pg8 {
typedef unsigned short bf16_t;
constexpr int BM = 256, BK = 64, HALF = 128, HTB = HALF * BK * 2, STAGE_BYTES = 8 * HTB, NXCD = 8, WGM = 8;
__host__ __device__ __forceinline__ int lds_byte(int r, int c) { const int st = (r >> 4) * 2 + (c >> 5), rr = r & 15, cc = c & 31, ob = rr * 64 + cc * 2; return st * 1024 + (ob ^ (((ob >> 9) & 1) << 5)); }
__host__ __device__ __forceinline__ void stage_rc(int b, int& R, int& C) { const int st = b / 1024, sb = b % 1024, swz = sb ^ (((sb >> 9) & 1) << 5); R = (st >> 1) * 16 + swz / 64; C = (st & 1) * 32 + (swz % 64) / 2; }

struct Unit { int pm, pn; };
struct Gemm { const bf16_t* A; const bf16_t* Bt; int M, N, K, lda, ldb; };

struct StaticOrder {
    int nM, nN, nwg, G, c;
    __host__ __device__ void init(int M, int N, int G_, int c_) { nM = M / BM; nN = N / BM; nwg = nM * nN; G = G_; c = c_; }
    __host__ __device__ bool next(int i, Unit& u) const {
        const long L = (long)i * G + c; if (L >= nwg) return false;
        int wgid = (int)L; { const int q = nwg / NXCD, r = nwg % NXCD, xcd = wgid % NXCD, off = wgid / NXCD; wgid = (xcd < r ? xcd * (q + 1) : r * (q + 1) + (xcd - r) * q) + off; }
        const int nig = WGM * nN, gid = wgid / nig, fm = gid * WGM, gsz = (nM - fm) < WGM ? (nM - fm) : WGM;
        u.pm = fm + ((wgid % nig) % gsz); u.pn = (wgid % nig) / gsz; return true;
    }
};

typedef f32x4 Acc[2][2][4][2];

struct EpiF32 {
    float* C; int ldc;
    __device__ __forceinline__ void operator()(const Acc& acc, const Unit& u, int wr, int wc, int fr, int fq) const {
        const int row0 = u.pm * BM + wr * 64 + fr, col0 = u.pn * BM + wc * 32 + 4 * fq;
#pragma unroll
        for (int ai = 0; ai < 2; ++ai)
#pragma unroll
            for (int m = 0; m < 4; ++m) { float* rowp = C + (size_t)(row0 + ai * HALF + m * 16) * ldc + col0;
#pragma unroll
                for (int bj = 0; bj < 2; ++bj)
#pragma unroll
                    for (int n = 0; n < 2; ++n) *(f32x4*)(rowp + bj * HALF + n * 16) = acc[ai][bj][m][n]; }
    }
};
struct EpiSwiGLU {
    bf16_t* O; int ldo;
    __device__ __forceinline__ void operator()(const Acc& acc, const Unit& u, int wr, int wc, int fr, int fq) const {
        const int row0 = u.pm * BM + wr * 64 + fr, col0 = u.pn * HALF + wc * 32 + 4 * fq;
#pragma unroll
        for (int ai = 0; ai < 2; ++ai)
#pragma unroll
            for (int m = 0; m < 4; ++m) { bf16_t* rowp = O + (size_t)(row0 + ai * HALF + m * 16) * ldo + col0;
#pragma unroll
                for (int n = 0; n < 2; ++n) { const f32x4 a = acc[ai][0][m][n], b = acc[ai][1][m][n];
                    u32x2 w; w.x = cvt_pk_bf16(fast_silu(a[0]) * b[0], fast_silu(a[1]) * b[1]); w.y = cvt_pk_bf16(fast_silu(a[2]) * b[2], fast_silu(a[3]) * b[3]);
                    *(u32x2*)(rowp + n * 16) = w; } }
    }
};
struct EpiZ {
    bf16_t *Zq, *Zgqk, *Zgv, *Zgg; float* Z1f;
    __device__ __forceinline__ void operator()(const Acc& acc, const Unit& u, int wr, int wc, int fr, int fq) const {
        const int row0 = u.pm * BM + wr * 64 + fr, cl = wc * 32 + 4 * fq, pn = u.pn;
        if (pn == 1) {
#pragma unroll
            for (int ai = 0; ai < 2; ++ai)
#pragma unroll
                for (int m = 0; m < 4; ++m) { float* rowp = Z1f + (size_t)(row0 + ai * HALF + m * 16) * 256 + cl;
#pragma unroll
                    for (int bj = 0; bj < 2; ++bj)
#pragma unroll
                        for (int n = 0; n < 2; ++n) *(f32x4*)(rowp + bj * HALF + n * 16) = acc[ai][bj][m][n]; }
        } else {
            bf16_t* base; int ld, cb;
            if (pn == 0) { base = Zq; ld = 256; cb = 0; }
            else if (pn < 4) { base = Zgqk; ld = 512; cb = (pn - 2) * 256; }
            else if (pn < 6) { base = Zgv; ld = 512; cb = (pn - 4) * 256; }
            else { base = Zgg; ld = 512; cb = (pn - 6) * 256; }
#pragma unroll
            for (int ai = 0; ai < 2; ++ai)
#pragma unroll
                for (int m = 0; m < 4; ++m) { bf16_t* rowp = base + (size_t)(row0 + ai * HALF + m * 16) * ld + cb + cl;
#pragma unroll
                    for (int bj = 0; bj < 2; ++bj)
#pragma unroll
                        for (int n = 0; n < 2; ++n) { const f32x4 v = acc[ai][bj][m][n]; u32x2 w; w.x = cvt_pk_bf16(v[0], v[1]); w.y = cvt_pk_bf16(v[2], v[3]);
                            *(u32x2*)(rowp + bj * HALF + n * 16) = w; } }
        }
    }
};
struct EpiQ {
    bf16_t* Q;
    __device__ __forceinline__ void operator()(const Acc& acc, const Unit& u, int wr, int wc, int fr, int fq) const {
        const int row0 = u.pm * BM + wr * 64 + fr, col0 = u.pn * BM + wc * 32 + 4 * fq;
#pragma unroll
        for (int ai = 0; ai < 2; ++ai)
#pragma unroll
            for (int m = 0; m < 4; ++m) { bf16_t* rowp = Q + (size_t)(row0 + ai * HALF + m * 16) * QP + col0;
#pragma unroll
                for (int bj = 0; bj < 2; ++bj)
#pragma unroll
                    for (int n = 0; n < 2; ++n) { const f32x4 v = acc[ai][bj][m][n]; u32x2 w; w.x = cvt_pk_bf16(v[0], v[1]); w.y = cvt_pk_bf16(v[2], v[3]);
                        *(u32x2*)(rowp + bj * HALF + n * 16) = w; } }
    }
};
struct EpiKV {
    bf16_t* KV;
    __device__ __forceinline__ void operator()(const Acc& acc, const Unit& u, int wr, int wc, int fr, int fq) const {
        const int row0 = u.pm * BM + wr * 64 + fr, col0 = u.pn * BM + wc * 32 + 4 * fq;
#pragma unroll
        for (int bj = 0; bj < 2; ++bj)
#pragma unroll
            for (int n = 0; n < 2; ++n) { const int c = col0 + bj * HALF + n * 16, h = c >> 7, part = (c >> 6) & 1, idx = c & 63, dc = h * KVH + (part ? 96 + idx : idx);
#pragma unroll
                for (int ai = 0; ai < 2; ++ai)
#pragma unroll
                    for (int m = 0; m < 4; ++m) { const int t = row0 + ai * HALF + m * 16; const f32x4 v = acc[ai][bj][m][n];
                        u32x2 w; w.x = cvt_pk_bf16(v[0], v[1]); w.y = cvt_pk_bf16(v[2], v[3]);
                        *(u32x2*)(KV + (size_t)t * KVP + dc) = w; } }
    }
};

template <class Epi, bool ALIGN_EPI>
__device__ __forceinline__ void gemm_phase(LAS unsigned char* lds, const Gemm g, const StaticOrder& S, const Epi& E, int wave) {
    const int wid = wave, lane = lane_id_opaque(), tid = wid * 64 + lane, wr = wid >> 2, wc = wid & 3, fr = lane & 15, fq = lane >> 4;
    const int K = g.K, nt = K / BK;
    unsigned voffA[2], voffB[2];
#pragma unroll
    for (int i = 0; i < 2; ++i) { int R, C; stage_rc(tid * 16 + i * 8192, R, C);
        voffA[i] = (unsigned)(R * g.lda + C) * 2u; voffB[i] = (unsigned)(R * g.ldb + C) * 2u; }
    const size_t kstep = (size_t)(BK * 2);
    const size_t hstepA = (size_t)HALF * g.lda * 2, hstepB = (size_t)HALF * g.ldb * 2;
    const size_t tstepA = 2 * hstepA, tstepB = 2 * hstepB;
    const unsigned ldsw = (unsigned)wid * 1024u;
    const int aoff = lds_byte(wr * 64 + fr, fq * 8), boff = lds_byte(wc * 32 + fr, fq * 8);
#define PG8_SA(b, h) (((b) * 2 + (h)) * HTB)
#define PG8_SB(b, h) ((4 + (b) * 2 + (h)) * HTB)
#define PG8_STAGE(bufoff, gbase, voff) do { _Pragma("unroll") for (int _i = 0; _i < 2; ++_i) \
        __builtin_amdgcn_global_load_lds((const unsigned*)((const char*)(gbase) + (voff)[_i]), (LAS unsigned*)(lds + (bufoff) + ldsw + _i * 8192), 16, 0, 0); } while (0)
#define PG8_LDA(dst, b, h) do { _Pragma("unroll") for (int m = 0; m < 4; ++m) _Pragma("unroll") for (int k = 0; k < 2; ++k) dst[m][k] = *(const LAS bf16x8*)(lds + PG8_SA(b, h) + aoff + m * 2048 + k * 1024); } while (0)
#define PG8_LDB(dst, b, h) do { _Pragma("unroll") for (int n = 0; n < 2; ++n) _Pragma("unroll") for (int k = 0; k < 2; ++k) dst[n][k] = *(const LAS bf16x8*)(lds + PG8_SB(b, h) + boff + n * 2048 + k * 1024); } while (0)
#define PG8_MMA(ai, bj, At, Bt) do { __builtin_amdgcn_s_setprio(1); _Pragma("unroll") for (int m = 0; m < 4; ++m) _Pragma("unroll") for (int n = 0; n < 2; ++n) _Pragma("unroll") for (int k = 0; k < 2; ++k) \
        acc[ai][bj][m][n] = __builtin_amdgcn_mfma_f32_16x16x32_bf16(Bt[n][k], At[m][k], acc[ai][bj][m][n], 0, 0, 0); __builtin_amdgcn_s_setprio(0); } while (0)
#define PG8_WAIT_V(n) asm volatile("s_waitcnt vmcnt(" #n ")" ::: "memory")
#define PG8_WAIT_L(n) asm volatile("s_waitcnt lgkmcnt(" #n ")" ::: "memory")
#define PG8_BAR __builtin_amdgcn_s_barrier()
#define PG8_SCHED __builtin_amdgcn_sched_barrier(0)
    Unit cur, nxt; int ui = 0;
    if (!S.next(0, cur)) return;
    Acc acc;
#pragma unroll
    for (int a = 0; a < 2; ++a)
#pragma unroll
        for (int b = 0; b < 2; ++b)
#pragma unroll
            for (int m = 0; m < 4; ++m)
#pragma unroll
                for (int n = 0; n < 2; ++n) acc[a][b][m][n] = (f32x4){0.f, 0.f, 0.f, 0.f};
    bf16x8 At[4][2], B0[2][2], B1[2][2];
    const char* cA = (const char*)g.A + (size_t)cur.pm * tstepA; const char* cB = (const char*)g.Bt + (size_t)cur.pn * tstepB;
    PG8_STAGE(PG8_SB(0, 0), cB, voffB); PG8_STAGE(PG8_SB(0, 1), cB + hstepB, voffB); PG8_STAGE(PG8_SA(0, 0), cA, voffA); PG8_STAGE(PG8_SA(0, 1), cA + hstepA, voffA);
    if (wr == 1) PG8_BAR;
    PG8_WAIT_V(2); PG8_BAR;
    PG8_STAGE(PG8_SB(1, 0), cB + kstep, voffB); PG8_STAGE(PG8_SA(1, 0), cA + kstep, voffA); PG8_STAGE(PG8_SB(1, 1), cB + hstepB + kstep, voffB);
    PG8_WAIT_V(6); PG8_BAR;
    for (;;) {
        const bool has_next = S.next(ui + 1, nxt);
        const char* nA = has_next ? (const char*)g.A + (size_t)nxt.pm * tstepA : cA; const char* nB = has_next ? (const char*)g.Bt + (size_t)nxt.pn * tstepB : cB;
        for (int t = 0; t < nt; t += 2) {
            const bool last = (t == nt - 2);
            const char* a1 = cA + (size_t)(t + 1) * kstep;
            const char* a2 = last ? nA : cA + (size_t)(t + 2) * kstep; const char* b2 = last ? nB : cB + (size_t)(t + 2) * kstep;
            const char* a3 = a2 + kstep; const char* b3 = b2 + kstep;
            PG8_LDB(B0, 0, 0); PG8_LDB(B1, 0, 1); PG8_SCHED; PG8_LDA(At, 0, 0); PG8_STAGE(PG8_SA(1, 1), a1 + hstepA, voffA);
            PG8_WAIT_V(8); PG8_WAIT_L(0); PG8_BAR; PG8_MMA(0, 0, At, B0); PG8_MMA(0, 1, At, B1); PG8_BAR; PG8_SCHED;
            PG8_LDA(At, 0, 1); PG8_STAGE(PG8_SB(0, 0), b2, voffB); PG8_STAGE(PG8_SB(0, 1), b2 + hstepB, voffB); PG8_STAGE(PG8_SA(0, 0), a2, voffA);
            PG8_WAIT_V(8); PG8_WAIT_L(0); PG8_BAR; PG8_MMA(1, 0, At, B0); PG8_MMA(1, 1, At, B1); PG8_BAR; PG8_SCHED;
            PG8_LDB(B0, 1, 0); PG8_LDB(B1, 1, 1); PG8_SCHED; PG8_LDA(At, 1, 0); PG8_STAGE(PG8_SA(0, 1), a2 + hstepA, voffA);
            PG8_WAIT_V(8); PG8_WAIT_L(0); PG8_BAR; PG8_MMA(0, 0, At, B0); PG8_MMA(0, 1, At, B1); PG8_BAR; PG8_SCHED;
            PG8_LDA(At, 1, 1); PG8_STAGE(PG8_SB(1, 0), b3, voffB); PG8_STAGE(PG8_SB(1, 1), b3 + hstepB, voffB); PG8_STAGE(PG8_SA(1, 0), a3, voffA);
            PG8_WAIT_V(8); PG8_WAIT_L(0); PG8_BAR; PG8_MMA(1, 0, At, B0); PG8_MMA(1, 1, At, B1); PG8_BAR; PG8_SCHED;
        }
        if constexpr (ALIGN_EPI) { if (wr == 0) PG8_BAR; }
        { const int l2 = lane_id_opaque(); E(acc, cur, wr, wc, l2 & 15, l2 >> 4); }
        if (!has_next) break;
#pragma unroll
        for (int a = 0; a < 2; ++a)
#pragma unroll
            for (int b = 0; b < 2; ++b)
#pragma unroll
                for (int m = 0; m < 4; ++m)
#pragma unroll
                    for (int n = 0; n < 2; ++n) acc[a][b][m][n] = (f32x4){0.f, 0.f, 0.f, 0.f};
        cur = nxt; cA = nA; cB = nB; ++ui;
        if constexpr (ALIGN_EPI) { if (wr == 1) PG8_BAR; }
    }
    PG8_WAIT_V(0);
    if constexpr (!ALIGN_EPI) { if (wr == 0) PG8_BAR; }
    PG8_BAR;
#undef PG8_SA
#undef PG8_SB
#undef PG8_STAGE
#undef PG8_LDA
#undef PG8_LDB
#undef PG8_MMA
#undef PG8_WAIT_V
#undef PG8_WAIT_L
#undef PG8_BAR
#undef PG8_SCHED
}
}

namespace att {
constexpr int NW = 8, QBLK = 32, KVBLK = 64;
constexpr float SCALE = 0.10206207261596575f;
constexpr float THR = 8.f;
constexpr int SHM_V = 16384, SHM_K = 16384, SHM_ATTN = 2 * SHM_V + 2 * SHM_K + NW * 64 * 4;
#define KSWZ(row, colB) ((row) * 256 + ((colB) ^ (((row) & 7) << 4)))
#define SBAR() __builtin_amdgcn_sched_barrier(0)
__device__ __forceinline__ int crow(int r, int hi) { return (r & 3) + 8 * (r >> 2) + 4 * hi; }

__device__ __forceinline__ void partialSM(f32x16& p0, f32x16& p1, float& m_reg, float& mn, float& alpha) {
  constexpr float C = SCALE * 1.4426950408889634f;
  float pmax = p0[0];
#pragma unroll
  for (int r = 1; r < 16; ++r) pmax = fmaxf(pmax, p0[r]);
#pragma unroll
  for (int r = 0; r < 16; ++r) pmax = fmaxf(pmax, p1[r]);
  { auto rr = __builtin_amdgcn_permlane32_swap(__float_as_uint(pmax), __float_as_uint(pmax), false, false);
    pmax = fmaxf(__uint_as_float(rr[0]), __uint_as_float(rr[1])); }
  if (__builtin_expect(__all(pmax - m_reg <= THR / SCALE), 1)) { mn = m_reg; alpha = 1.f; }
  else { mn = fmaxf(m_reg, pmax); alpha = __builtin_amdgcn_exp2f((m_reg - mn) * C); m_reg = mn; }
  float mnC = -mn * C;
#pragma unroll
  for (int r = 0; r < 16; ++r) p0[r] = fmaf(p0[r], C, mnC);
#pragma unroll
  for (int r = 0; r < 16; ++r) p1[r] = fmaf(p1[r], C, mnC);
#pragma unroll
  for (int r = 0; r < 16; ++r) p0[r] = __builtin_amdgcn_exp2f(p0[r]);
}
__device__ __forceinline__ void finishSM(f32x16& p0, f32x16& p1, float alpha, float& l_reg, bf16x8& pa0, bf16x8& pa1, bf16x8& pa2, bf16x8& pa3) {
#pragma unroll
  for (int r = 0; r < 16; ++r) p1[r] = __builtin_amdgcn_exp2f(p1[r]);
  float ps = 0;
#pragma unroll
  for (int r = 0; r < 16; ++r) ps += p0[r];
#pragma unroll
  for (int r = 0; r < 16; ++r) ps += p1[r];
  { auto rr = __builtin_amdgcn_permlane32_swap(__float_as_uint(ps), __float_as_uint(ps), false, false);
    ps = __uint_as_float(rr[0]) + __uint_as_float(rr[1]); }
  l_reg = l_reg * alpha + ps;
#define PK4(P, BASE, OUT) do { unsigned a0 = cvt_pk_bf16(P[BASE + 0], P[BASE + 1]), a1 = cvt_pk_bf16(P[BASE + 2], P[BASE + 3]);   \
    unsigned b0 = cvt_pk_bf16(P[BASE + 4], P[BASE + 5]), b1 = cvt_pk_bf16(P[BASE + 6], P[BASE + 7]);                              \
    auto r0 = __builtin_amdgcn_permlane32_swap(a0, b0, false, false); auto r1 = __builtin_amdgcn_permlane32_swap(a1, b1, false, false); \
    u32x4 w = {r0[0], r1[0], r0[1], r1[1]}; OUT = __builtin_bit_cast(bf16x8, w); } while (0)
  PK4(p0, 0, pa0); PK4(p0, 8, pa1); PK4(p1, 0, pa2); PK4(p1, 8, pa3);
#undef PK4
}
__device__ __forceinline__ void qkt(f32x16& p0, f32x16& p1, const LAS char* Ks, const bf16x8* qr, int r32, int hi) {
  p0 = f32x16{}; p1 = f32x16{};
#pragma unroll
  for (int d0 = 0; d0 < 6; ++d0) { int cb = (d0 * 16 + hi * 8) * 2;
    bf16x8 b0 = *reinterpret_cast<const LAS bf16x8*>(Ks + KSWZ(r32, cb));
    bf16x8 b1 = *reinterpret_cast<const LAS bf16x8*>(Ks + KSWZ(32 + r32, cb));
    p0 = __builtin_amdgcn_mfma_f32_32x32x16_bf16(b0, qr[d0], p0, 0, 0, 0);
    p1 = __builtin_amdgcn_mfma_f32_32x32x16_bf16(b1, qr[d0], p1, 0, 0, 0); }
}
__device__ __forceinline__ int v_st(int k, int c) { const int kk = (k & ~0xC) | ((k & 4) << 1) | ((k & 8) >> 1); return ((kk >> 3) * 4 + (c >> 5)) * 512 + ((kk & 7) * 32 + (c & 31)) * 2; }
__device__ __forceinline__ int v_rd_base(int lane) { return ((lane & 3) << 3) | (((lane >> 2) & 3) << 6) | (((lane >> 4) & 1) << 5) | (((lane >> 5) & 1) << 8); }
constexpr int v_rd_off(int d0, int ks, int half) { return d0 * 512 + ks * 4096 + half * 2048; }
template <int OFF> __device__ __forceinline__ s16x4 tr_read(int vb) {
  s16x4 r; asm volatile("ds_read_b64_tr_b16 %0, %1 offset:%2" : "=&v"(r) : "v"(vb), "i"(OFF) : "memory"); return r;
}
template <int D0> __device__ __forceinline__ void pv_one(f32x16& od, int vb, bf16x8 pa0, bf16x8 pa1, bf16x8 pa2, bf16x8 pa3) {
  const s16x4 l0 = tr_read<v_rd_off(D0, 0, 0)>(vb), h0 = tr_read<v_rd_off(D0, 0, 1)>(vb), l1 = tr_read<v_rd_off(D0, 1, 0)>(vb), h1 = tr_read<v_rd_off(D0, 1, 1)>(vb);
  const s16x4 l2 = tr_read<v_rd_off(D0, 2, 0)>(vb), h2 = tr_read<v_rd_off(D0, 2, 1)>(vb), l3 = tr_read<v_rd_off(D0, 3, 0)>(vb), h3 = tr_read<v_rd_off(D0, 3, 1)>(vb);
  asm volatile("s_waitcnt lgkmcnt(0)" ::: "memory"); SBAR();
#define PK(L, H) (bf16x8){L[0], L[1], L[2], L[3], H[0], H[1], H[2], H[3]}
  od = __builtin_amdgcn_mfma_f32_32x32x16_bf16(pa0, PK(l0, h0), od, 0, 0, 0);
  od = __builtin_amdgcn_mfma_f32_32x32x16_bf16(pa1, PK(l1, h1), od, 0, 0, 0);
  od = __builtin_amdgcn_mfma_f32_32x32x16_bf16(pa2, PK(l2, h2), od, 0, 0, 0);
  od = __builtin_amdgcn_mfma_f32_32x32x16_bf16(pa3, PK(l3, h3), od, 0, 0, 0);
#undef PK
}
__device__ __forceinline__ void pv_d0(f32x16* o, int vb, bf16x8 pa0, bf16x8 pa1, bf16x8 pa2, bf16x8 pa3) {
  pv_one<0>(o[0], vb, pa0, pa1, pa2, pa3); pv_one<1>(o[1], vb, pa0, pa1, pa2, pa3);
}

__device__ __forceinline__ void attn_unit(const bf16* __restrict__ Qb, const bf16* __restrict__ KVh, bf16* __restrict__ Ob, int seq, LAS char* lds, int t0, const f32x2* __restrict__ tab, int wave) {
  const int wid = wave, lane = lane_id_opaque(), tid = wid * 64 + lane, r32 = lane & 31, hi = lane >> 5;
  LAS char* V_lds = lds; LAS char* K_lds = lds + 2 * SHM_V;
  LAS float* ws = (LAS float*)(lds + 2 * SHM_V + 2 * SHM_K) + wid * 64; LAS float* li_l = ws; LAS float* al_l = ws + 32;
  float m_reg = -1e30f, l_reg = 0; f32x16 o[2] = {}; bf16x8 qr[6];
  const bf16* Qw = Qb + (long)(wid * QBLK + r32) * QP + hi * 8;
#pragma unroll
  for (int d0 = 0; d0 < 6; ++d0) qr[d0] = *reinterpret_cast<const bf16x8*>(Qw + d0 * 16);
  {
    const int t = t0 + wid * QBLK + r32;
#pragma unroll
    for (int a = 0; a < 2; ++a) { const int pos = a ? (t & 63) : (t >> 6); const u32x4 w = __builtin_bit_cast(u32x4, qr[4 + a]); u32x4 o;
#pragma unroll
      for (int p = 0; p < 4; ++p) { const f32x2 cs = tab[pos * 8 + 4 * hi + p]; const float x1 = bflo(w[p]), x2 = bfhi(w[p]);
        o[p] = cvt_pk_bf16(x1 * cs.x - x2 * cs.y, x2 * cs.x + x1 * cs.y); }
      qr[4 + a] = __builtin_bit_cast(bf16x8, o); } }
  int goff[3], loff[3];
#pragma unroll
  for (int i = 0; i < 3; ++i) { int q = tid + 512 * i; if (q >= 1280) q -= 1280; const int key = q / 20, cc = q % 20;
    goff[i] = key * KVP + cc * 8;
    loff[i] = cc < 12 ? (2 * SHM_V + KSWZ(key, cc * 16)) : v_st(key, (cc - 12) * 8); }
  const bool w3 = tid < 256;
  const int vb0 = (int)(uintptr_t)V_lds + v_rd_base(lane);
  struct { bf16x8 c[3]; } sr_[2];
#define SLOAD(i, k0) do { _Pragma("unroll") for (int _j = 0; _j < 3; ++_j) sr_[i].c[_j] = *reinterpret_cast<const bf16x8*>(KVh + (long)(k0) * KVP + goff[_j]); } while (0)
#define SWRITE(b, i) do { *(LAS bf16x8*)(lds + (b) * SHM_V + loff[0]) = sr_[i].c[0]; *(LAS bf16x8*)(lds + (b) * SHM_V + loff[1]) = sr_[i].c[1]; \
    if (w3) *(LAS bf16x8*)(lds + (b) * SHM_V + loff[2]) = sr_[i].c[2]; } while (0)
#define SWAIT() asm volatile("s_waitcnt vmcnt(3)" ::: "memory")
#define RESC(a) do { if (__any((a) < 1.f)) { if (hi == 0) al_l[r32] = (a); asm volatile("s_waitcnt lgkmcnt(0)" ::: "memory"); \
    _Pragma("unroll") for (int d = 0; d < 2; ++d) _Pragma("unroll") for (int r = 0; r < 16; ++r) o[d][r] *= al_l[crow(r, hi)]; } } while (0)
  f32x16 pA0, pA1, pB0, pB1; float mnA, mnB, alA, alB; bf16x8 pa0, pa1, pa2, pa3; const int NT = seq / KVBLK;
  constexpr int SE = 0, SO = 1;
  SLOAD(SE, 0); asm volatile("s_waitcnt vmcnt(0)" ::: "memory"); SWRITE(0, SE); __syncthreads();
  qkt(pA0, pA1, K_lds, qr, r32, hi); partialSM(pA0, pA1, m_reg, mnA, alA);
  SLOAD(SO, KVBLK); if (2 < NT) SLOAD(SE, 2 * KVBLK);
  SWAIT(); SWRITE(1, SO); __syncthreads();
  for (int j = 1; j + 1 < NT; j += 2) {
    SBAR(); qkt(pB0, pB1, K_lds + SHM_K, qr, r32, hi);
    finishSM(pA0, pA1, alA, l_reg, pa0, pa1, pa2, pa3); SBAR();
    SLOAD(SO, (j + 2) * KVBLK); SBAR();
    pv_d0(o, vb0, pa0, pa1, pa2, pa3); partialSM(pB0, pB1, m_reg, mnB, alB);
    __syncthreads(); SWAIT(); SWRITE(0, SE);
    RESC(alB); __syncthreads();
    SBAR(); qkt(pA0, pA1, K_lds, qr, r32, hi);
    finishSM(pB0, pB1, alB, l_reg, pa0, pa1, pa2, pa3); SBAR();
    if (j + 3 < NT) SLOAD(SE, (j + 3) * KVBLK); SBAR();
    pv_d0(o, vb0 + SHM_V, pa0, pa1, pa2, pa3); partialSM(pA0, pA1, m_reg, mnA, alA);
    __syncthreads(); SWAIT(); SWRITE(1, SO);
    RESC(alA); __syncthreads();
  }
  SBAR(); qkt(pB0, pB1, K_lds + SHM_K, qr, r32, hi);
  finishSM(pA0, pA1, alA, l_reg, pa0, pa1, pa2, pa3); SBAR();
  pv_d0(o, vb0, pa0, pa1, pa2, pa3); partialSM(pB0, pB1, m_reg, mnB, alB);
  __syncthreads(); RESC(alB);
  finishSM(pB0, pB1, alB, l_reg, pa0, pa1, pa2, pa3); SBAR();
  pv_d0(o, vb0 + SHM_V, pa0, pa1, pa2, pa3);
  if (hi == 0) li_l[r32] = l_reg; asm volatile("s_waitcnt lgkmcnt(0)" ::: "memory");
  float rli[16];
#pragma unroll
  for (int r = 0; r < 16; ++r) rli[r] = __builtin_amdgcn_rcpf(li_l[crow(r, hi)]);
  bf16* Ow = Ob + (long)(wid * QBLK) * DM;
#pragma unroll
  for (int r = 0; r < 16; ++r) { int orow = crow(r, hi);
#pragma unroll
    for (int d0 = 0; d0 < 2; ++d0) Ow[(long)orow * DM + d0 * 32 + r32] = (bf16)f2bf(o[d0][r] * rli[r]); }
  __syncthreads();
#undef SLOAD
#undef SWRITE
#undef SWAIT
#undef RESC
}
}

typedef GAS unsigned gu32;
#define RLX_AGENT __ATOMIC_RELAXED, __HIP_MEMORY_SCOPE_AGENT
#define XB_TMO      128
#define XB_XCNT(j)  (256  + 64 * (j))
#define XB_XSUB(j)  (1280 + 64 * (j))
#define XB_XGEN(j)  (2304 + 64 * (j))
#define XB_TOP      3328
#define XB_TOPGEN   3392
#define XCD_BAR_WORDS 3456
#define XB_SPIN_CAP (1u << 21)
__device__ __forceinline__ unsigned xb_ld(unsigned* p)              { return __hip_atomic_load(p, __ATOMIC_RELAXED, __HIP_MEMORY_SCOPE_AGENT); }
__device__ __forceinline__ unsigned xb_add(unsigned* p, unsigned v) { return __hip_atomic_fetch_add(p, v, __ATOMIC_RELAXED, __HIP_MEMORY_SCOPE_AGENT); }
__device__ __forceinline__ unsigned xb_xcc_id() { return (unsigned)__builtin_amdgcn_s_getreg((3 << 11) | 20) & 0xFu; }
#define XB_CODE 192
#define XB_SPIN(cond, bar, code) do { unsigned _sp = 0; while (cond) { __builtin_amdgcn_s_sleep(1); \
    if ((++_sp & 255u) == 0u) { if (xb_ld(&(bar)[XB_TMO])) break; if (_sp > XB_SPIN_CAP) { atomicCAS(&(bar)[XB_CODE], 0u, (unsigned)(code)); atomicAdd(&(bar)[XB_TMO], 1u); break; } } } } while (0)
struct XcdBarrier { unsigned* bar; unsigned x; volatile LAS unsigned* st; };
__device__ __forceinline__ XcdBarrier xcd_barrier_post(unsigned* bar, volatile LAS unsigned* st, int tid) {
    XcdBarrier b; b.bar = bar; b.x = xb_xcc_id(); b.st = st;
    if (tid == 0) (void)xb_add(&bar[XB_XCNT(b.x)], 1u);
    return b;
}
__device__ __forceinline__ void xcd_barrier_complete(unsigned* bar, unsigned x, unsigned& nloc, unsigned& nx) {
    const unsigned G = gridDim.x * gridDim.y * gridDim.z;
    unsigned sum, cnt, mine, sp = 0u;
    for (;;) {
        sum = 0u; cnt = 0u; mine = 0u;
#pragma unroll
        for (unsigned j = 0; j < 16; ++j) { const unsigned c = xb_ld(&bar[XB_XCNT(j)]); sum += c; cnt += (c > 0u) ? 1u : 0u; mine = (j == x) ? c : mine; }
        if (sum == G) break;
        __builtin_amdgcn_s_sleep(1);
        if ((++sp & 255u) == 0u) { if (xb_ld(&bar[XB_TMO])) break; if (sp > XB_SPIN_CAP) { atomicCAS(&bar[XB_CODE], 0u, 1u); atomicAdd(&bar[XB_TMO], 1u); break; } }
    }
    nloc = mine > 0u ? mine : 1u; nx = cnt > 0u ? cnt : 1u;
}
__device__ __forceinline__ void xcd_barrier(const XcdBarrier& b, unsigned seq, int tid) {
    asm volatile("s_waitcnt vmcnt(0)" ::: "memory");
    __syncthreads();
    if (tid == 0) {
        unsigned* bar = b.bar;
        __builtin_amdgcn_s_waitcnt(0);
        unsigned nloc = b.st[0], nx = b.st[1];
        if (nloc == 0u) { xcd_barrier_complete(bar, b.x, nloc, nx); b.st[0] = nloc; b.st[1] = nx; }
        const unsigned old = xb_add(&bar[XB_XSUB(b.x)], 1u);
        const unsigned gen = old / nloc;
        if (old + 1u == (gen + 1u) * nloc) {
            __builtin_amdgcn_fence(__ATOMIC_RELEASE, "agent");
            asm volatile("s_waitcnt vmcnt(0)" ::: "memory");
            const unsigned og = xb_add(&bar[XB_TOP], 1u);
            const unsigned tg = og / nx;
            if (og + 1u == (tg + 1u) * nx) xb_add(&bar[XB_TOPGEN], 1u);
            else XB_SPIN(xb_ld(&bar[XB_TOPGEN]) == tg, bar, 10u * seq + 2u);
            __builtin_amdgcn_fence(__ATOMIC_ACQUIRE, "agent");
            xb_add(&bar[XB_XGEN(b.x)], 1u);
            asm volatile("s_waitcnt vmcnt(0)" ::: "memory");
        } else {
            XB_SPIN(xb_ld(&bar[XB_XGEN(b.x)]) == gen, bar, 10u * seq + 3u);
            __builtin_amdgcn_fence(__ATOMIC_ACQUIRE, "agent");
            asm volatile("s_waitcnt vmcnt(0)" ::: "memory");
        }
    }
    __syncthreads();
}

constexpr int NWAVES = 8;
constexpr int RING_OFF = 0, RING_BYTES = 131072;
constexpr int LDSCTL_OFF = RING_BYTES, MISC_OFF = LDSCTL_OFF + 320;
constexpr int LDS_BYTES = 147456;
static_assert(att::SHM_ATTN <= RING_BYTES, "attention LDS");

struct Frame {
    LAS unsigned char* lds;
    volatile LAS unsigned* MISC;
    int tid, lane, wave, vcu, G;
    const float* in[23]; float* out; unsigned char* ws;
};
enum { I_X = 0, I_C, I_CTX, I_CCTX, I_WADA, I_BADA, I_NPRE, I_NPOST, I_F1IN, I_F1OUT, I_F2IN, I_F2OUT, I_WIN, I_QNORM, I_WQB, I_KVNORM, I_WKVB,
       I_WAF, I_BAF, I_WAB, I_BAB, I_GNORM, I_WOUT };

template <class Map>
__device__ __forceinline__ void transpose_item(const float* W, int Ns, bf16* WT, int ldd, LAS float* scr, int k0, int n0, int lane, Map srcmap) {
    const int sc = srcmap(n0 + (lane & 31));
#pragma unroll 8
    for (int i = 0; i < 32; ++i) { const int kk = 2 * i + (lane >> 5); scr[kk * 33 + (lane & 31)] = sc >= 0 ? W[(size_t)(k0 + kk) * Ns + sc] : 0.f; }
    LDS_WAIT(); asm volatile("" ::: "memory");
    const int c = lane & 7;
#pragma unroll
    for (int j = 0; j < 4; ++j) { const int n = (lane >> 3) + 8 * j; const LAS float* s = scr + (8 * c) * 33 + n;
        u32x4 o; o.x = cvt_pk_bf16(s[0 * 33], s[1 * 33]); o.y = cvt_pk_bf16(s[2 * 33], s[3 * 33]); o.z = cvt_pk_bf16(s[4 * 33], s[5 * 33]); o.w = cvt_pk_bf16(s[6 * 33], s[7 * 33]);
        *(GAS u32x4*)(WT + (size_t)(n0 + n) * ldd + k0 + 8 * c) = o; }
    LDS_WAIT(); asm volatile("" ::: "memory");
}
struct MapId { __device__ int operator()(int n) const { return n; } };
struct MapFfnIn { __device__ int operator()(int n) const { const int pn = n >> 8, c = n & 255; return c < 128 ? 128 * pn + c : DFF + 128 * pn + (c - 128); } };
struct MapWin { __device__ int operator()(int n) const {
    if (n < 416) return n;
    if (n < 448) return 1952 + (n - 416);
    if (n < 512) return -1;
    if (n < 768) return 416 + (n - 512);
    if (n < 1024) return 672 + (n - 768);
    if (n < 1536) return 928 + (n - 1024);
    return 1440 + (n - 1536); } };
struct MapWqb { __device__ int operator()(int n) const { const int h = n / QH, j = n % QH; if (j < 64) return h * QH + j;
    const int jj = j - 64, i = jj >> 1, p = jj & 1, a = i >> 3, f = i & 7; return h * QH + 64 + 16 * a + 8 * p + f; } };

__device__ __forceinline__ void p0_prologue(Frame& F) {
    LAS float* scr = (LAS float*)(F.lds + RING_OFF + F.wave * 16384);
    const int gw = F.vcu * NWAVES + F.wave, NGW = F.G * NWAVES;
    for (int idx = F.vcu * 512 + F.tid; idx < 2048; idx += F.G * 512) {
        const int pos = idx >> 3, f = idx & 7;
        const float invf = f == 0 ? 1.0f : f == 1 ? 0.31622776601683794f : f == 2 ? 0.1f : f == 3 ? 0.031622776601683794f : f == 4 ? 0.01f : f == 5 ? 0.0031622776601683794f : f == 6 ? 0.001f : 0.00031622776601683794f;
        const float ang = (float)pos * invf;
        double t = (double)ang * 0.15915494309189535; t -= floor(t);
        const float tf = (float)t;
        f32x2 cs; cs.x = __builtin_amdgcn_cosf(tf); cs.y = __builtin_amdgcn_sinf(tf);
        ((f32x2*)(F.ws + WS_ROPE))[idx] = cs;
    }
    if (F.vcu < 144) {
        LAS float* sl = (LAS float*)(F.lds + 100 * 1024);
        LAS float* red = (LAS float*)(F.lds + 108 * 1024);
        for (int i = F.tid; i < 2048; i += 512) { const float v = i < 1024 ? F.in[I_C][i] : F.in[I_CCTX][i - 1024]; sl[i] = v / (1.0f + expf(-v)); }
        __syncthreads();
        for (int u = F.vcu; u < 144; u += F.G) {
            const int cq = F.tid & 15, kg = F.tid >> 4;
            const float* Wp = F.in[I_WADA] + (size_t)u * 64 + cq * 4;
            f32x4 al = {0.f, 0.f, 0.f, 0.f}, ac = {0.f, 0.f, 0.f, 0.f};
#pragma unroll 8
            for (int i = 0; i < 32; ++i) { const int k = kg + 32 * i; const f32x4 w = *(const f32x4*)(Wp + (size_t)k * NMODV); al += w * sl[k]; ac += w * sl[1024 + k]; }
            *(LAS f32x4*)(red + kg * 128 + cq * 4) = al; *(LAS f32x4*)(red + kg * 128 + 64 + cq * 4) = ac;
            __syncthreads();
            if (F.tid < 128) { float s = 0.f;
#pragma unroll
                for (int g = 0; g < 32; ++g) s += red[g * 128 + F.tid];
                const int ty = F.tid >> 6, col = u * 64 + (F.tid & 63);
                ((float*)(F.ws + WS_MOD))[ty * NMODV + col] = s + F.in[I_BADA][col]; }
            __syncthreads();
        }
    }
    constexpr int I_1IN = 16 * 176, I_1OUT = 44 * 32, I_WN = 16 * 64, I_QB = 4 * 24, I_KVB = 2 * 32, I_OUT = 16 * 32;
    constexpr int NITEMS = 2 * I_1IN + 2 * I_1OUT + I_WN + I_QB + I_KVB + I_OUT;
    for (int it = gw; it < NITEMS; it += NGW) {
        int r = it;
        if (r < I_1IN) { transpose_item(F.in[I_F1IN], 2 * DFF, (bf16*)(F.ws + WS_W1IN), DM, scr, 64 * (r / 176), 32 * (r % 176), F.lane, MapFfnIn()); continue; } r -= I_1IN;
        if (r < I_1IN) { transpose_item(F.in[I_F2IN], 2 * DFF, (bf16*)(F.ws + WS_W2IN), DM, scr, 64 * (r / 176), 32 * (r % 176), F.lane, MapFfnIn()); continue; } r -= I_1IN;
        if (r < I_1OUT) { transpose_item(F.in[I_F1OUT], DM, (bf16*)(F.ws + WS_W1OUT), DFF, scr, 64 * (r / 32), 32 * (r % 32), F.lane, MapId()); continue; } r -= I_1OUT;
        if (r < I_1OUT) { transpose_item(F.in[I_F2OUT], DM, (bf16*)(F.ws + WS_W2OUT), DFF, scr, 64 * (r / 32), 32 * (r % 32), F.lane, MapId()); continue; } r -= I_1OUT;
        if (r < I_WN) { transpose_item(F.in[I_WIN], 1984, (bf16*)(F.ws + WS_WIN), DM, scr, 64 * (r / 64), 32 * (r % 64), F.lane, MapWin()); continue; } r -= I_WN;
        if (r < I_QB) { transpose_item(F.in[I_WQB], QP, (bf16*)(F.ws + WS_WQB), 256, scr, 64 * (r / 24), 32 * (r % 24), F.lane, MapWqb()); continue; } r -= I_QB;
        if (r < I_KVB) { transpose_item(F.in[I_WKVB], 1024, (bf16*)(F.ws + WS_WKVB), 256, scr, 64 * (r / 32), 32 * (r % 32), F.lane, MapId()); continue; } r -= I_KVB;
        transpose_item(F.in[I_WOUT], DM, (bf16*)(F.ws + WS_WOUT), DM, scr, 64 * (r / 32), 32 * (r % 32), F.lane, MapId());
    }
    for (int i = F.vcu * 512 + F.tid; i < 1024 * 16; i += F.G * 512) { const int n = i >> 4, c = i & 15;
        *(GAS u32x4*)((bf16*)(F.ws + WS_WKVB) + (size_t)n * 256 + 128 + c * 8) = (u32x4){0u, 0u, 0u, 0u}; }
}

__device__ __forceinline__ void norm_row(int lane, const float* src, const float* y, float gsc, const float* gate, const float* gpost, float* resout,
                                         const float* gpre, const float* shift, const float* scale, bf16* hout) {
    f32x4 v[4];
#pragma unroll
    for (int j = 0; j < 4; ++j) v[j] = *((const f32x4*)src + lane + 64 * j);
    if (y) {
        f32x4 yv[4]; float s = 0.f;
#pragma unroll
        for (int j = 0; j < 4; ++j) { yv[j] = *((const f32x4*)y + lane + 64 * j); s += (yv[j].x * yv[j].x + yv[j].y * yv[j].y) + (yv[j].z * yv[j].z + yv[j].w * yv[j].w); }
        const float rstd = 1.0f / sqrtf(wave_sum(s) * (1.f / DM) + EPS);
#pragma unroll
        for (int j = 0; j < 4; ++j) { const f32x4 g = *((const f32x4*)gate + lane + 64 * j), p = *((const f32x4*)gpost + lane + 64 * j);
            v[j] = v[j] + (yv[j] * rstd) * p * g * gsc; }
    }
    if (resout) {
#pragma unroll
        for (int j = 0; j < 4; ++j) *((f32x4*)resout + lane + 64 * j) = v[j];
    }
    if (hout) {
        float s = 0.f;
#pragma unroll
        for (int j = 0; j < 4; ++j) s += (v[j].x * v[j].x + v[j].y * v[j].y) + (v[j].z * v[j].z + v[j].w * v[j].w);
        const float rstd = 1.0f / sqrtf(wave_sum(s) * (1.f / DM) + EPS);
#pragma unroll
        for (int j = 0; j < 4; ++j) { const f32x4 g = *((const f32x4*)gpre + lane + 64 * j), sh = *((const f32x4*)shift + lane + 64 * j), sc = *((const f32x4*)scale + lane + 64 * j);
            const f32x4 h = (v[j] * rstd) * g * (sc + 1.0f) + sh;
            u32x2 w; w.x = cvt_pk_bf16(h.x, h.y); w.y = cvt_pk_bf16(h.z, h.w);
            *((u32x2*)hout + lane + 64 * j) = w; }
    }
}

__device__ __forceinline__ void mixer_row(Frame& F, int row) {
    const int lane = lane_id_opaque();
    const bf16* Zq = (const bf16*)(F.ws + WS_ZQ); const float* Z1f = (const float*)(F.ws + WS_Z1F);
    bf16* KV = (bf16*)(F.ws + WS_KV);
    if (row >= CTX) {
        const u32x2 w = *((const u32x2*)(Zq + (size_t)row * 256) + lane);
        const float a = bflo(w.x), b = bfhi(w.x), c = bflo(w.y), d = bfhi(w.y);
        const float rstd = 1.0f / sqrtf(wave_sum((a * a + b * b) + (c * c + d * d)) * (1.f / 256.f) + EPS);
        const f32x4 g = *((const f32x4*)F.in[I_QNORM] + lane);
        u32x2 o; o.x = cvt_pk_bf16(a * rstd * g.x, b * rstd * g.y); o.y = cvt_pk_bf16(c * rstd * g.z, d * rstd * g.w);
        *((u32x2*)((bf16*)(F.ws + WS_QN) + (size_t)(row - CTX) * 256) + lane) = o;
    }
    {
        f32x4 v = {0.f, 0.f, 0.f, 0.f}, g = {0.f, 0.f, 0.f, 0.f};
        if (lane < 32) { v = *((const f32x4*)(Z1f + (size_t)row * 256) + lane); g = *((const f32x4*)F.in[I_KVNORM] + lane); }
        const float rstd = 1.0f / sqrtf(wave_sum((v.x * v.x + v.y * v.y) + (v.z * v.z + v.w * v.w)) * (1.f / 128.f) + EPS);
        u32x2 o; o.x = cvt_pk_bf16(v.x * rstd * g.x, v.y * rstd * g.y); o.y = cvt_pk_bf16(v.z * rstd * g.z, v.w * rstd * g.w);
        *((u32x2*)((bf16*)(F.ws + WS_KVN) + (size_t)row * 256) + lane) = o;
    }
    if (lane < 16) {
        const int i = lane, a = i >> 3, f = i & 7;
        const float x1 = Z1f[(size_t)row * 256 + 128 + 16 * a + f], x2 = Z1f[(size_t)row * 256 + 128 + 16 * a + 8 + f];
        float o1 = x1, o2 = x2;
        if (row >= CTX) { const int t = row - CTX, pos = a ? (t & 63) : (t >> 6); const f32x2 cs = ((const f32x2*)(F.ws + WS_ROPE))[pos * 8 + f];
            o1 = x1 * cs.x - x2 * cs.y; o2 = x2 * cs.x + x1 * cs.y; }
        const unsigned pk = cvt_pk_bf16(o1, o2);
#pragma unroll
        for (int h = 0; h < 8; ++h) *(unsigned*)(KV + (size_t)row * KVP + h * KVH + 64 + 2 * i) = pk;
    }
}

template <int DIR>
__device__ __forceinline__ void gla_prep_qk(Frame& F, int cn, int h, LAS float* gal) {
    const int lane = lane_id_opaque(), c = h * 64 + lane;
    const float* wa = F.in[DIR ? I_WAB : I_WAF]; const float bb = F.in[DIR ? I_BAB : I_BAF][c];
    const int row0 = cn * 64;
    {
        const float* gp = (const float*)(F.ws + WS_Z1F) + (size_t)(row0 + lane) * 256 + 160 + 16 * DIR;
#pragma unroll
        for (int q4 = 0; q4 < 4; ++q4) *(LAS f32x4*)(gal + lane * 16 + q4 * 4) = *(const f32x4*)(gp + q4 * 4);
    }
    float w[16];
#pragma unroll
    for (int r = 0; r < 16; ++r) w[r] = wa[r * 256 + c];
    LDS_WAIT(); asm volatile("" ::: "memory");
    const bf16* Zg = (const bf16*)(F.ws + WS_ZGQK);
    float Gs[64]; float G = 0.f;
#pragma unroll
    for (int s = 0; s < 64; ++s) { const int i = DIR ? 63 - s : s;
        float lg = bb;
#pragma unroll
        for (int q4 = 0; q4 < 4; ++q4) { const f32x4 g4 = *(const LAS f32x4*)(gal + i * 16 + q4 * 4);
            lg = fmaf(g4.x, w[4 * q4], lg); lg = fmaf(g4.y, w[4 * q4 + 1], lg); lg = fmaf(g4.z, w[4 * q4 + 2], lg); lg = fmaf(g4.w, w[4 * q4 + 3], lg); }
        const float la = (fminf(lg, 0.f) - __logf(1.0f + __expf(-fabsf(lg)))) * (1.0f / 16.0f);
        G += la; Gs[i] = G; }
    const float Glast = G, Gref = DIR ? Gs[32] : Gs[31];
    const size_t aidx = ((size_t)DIR * NCH + cn) * 256 + c;
    float* aux = (float*)(F.ws + WS_AUX);
    aux[aidx] = __expf(Glast); aux[AUX_N + aidx] = __expf(Glast - Gref); aux[2 * AUX_N + aidx] = __expf(Gref);
    bf16* Qt = (bf16*)(F.ws + WS_QT) + (size_t)DIR * ROWS * 256; bf16* Kt = (bf16*)(F.ws + WS_KT) + (size_t)DIR * ROWS * 256;
    bf16* KtT = (bf16*)(F.ws + WS_KTT) + (((size_t)DIR * NCH + cn) * 256 + c) * 64;
#pragma unroll
    for (int g8 = 0; g8 < 8; ++g8) { float kt[8]; unsigned short qv[8], kv[8];
#pragma unroll
        for (int t = 0; t < 8; ++t) { const size_t ro = (size_t)(row0 + g8 * 8 + t); qv[t] = Zg[ro * 512 + c]; kv[t] = Zg[ro * 512 + 256 + c]; }
#pragma unroll
        for (int t = 0; t < 8; ++t) { const int i = g8 * 8 + t; const size_t ro = (size_t)(row0 + i);
            const float qt = bf2f(qv[t]) * 0.125f * __expf(Gs[i] - Gref); kt[t] = bf2f(kv[t]) * __expf(Gref - Gs[i]);
            Qt[ro * 256 + c] = (bf16)f2bf(qt); Kt[ro * 256 + c] = (bf16)f2bf(kt[t]); }
        u32x4 o; o.x = cvt_pk_bf16(kt[0], kt[1]); o.y = cvt_pk_bf16(kt[2], kt[3]); o.z = cvt_pk_bf16(kt[4], kt[5]); o.w = cvt_pk_bf16(kt[6], kt[7]);
        *(u32x4*)(KtT + g8 * 8) = o; }
    LDS_WAIT(); asm volatile("" ::: "memory");
}
__device__ __forceinline__ void gla_prep_v(Frame& F, int cn, int grp) {
    const int col = grp * 64 + lane_id_opaque();
    const bf16* Zv = (const bf16*)(F.ws + WS_ZGV) + (size_t)cn * 64 * 512 + col;
    bf16* vT = (bf16*)(F.ws + WS_VT) + ((size_t)cn * 512 + col) * 64;
#pragma unroll
    for (int g8 = 0; g8 < 8; ++g8) { unsigned short e[8];
#pragma unroll
        for (int t = 0; t < 8; ++t) e[t] = Zv[(size_t)(g8 * 8 + t) * 512];
        u32x4 o; o.x = e[0] | ((unsigned)e[1] << 16); o.y = e[2] | ((unsigned)e[3] << 16); o.z = e[4] | ((unsigned)e[5] << 16); o.w = e[6] | ((unsigned)e[7] << 16);
        *(u32x4*)(vT + g8 * 8) = o; }
}

__device__ __forceinline__ void gla_pass_l(Frame& F, int task) {
    const int lane = lane_id_opaque(), r = lane & 31, hi = lane >> 5;
    const int cn = task % NCH, dh = task / NCH, h = dh & 3, dir = dh >> 2;
    const bf16* vTp = (const bf16*)(F.ws + WS_VT) + ((size_t)cn * 512 + h * 128) * 64;
    const bf16* kTp = (const bf16*)(F.ws + WS_KTT) + (((size_t)dir * NCH + cn) * 256 + h * 64) * 64;
    bf16* Lp = (bf16*)(F.ws + WS_LS) + (((size_t)(dir * 4 + h) * NCH + cn) * 128) * 64;
    bf16x8 bfr[2][4];
#pragma unroll
    for (int nt = 0; nt < 2; ++nt)
#pragma unroll
        for (int s = 0; s < 4; ++s) bfr[nt][s] = *(const bf16x8*)(kTp + (32 * nt + r) * 64 + 16 * s + 8 * hi);
#pragma unroll
    for (int mt = 0; mt < 4; ++mt) { bf16x8 afr[4]; bf16* pm = Lp + (4 * hi) * 64 + r + (32 * mt) * 64;
#pragma unroll
        for (int s = 0; s < 4; ++s) afr[s] = *(const bf16x8*)(vTp + (32 * mt + r) * 64 + 16 * s + 8 * hi);
#pragma unroll
        for (int nt = 0; nt < 2; ++nt) { f32x16 acc = {};
#pragma unroll
            for (int s = 0; s < 4; ++s) acc = __builtin_amdgcn_mfma_f32_32x32x16_bf16(afr[s], bfr[nt][s], acc, 0, 0, 0);
#pragma unroll
            for (int rg = 0; rg < 16; ++rg) pm[((rg & 3) + 8 * (rg >> 2)) * 64 + 32 * nt] = (bf16)f2bf(acc[rg]); } }
}

__device__ __forceinline__ void gla_pass_s(Frame& F) {
    const float* aux = (const float*)(F.ws + WS_AUX);
    for (int el = F.vcu * 256 + F.tid; F.tid < 256 && el < 65536; el += F.G * 256) {
        const int d = el & 63, e = (el >> 6) & 127, dh = el >> 13, h = dh & 3, dir = dh >> 2;
        bf16* Lp = (bf16*)(F.ws + WS_LS) + ((size_t)dh * NCH * 128 + e) * 64 + d;
        const float* ap = aux + (size_t)dir * NCH * 256 + h * 64 + d;
        float S = 0.f;
        for (int p0 = 0; p0 < NCH; p0 += 10) { float lv[10], dc[10], sc[10], er[10]; int cn[10];
#pragma unroll
            for (int u = 0; u < 10; ++u) { const int p = p0 + u; cn[u] = dir ? (p < 4 ? 3 - p : 263 - p) : p;
                lv[u] = bf2f(Lp[(size_t)cn[u] * 8192]); dc[u] = ap[cn[u] * 256]; sc[u] = ap[AUX_N + cn[u] * 256]; er[u] = ap[2 * AUX_N + cn[u] * 256]; }
#pragma unroll
            for (int u = 0; u < 10; ++u) { Lp[(size_t)cn[u] * 8192] = (bf16)f2bf(S * er[u]); S = dc[u] * S + sc[u] * lv[u]; } }
    }
}

template <int DIR, int IT>
__device__ __forceinline__ void gla_o_dir(Frame& F, f32x16 (&o)[4], int h, int cn, int r, int hi) {
    const size_t row0 = (size_t)cn * 64;
    const bf16* Qp = (const bf16*)(F.ws + WS_QT) + ((size_t)DIR * ROWS + row0) * 256 + h * 64;
    const bf16* Kp = (const bf16*)(F.ws + WS_KT) + ((size_t)DIR * ROWS + row0) * 256 + h * 64;
    const bf16* Sp = (const bf16*)(F.ws + WS_LS) + (((size_t)(DIR * 4 + h) * NCH + cn) * 128) * 64;
    const bf16* vTp = (const bf16*)(F.ws + WS_VT) + ((size_t)cn * 512 + h * 128) * 64;
    bf16x8 qf[4];
#pragma unroll
    for (int s = 0; s < 4; ++s) qf[s] = *(const bf16x8*)(Qp + (size_t)(32 * IT + r) * 256 + 16 * s + 8 * hi);
#pragma unroll
    for (int jt = 0; jt < 2; ++jt) {
        if (DIR == 0 ? (jt > IT) : (jt < IT)) continue;
        bf16x8 kf[4];
#pragma unroll
        for (int s = 0; s < 4; ++s) kf[s] = *(const bf16x8*)(Kp + (size_t)(32 * jt + r) * 256 + 16 * s + 8 * hi);
        f32x16 X = {};
#pragma unroll
        for (int s = 0; s < 4; ++s) X = __builtin_amdgcn_mfma_f32_32x32x16_bf16(kf[s], qf[s], X, 0, 0, 0);
        if (jt == IT) {
#pragma unroll
            for (int rg = 0; rg < 16; ++rg) { const int j = att::crow(rg, hi); const bool keep = DIR == 0 ? (j <= r) : (j >= r); X[rg] = keep ? X[rg] : 0.f; } }
        bf16x8 xa[2];
#pragma unroll
        for (int s2 = 0; s2 < 2; ++s2) { u32x4 w; w.x = cvt_pk_bf16(X[8 * s2 + 0], X[8 * s2 + 1]); w.y = cvt_pk_bf16(X[8 * s2 + 2], X[8 * s2 + 3]);
            w.z = cvt_pk_bf16(X[8 * s2 + 4], X[8 * s2 + 5]); w.w = cvt_pk_bf16(X[8 * s2 + 6], X[8 * s2 + 7]); xa[s2] = __builtin_bit_cast(bf16x8, w); }
#pragma unroll
        for (int nt = 0; nt < 4; ++nt)
#pragma unroll
            for (int s2 = 0; s2 < 2; ++s2) { const bf16* vp = vTp + (size_t)(32 * nt + r) * 64 + 32 * jt + 16 * s2 + 4 * hi;
                const u32x2 lo = *(const u32x2*)vp, hi8 = *(const u32x2*)(vp + 8);
                const u32x4 bw = {lo.x, lo.y, hi8.x, hi8.y};
                o[nt] = __builtin_amdgcn_mfma_f32_32x32x16_bf16(xa[s2], __builtin_bit_cast(bf16x8, bw), o[nt], 0, 0, 0); }
    }
#pragma unroll
    for (int nt = 0; nt < 4; ++nt)
#pragma unroll
        for (int s = 0; s < 4; ++s) { const bf16x8 sf = *(const bf16x8*)(Sp + (size_t)(32 * nt + r) * 64 + 16 * s + 8 * hi);
            o[nt] = __builtin_amdgcn_mfma_f32_32x32x16_bf16(qf[s], sf, o[nt], 0, 0, 0); }
}
template <int IT>
__device__ __forceinline__ void gla_pass_o(Frame& F, int h, int cn) {
    const int lane = lane_id_opaque(), r = lane & 31, hi = lane >> 5;
    f32x16 o[4];
#pragma unroll
    for (int nt = 0; nt < 4; ++nt) o[nt] = f32x16{};
    gla_o_dir<0, IT>(F, o, h, cn, r, hi);
    gla_o_dir<1, IT>(F, o, h, cn, r, hi);
    const bf16* Zgg = (const bf16*)(F.ws + WS_ZGG); bf16* mix = (bf16*)(F.ws + WS_MIX);
    float gn[4];
#pragma unroll
    for (int nt = 0; nt < 4; ++nt) gn[nt] = F.in[I_GNORM][32 * nt + r];
#pragma unroll
    for (int rg = 0; rg < 16; ++rg) {
        float ss = 0.f;
#pragma unroll
        for (int nt = 0; nt < 4; ++nt) ss += o[nt][rg] * o[nt][rg];
        ss = half_sum(ss);
        const float rstd = 1.0f / sqrtf(ss * (1.f / 128.f) + EPS);
        const int i = 32 * IT + att::crow(rg, hi); const size_t row = (size_t)cn * 64 + i;
#pragma unroll
        for (int nt = 0; nt < 4; ++nt) { const int e = 32 * nt + r; const float gg = bf2f(Zgg[row * 512 + h * 128 + e]);
            const float val = o[nt][rg] * rstd * gn[nt] * (gg / (1.0f + expf(-gg)));
            mix[(row - CTX) * DM + 512 + h * 128 + e] = (bf16)f2bf(val); } }
}

#ifndef PHM
#define PHM 0xFFFF
#endif
#define PH(k) ((PHM >> (k)) & 1)
struct Args { const float* in[23]; float* out; unsigned char* ws; };
__global__ void __launch_bounds__(NWAVES * 64, 2) fwd_megakernel(Args args) {
    extern __shared__ __attribute__((aligned(16))) unsigned char lds[];
    Frame F;
    F.lds = (LAS unsigned char*)lds;
    F.MISC = (volatile LAS unsigned*)(F.lds + MISC_OFF);
    F.wave = __builtin_amdgcn_readfirstlane((int)threadIdx.x >> 6); F.lane = lane_id_opaque(); F.tid = F.wave * 64 + F.lane;
    F.G = gridDim.x; { const int bx = blockIdx.x; F.vcu = (F.G % 8 == 0) ? (bx % 8) * (F.G / 8) + bx / 8 : bx; }
#pragma unroll
    for (int i = 0; i < 23; ++i) F.in[i] = args.in[i];
    F.out = args.out; F.ws = args.ws;
    for (int u = F.tid; u < (LDS_BYTES - LDSCTL_OFF) / 4; u += NWAVES * 64) ((LAS unsigned*)(F.lds + LDSCTL_OFF))[u] = 0u;
    __syncthreads();
    XcdBarrier bar = xcd_barrier_post((unsigned*)(F.ws + WS_CTL), F.MISC + 8, F.tid);
unsigned bseq = 0;
#ifdef TIMEPH
#define TSTAMP(k) do { if (blockIdx.x == 0 && F.tid == 0) ((unsigned long long*)(F.ws + WS_CTL + 32768))[k] = __builtin_amdgcn_s_memrealtime(); } while (0)
#else
#define TSTAMP(k) do { } while (0)
#endif
#define GRID_BAR() do { ++bseq; { const int l_ = lane_id_opaque(); xcd_barrier(bar, bseq, F.wave * 64 + l_); } F.lane = lane_id_opaque(); F.tid = F.wave * 64 + F.lane; TSTAMP(bseq); } while (0)
    const int gw = F.vcu * NWAVES + F.wave, NGW = F.G * NWAVES;
    const float* modl = (const float*)(F.ws + WS_MOD); const float* modc = modl + NMODV;
    bf16* hA = (bf16*)(F.ws + WS_A); float* Y = (float*)(F.ws + WS_Y);
    const float* npre = F.in[I_NPRE]; const float* npost = F.in[I_NPOST];
    LAS unsigned char* ring = F.lds + RING_OFF;

    TSTAMP(0);
    if (PH(0)) p0_prologue(F);
    GRID_BAR();
    if (PH(1)) for (int row = gw; row < ROWS; row += NGW) {
        const bool isc = row < CTX; const float* md = isc ? modc : modl;
        const float* src = isc ? F.in[I_CTX] + (size_t)row * DM : F.in[I_X] + (size_t)(row - CTX) * DM;
        norm_row(F.lane, src, nullptr, 0.f, nullptr, nullptr, nullptr, npre, md, md + DM, hA + (size_t)row * DM);
    }
    GRID_BAR();
    if (PH(2)) { pg8::Gemm g{hA, (const bf16*)(F.ws + WS_W1IN), ROWS, 2 * DFF, DM, DM, DM}; pg8::StaticOrder S; S.init(ROWS, 2 * DFF, F.G, (int)blockIdx.x);
      pg8::EpiSwiGLU E{(bf16*)(F.ws + WS_ACT), DFF};
      pg8::gemm_phase<pg8::EpiSwiGLU, true>(ring, g, S, E, F.wave); }
    GRID_BAR();
    if (PH(3)) { pg8::Gemm g{(const bf16*)(F.ws + WS_ACT), (const bf16*)(F.ws + WS_W1OUT), ROWS, DM, DFF, DFF, DFF}; pg8::StaticOrder S; S.init(ROWS, DM, F.G, (int)blockIdx.x);
      pg8::EpiF32 E{Y, DM};
      pg8::gemm_phase<pg8::EpiF32, true>(ring, g, S, E, F.wave); }
    GRID_BAR();
    if (PH(4)) for (int row = gw; row < ROWS; row += NGW) {
        const bool isc = row < CTX; const float* md = isc ? modc : modl;
        const float* src = isc ? F.in[I_CTX] + (size_t)row * DM : F.in[I_X] + (size_t)(row - CTX) * DM;
        float* ro = isc ? nullptr : F.out + (size_t)(row - CTX) * DM;
        norm_row(F.lane, src, Y + (size_t)row * DM, 0.5f, md + 2 * DM, npost, ro, npre + DM, md + 3 * DM, md + 4 * DM, hA + (size_t)row * DM);
    }
    GRID_BAR();
#if defined(STOPAT) && STOPAT == 4
    return;
#endif
    if (PH(5)) { pg8::Gemm g{hA, (const bf16*)(F.ws + WS_WIN), ROWS, 2048, DM, DM, DM}; pg8::StaticOrder S; S.init(ROWS, 2048, F.G, (int)blockIdx.x);
      pg8::EpiZ E{(bf16*)(F.ws + WS_ZQ), (bf16*)(F.ws + WS_ZGQK), (bf16*)(F.ws + WS_ZGV), (bf16*)(F.ws + WS_ZGG), (float*)(F.ws + WS_Z1F)};
      pg8::gemm_phase<pg8::EpiZ, true>(ring, g, S, E, F.wave); }
    GRID_BAR();
    if (PH(6)) for (int row = gw; row < ROWS; row += NGW) mixer_row(F, row);
    if (PH(6)) { LAS float* gal = (LAS float*)(ring + F.wave * 4096);
        for (int t = gw; t < 16 * NCH; t += NGW) { const int cn = t % NCH, sub = t / NCH;
            if (sub < 4) gla_prep_qk<0>(F, cn, sub, gal); else if (sub < 8) gla_prep_qk<1>(F, cn, sub - 4, gal); else gla_prep_v(F, cn, sub - 8); } }
    GRID_BAR();
    if (PH(7)) { pg8::Gemm g{(const bf16*)(F.ws + WS_QN), (const bf16*)(F.ws + WS_WQB), SEQ, QP, 256, 256, 256}; pg8::StaticOrder S; S.init(SEQ, QP, F.G, (int)blockIdx.x);
      pg8::EpiQ E{(bf16*)(F.ws + WS_Q)};
      pg8::gemm_phase<pg8::EpiQ, true>(ring, g, S, E, F.wave); }
    if (PH(7)) { pg8::Gemm g{(const bf16*)(F.ws + WS_KVN), (const bf16*)(F.ws + WS_WKVB), ROWS, 1024, 256, 256, 256}; pg8::StaticOrder S; S.init(ROWS, 1024, F.G, (int)((blockIdx.x + 64) % F.G));
      pg8::EpiKV E{(bf16*)(F.ws + WS_KV)};
      pg8::gemm_phase<pg8::EpiKV, true>(ring, g, S, E, F.wave); }
    if (PH(8)) for (int t = gw; t < 8 * NCH; t += NGW) gla_pass_l(F, t);
    GRID_BAR();
#if defined(STOPAT) && STOPAT == 6
    { const bf16* Qp = (const bf16*)(F.ws + WS_Q); const bf16* KVp = (const bf16*)(F.ws + WS_KV);
      for (size_t i = (size_t)blockIdx.x * 512 + F.tid; i < (size_t)SEQ * DM; i += (size_t)F.G * 512) { const size_t t = i >> 10; const int c = (int)(i & 1023);
        F.out[i] = c < 768 ? bf2f(Qp[t * QP + c]) : bf2f(KVp[(t + CTX) * KVP + (c - 768)]) + bf2f(KVp[(t + CTX) * KVP + 256 + (c - 768)]) + bf2f(KVp[t * KVP + 1024 + (c - 768)]); } }
    return;
#endif
#if defined(STOPAT) && STOPAT == 7
    { const bf16* Qt = (const bf16*)(F.ws + WS_QT); const bf16* Kt = (const bf16*)(F.ws + WS_KT); const bf16* KtT = (const bf16*)(F.ws + WS_KTT); const bf16* vT = (const bf16*)(F.ws + WS_VT);
      const bf16* LS = (const bf16*)(F.ws + WS_LS); const float* aux = (const float*)(F.ws + WS_AUX);
      for (size_t i = (size_t)blockIdx.x * 512 + F.tid; i < (size_t)SEQ * DM; i += (size_t)F.G * 512) { const size_t t = i >> 10; const int c = (int)(i & 1023);
        float v;
        if (c < 256) v = bf2f(Qt[t * 256 + c]) + bf2f(Qt[((size_t)ROWS + t) * 256 + c]);
        else if (c < 512) v = bf2f(Kt[t * 256 + c - 256]) + bf2f(Kt[((size_t)ROWS + t) * 256 + c - 256]);
        else if (c < 768) v = bf2f(KtT[i]) + bf2f(vT[i >> 1]);
        else v = bf2f(LS[i]) + bf2f(LS[i + (size_t)SEQ * DM]) + aux[i % (3 * AUX_N)];
        F.out[i] = v; } }
    return;
#endif
    if (PH(9)) gla_pass_s(F);
    TSTAMP(20);
    if (PH(10)) for (int u = F.vcu; u < 512; u += F.G) {
        const int h = (u & 255) >> 5, qb = (u & 31) + 32 * (u >> 8);
        att::attn_unit((const bf16*)(F.ws + WS_Q) + (size_t)qb * 256 * QP + h * QH, (const bf16*)(F.ws + WS_KV) + h * KVH,
                       (bf16*)(F.ws + WS_MIX) + (size_t)qb * 256 * DM + h * 64, ROWS, (LAS char*)ring, qb * 256, (const f32x2*)(F.ws + WS_ROPE), F.wave);
    }
    GRID_BAR();
#if defined(STOPAT) && STOPAT == 9
    { const bf16* LS = (const bf16*)(F.ws + WS_LS);
      for (size_t i = (size_t)blockIdx.x * 512 + F.tid; i < (size_t)SEQ * DM; i += (size_t)F.G * 512) F.out[i] = bf2f(LS[i]); }
    return;
#endif
    if (PH(11)) for (int t = gw; t < 8 * (NCH - 4); t += NGW) { const int h = (t >> 1) & 3, cn = 4 + (t >> 3); if (t & 1) gla_pass_o<1>(F, h, cn); else gla_pass_o<0>(F, h, cn); }
    GRID_BAR();
#if defined(STOPAT) && STOPAT == 8
    { const bf16* mixp = (const bf16*)(F.ws + WS_MIX);
      for (size_t i = (size_t)blockIdx.x * 512 + F.tid; i < (size_t)SEQ * DM; i += (size_t)F.G * 512) F.out[i] = bf2f(mixp[i]); }
    return;
#endif
    if (PH(12)) { pg8::Gemm g{(const bf16*)(F.ws + WS_MIX), (const bf16*)(F.ws + WS_WOUT), SEQ, DM, DM, DM, DM}; pg8::StaticOrder S; S.init(SEQ, DM, F.G, (int)blockIdx.x);
      pg8::EpiF32 E{Y, DM};
      pg8::gemm_phase<pg8::EpiF32, true>(ring, g, S, E, F.wave); }
    GRID_BAR();
    if (PH(13)) for (int row = gw; row < SEQ; row += NGW) {
        float* hr = F.out + (size_t)row * DM;
        norm_row(F.lane, hr, Y + (size_t)row * DM, 1.0f, modl + 5 * DM, npost + DM, hr, npre + 2 * DM, modl + 6 * DM, modl + 7 * DM, hA + (size_t)row * DM);
    }
    GRID_BAR();
    if (PH(14)) { pg8::Gemm g{hA, (const bf16*)(F.ws + WS_W2IN), SEQ, 2 * DFF, DM, DM, DM}; pg8::StaticOrder S; S.init(SEQ, 2 * DFF, F.G, (int)blockIdx.x);
      pg8::EpiSwiGLU E{(bf16*)(F.ws + WS_ACT), DFF};
      pg8::gemm_phase<pg8::EpiSwiGLU, true>(ring, g, S, E, F.wave); }
    GRID_BAR();
#ifdef DIAG
    GRID_BAR();
    for (int row = gw; row < SEQ; row += NGW) { float* hr = F.out + (size_t)row * DM;
        for (int j = 0; j < 4; ++j) *((f32x4*)hr + F.lane + 64 * j) = (f32x4){0.f, 0.f, 0.f, 0.f}; }
    GRID_BAR();
    if (blockIdx.x == 0 && F.tid == 0) { unsigned* bw = (unsigned*)(F.ws + WS_CTL);
        const unsigned code = xb_ld(&bw[XB_CODE]), tmo = xb_ld(&bw[XB_TMO]);
        unsigned val = DIAG == 0 ? code : DIAG == 1 ? tmo : DIAG == 2 ? (unsigned)F.G : DIAG == 3 ? F.MISC[8] : F.MISC[9];
        F.out[(size_t)(gw) * DM] = 1.0e6f * (float)(val + 1u); }
    return;
#endif
    if (PH(15)) { pg8::Gemm g{(const bf16*)(F.ws + WS_ACT), (const bf16*)(F.ws + WS_W2OUT), SEQ, DM, DFF, DFF, DFF}; pg8::StaticOrder S; S.init(SEQ, DM, F.G, (int)blockIdx.x);
      pg8::EpiF32 E{Y, DM};
      pg8::gemm_phase<pg8::EpiF32, true>(ring, g, S, E, F.wave); }
    GRID_BAR();
    for (int row = gw; row < SEQ; row += NGW) {
        float* hr = F.out + (size_t)row * DM;
        norm_row(F.lane, hr, Y + (size_t)row * DM, 0.5f, modl + 8 * DM, npost + 2 * DM, hr, nullptr, nullptr, nullptr, nullptr);
    }
#ifdef TIMEPH
    TSTAMP(15);
    GRID_BAR();
    if (blockIdx.x == 0) { volatile unsigned long long* ts = (volatile unsigned long long*)(F.ws + WS_CTL + 32768);
        const unsigned long long d = TIMEPH < 0 ? 10000ull : ts[TIMEPH_B] - ts[TIMEPH];
        long n = (long)((double)d * 0.01 * TIMEPH_K); if (n > 330000) n = 330000;
        for (long i = F.tid; i < n; i += 512) F.out[i] += 0.05f; }
#endif
}

extern "C" void kernel_launch(void* const* d_in, const int* in_sizes, int n_in, void* d_out, int out_size, void* d_ws, size_t ws_size, hipStream_t stream) {
    static int grid = 0;
    if (grid == 0) {
        if (n_in != 23 || in_sizes[0] != SEQ * DM || out_size != SEQ * DM || ws_size < WS_END) {
            fprintf(stderr, "kernel_launch: unexpected shapes: n_in %d in0 %d out %d ws %zu\n", n_in, n_in > 0 ? in_sizes[0] : -1, out_size, ws_size); grid = -1; return; }
        int dev = 0, cus = 0, per_cu = 0;
        if (hipGetDevice(&dev) != hipSuccess || hipDeviceGetAttribute(&cus, hipDeviceAttributeMultiprocessorCount, dev) != hipSuccess) { fprintf(stderr, "kernel_launch: device query failed\n"); grid = -1; return; }
        if (hipFuncSetAttribute((const void*)fwd_megakernel, hipFuncAttributeMaxDynamicSharedMemorySize, LDS_BYTES) != hipSuccess) { fprintf(stderr, "kernel_launch: hipFuncSetAttribute failed\n"); grid = -1; return; }
        if (hipOccupancyMaxActiveBlocksPerMultiprocessor(&per_cu, (const void*)fwd_megakernel, NWAVES * 64, LDS_BYTES) != hipSuccess || per_cu < 1) {
            fprintf(stderr, "kernel_launch: occupancy query reports %d workgroups per CU\n", per_cu); (void)hipGetLastError(); grid = -1; return; }
        grid = cus;
    }
    if (grid < 0) return;
    if (hipMemsetAsync((char*)d_ws + WS_CTL, 0, CTL_ZERO_BYTES, stream) != hipSuccess) { fprintf(stderr, "kernel_launch: memset failed\n"); return; }
    Args a{};
    for (int i = 0; i < 23; ++i) a.in[i] = (const float*)d_in[i];
    a.out = (float*)d_out; a.ws = (unsigned char*)d_ws;
    hipLaunchKernelGGL(fwd_megakernel, dim3(grid), dim3(NWAVES * 64), LDS_BYTES, stream, a);
    const hipError_t le = hipPeekAtLastError();
    if (le != hipSuccess) fprintf(stderr, "kernel_launch: launch failed: %s\n", hipGetErrorName(le));
}
```

```cpp
#include <hip/hip_runtime.h>
#include <cstdio>
#include <cstdint>

#define GAS __attribute__((address_space(1)))
#define LAS __attribute__((address_space(3)))
typedef unsigned short bf16;
typedef short bf16x8 __attribute__((ext_vector_type(8)));
typedef short s16x4 __attribute__((ext_vector_type(4)));
typedef float f32x4 __attribute__((ext_vector_type(4)));
typedef float f32x2 __attribute__((ext_vector_type(2)));
typedef float f32x16 __attribute__((ext_vector_type(16)));
typedef unsigned u32x4 __attribute__((ext_vector_type(4)));
typedef unsigned u32x2 __attribute__((ext_vector_type(2)));

constexpr int DM = 1024, SEQ = 16384, CTX = 256, ROWS = SEQ + CTX, DFF = 2816, NMODV = 9 * DM;
constexpr int NCH = ROWS / 64;
constexpr float EPS = 1e-6f;
constexpr int KVP = 1280, KVH = 160;
constexpr int QP = 768, QH = 96;

constexpr size_t MiB = 1u << 20;
constexpr size_t WS_CTL = 0, CTL_ZERO_BYTES = 64 * 1024;
constexpr size_t WS_MOD = 1 * MiB;
constexpr size_t WS_ROPE = 1 * MiB + 128 * 1024;
constexpr size_t WS_W1IN = 2 * MiB;
constexpr size_t WS_W1OUT = WS_W1IN + 11 * MiB;
constexpr size_t WS_W2IN = WS_W1OUT + 5 * MiB + 512 * 1024;
constexpr size_t WS_W2OUT = WS_W2IN + 11 * MiB;
constexpr size_t WS_WIN = WS_W2OUT + 5 * MiB + 512 * 1024;
constexpr size_t WS_WQB = WS_WIN + 4 * MiB;
constexpr size_t WS_WKVB = WS_WQB + 384 * 1024;
constexpr size_t WS_WOUT = WS_WKVB + 512 * 1024;
constexpr size_t WS_A = 42 * MiB;
constexpr size_t WS_QN = WS_A;
constexpr size_t WS_KVN = WS_A + 8 * MiB;
constexpr size_t WS_MIX = WS_A;
constexpr size_t WS_B = WS_A + (size_t)ROWS * DM * 2;
constexpr size_t WS_ZQ = WS_B;
constexpr size_t WS_Z1F = WS_ZQ + (size_t)ROWS * 256 * 2;
constexpr size_t WS_Q = WS_B;
constexpr size_t WS_C = WS_Z1F + (size_t)ROWS * 256 * 4;
constexpr size_t WS_ZGQK = WS_C;
constexpr size_t WS_ZGV = WS_ZGQK + (size_t)ROWS * 512 * 2;
constexpr size_t WS_LS = WS_C;
constexpr size_t WS_ZGG = WS_ZGV + (size_t)ROWS * 512 * 2;
constexpr size_t WS_KV = WS_ZGG + (size_t)ROWS * 512 * 2;
constexpr size_t WS_QT = WS_KV + (size_t)ROWS * KVP * 2;
constexpr size_t WS_KT = WS_QT + (size_t)2 * ROWS * 256 * 2;
constexpr size_t WS_KTT = WS_KT + (size_t)2 * ROWS * 256 * 2;
constexpr size_t WS_VT = WS_KTT + (size_t)2 * ROWS * 256 * 2;
constexpr size_t WS_AUX = WS_VT + (size_t)ROWS * 512 * 2;
constexpr size_t AUX_N = (size_t)2 * NCH * 256;
constexpr size_t WS_AUX_END = WS_AUX + 3 * AUX_N * 4;
constexpr size_t WS_ACT = WS_B;
constexpr size_t WS_Y = 164 * MiB;
constexpr size_t WS_SLAB = 230 * MiB;
constexpr int NSPLIT = 11;
constexpr size_t CTL_CTXCNT = 16384;
constexpr size_t WS_END = 256 * MiB;
static_assert(WS_WOUT + 2 * MiB <= WS_A, "weights");
static_assert(WS_KVN + (size_t)ROWS * 256 * 2 <= WS_B, "qn/kvn in A");
static_assert(WS_Q + (size_t)SEQ * QP * 2 <= WS_C, "Q in B");
static_assert(WS_LS + (size_t)8 * NCH * 8192 * 2 <= WS_ZGG, "LS in C");
static_assert(WS_AUX_END <= WS_END, "aux");
static_assert(WS_ACT + (size_t)ROWS * DFF * 2 <= WS_Y && WS_Y + (size_t)ROWS * DM * 4 <= WS_END, "ffn map");
static_assert(WS_MIX + (size_t)SEQ * DM * 2 <= WS_Y, "mix below y");

typedef __bf16 bf16x2_t __attribute__((ext_vector_type(2)));
__device__ __forceinline__ unsigned cvt_pk_bf16(float lo, float hi) { f32x2 v = {lo, hi}; bf16x2_t b = __builtin_convertvector(v, bf16x2_t); return __builtin_bit_cast(unsigned, b); }
__device__ __forceinline__ unsigned f2bf(float f) { unsigned u = __builtin_bit_cast(unsigned, f); return (u + 0x7fffu + ((u >> 16) & 1u)) >> 16; }
__device__ __forceinline__ float bf2f(unsigned short b) { return __builtin_bit_cast(float, (unsigned)b << 16); }
__device__ __forceinline__ float bflo(unsigned w) { return __builtin_bit_cast(float, w << 16); }
__device__ __forceinline__ float bfhi(unsigned w) { return __builtin_bit_cast(float, w & 0xffff0000u); }
__device__ __forceinline__ float fast_silu(float a) { return a * __builtin_amdgcn_rcpf(1.0f + __builtin_amdgcn_exp2f(-a * 1.4426950408889634f)); }
template <int M> __device__ __forceinline__ float swz_xor(float v) { return __builtin_bit_cast(float, __builtin_amdgcn_ds_swizzle(__builtin_bit_cast(int, v), (M << 10) | 0x1f)); }
__device__ __forceinline__ float half_sum(float v) {
    v += swz_xor<1>(v); v += swz_xor<2>(v); v += swz_xor<4>(v); v += swz_xor<8>(v); v += swz_xor<16>(v); return v;
}
__device__ __forceinline__ float wave_sum(float v) {
    v = half_sum(v);
    auto rr = __builtin_amdgcn_permlane32_swap(__float_as_uint(v), __float_as_uint(v), false, false);
    return __uint_as_float(rr[0]) + __uint_as_float(rr[1]);
}
__device__ __forceinline__ int lane_id_opaque() { int l; asm volatile("v_mbcnt_lo_u32_b32 %0, -1, 0\n\tv_mbcnt_hi_u32_b32 %0, -1, %0" : "=v"(l)); return l; }
#define LDS_WAIT() asm volatile("s_waitcnt lgkmcnt(0)" ::: "memory")
#define VM_WAIT() asm volatile("s_waitcnt vmcnt(0)" ::: "memory")

namespace pg8 {
typedef unsigned short bf16_t;
constexpr int BM = 256, BK = 64, HALF = 128, HTB = HALF * BK * 2, STAGE_BYTES = 8 * HTB, NXCD = 8, WGM = 8;
__host__ __device__ __forceinline__ int lds_byte(int r, int c) { const int st = (r >> 4) * 2 + (c >> 5), rr = r & 15, cc = c & 31, ob = rr * 64 + cc * 2; return st * 1024 + (ob ^ (((ob >> 9) & 1) << 5)); }
__host__ __device__ __forceinline__ void stage_rc(int b, int& R, int& C) { const int st = b / 1024, sb = b % 1024, swz = sb ^ (((sb >> 9) & 1) << 5); R = (st >> 1) * 16 + swz / 64; C = (st & 1) * 32 + (swz % 64) / 2; }

struct Unit { int pm, pn; };
struct OneUnit { bool has; int pn;
    __device__ bool next(int i, Unit& u) const { if (i > 0 || !has) return false; u.pm = 0; u.pn = pn; return true; } };
struct Gemm { const bf16_t* A; const bf16_t* Bt; int M, N, K, lda, ldb; };

struct StaticOrder {
    int nM, nN, nwg, G, c;
    __host__ __device__ void init(int M, int N, int G_, int c_) { nM = M / BM; nN = N / BM; nwg = nM * nN; G = G_; c = c_; }
    __host__ __device__ bool next(int i, Unit& u) const {
        const long L = (long)i * G + c; if (L >= nwg) return false;
        int wgid = (int)L; { const int q = nwg / NXCD, r = nwg % NXCD, xcd = wgid % NXCD, off = wgid / NXCD; wgid = (xcd < r ? xcd * (q + 1) : r * (q + 1) + (xcd - r) * q) + off; }
        const int nig = WGM * nN, gid = wgid / nig, fm = gid * WGM, gsz = (nM - fm) < WGM ? (nM - fm) : WGM;
        u.pm = fm + ((wgid % nig) % gsz); u.pn = (wgid % nig) / gsz; return true;
    }
};

typedef f32x4 Acc[2][2][4][2];

struct EpiF32 {
    __device__ __forceinline__ void done(const Unit&, int) const {}
    float* C; int ldc;
    __device__ __forceinline__ void operator()(const Acc& acc, const Unit& u, int wr, int wc, int fr, int fq) const {
        const int row0 = u.pm * BM + wr * 64 + fr, col0 = u.pn * BM + wc * 32 + 4 * fq;
#pragma unroll
        for (int ai = 0; ai < 2; ++ai)
#pragma unroll
            for (int m = 0; m < 4; ++m) { float* rowp = C + (size_t)(row0 + ai * HALF + m * 16) * ldc + col0;
#pragma unroll
                for (int bj = 0; bj < 2; ++bj)
#pragma unroll
                    for (int n = 0; n < 2; ++n) *(f32x4*)(rowp + bj * HALF + n * 16) = acc[ai][bj][m][n]; }
    }
};
struct EpiSwiGLU {
    bf16_t* O; int ldo; unsigned* cnt;
    __device__ __forceinline__ void done(const Unit& u, int lane) const {
        if (cnt != nullptr && u.pm == 0) { asm volatile("s_waitcnt vmcnt(0)" ::: "memory");
            if (lane == 0) __hip_atomic_fetch_add(cnt, 1u, __ATOMIC_RELAXED, __HIP_MEMORY_SCOPE_AGENT); } }
    __device__ __forceinline__ void operator()(const Acc& acc, const Unit& u, int wr, int wc, int fr, int fq) const {
        const int row0 = u.pm * BM + wr * 64 + fr, col0 = u.pn * HALF + wc * 32 + 4 * fq;
        const bool wt = cnt != nullptr && u.pm == 0;
#pragma unroll
        for (int ai = 0; ai < 2; ++ai)
#pragma unroll
            for (int m = 0; m < 4; ++m) { bf16_t* rowp = O + (size_t)(row0 + ai * HALF + m * 16) * ldo + col0;
#pragma unroll
                for (int n = 0; n < 2; ++n) { const f32x4 a = acc[ai][0][m][n], b = acc[ai][1][m][n];
                    u32x2 w; w.x = cvt_pk_bf16(fast_silu(a[0]) * b[0], fast_silu(a[1]) * b[1]); w.y = cvt_pk_bf16(fast_silu(a[2]) * b[2], fast_silu(a[3]) * b[3]);
                    if (wt) __hip_atomic_store((unsigned long long*)(rowp + n * 16), ((unsigned long long)w.y << 32) | w.x, __ATOMIC_RELAXED, __HIP_MEMORY_SCOPE_AGENT);
                    else *(u32x2*)(rowp + n * 16) = w; } }
    }
};
struct EpiZ {
    __device__ __forceinline__ void done(const Unit&, int) const {}
    bf16_t *Zq, *Zgqk, *Zgv, *Zgg; float* Z1f;
    __device__ __forceinline__ void operator()(const Acc& acc, const Unit& u, int wr, int wc, int fr, int fq) const {
        const int row0 = u.pm * BM + wr * 64 + fr, cl = wc * 32 + 4 * fq, pn = u.pn;
        if (pn == 1) {
#pragma unroll
            for (int ai = 0; ai < 2; ++ai)
#pragma unroll
                for (int m = 0; m < 4; ++m) { float* rowp = Z1f + (size_t)(row0 + ai * HALF + m * 16) * 256 + cl;
#pragma unroll
                    for (int bj = 0; bj < 2; ++bj)
#pragma unroll
                        for (int n = 0; n < 2; ++n) *(f32x4*)(rowp + bj * HALF + n * 16) = acc[ai][bj][m][n]; }
        } else {
            bf16_t* base; int ld, cb;
            if (pn == 0) { base = Zq; ld = 256; cb = 0; }
            else if (pn < 4) { base = Zgqk; ld = 512; cb = (pn - 2) * 256; }
            else if (pn < 6) { base = Zgv; ld = 512; cb = (pn - 4) * 256; }
            else { base = Zgg; ld = 512; cb = (pn - 6) * 256; }
#pragma unroll
            for (int ai = 0; ai < 2; ++ai)
#pragma unroll
                for (int m = 0; m < 4; ++m) { bf16_t* rowp = base + (size_t)(row0 + ai * HALF + m * 16) * ld + cb + cl;
#pragma unroll
                    for (int bj = 0; bj < 2; ++bj)
#pragma unroll
                        for (int n = 0; n < 2; ++n) { const f32x4 v = acc[ai][bj][m][n]; u32x2 w; w.x = cvt_pk_bf16(v[0], v[1]); w.y = cvt_pk_bf16(v[2], v[3]);
                            *(u32x2*)(rowp + bj * HALF + n * 16) = w; } }
        }
    }
};
struct EpiQ {
    __device__ __forceinline__ void done(const Unit&, int) const {}
    bf16_t* Q;
    __device__ __forceinline__ void operator()(const Acc& acc, const Unit& u, int wr, int wc, int fr, int fq) const {
        const int row0 = u.pm * BM + wr * 64 + fr, col0 = u.pn * BM + wc * 32 + 4 * fq;
#pragma unroll
        for (int ai = 0; ai < 2; ++ai)
#pragma unroll
            for (int m = 0; m < 4; ++m) { bf16_t* rowp = Q + (size_t)(row0 + ai * HALF + m * 16) * QP + col0;
#pragma unroll
                for (int bj = 0; bj < 2; ++bj)
#pragma unroll
                    for (int n = 0; n < 2; ++n) { const f32x4 v = acc[ai][bj][m][n]; u32x2 w; w.x = cvt_pk_bf16(v[0], v[1]); w.y = cvt_pk_bf16(v[2], v[3]);
                        *(u32x2*)(rowp + bj * HALF + n * 16) = w; } }
    }
};
struct EpiKV {
    __device__ __forceinline__ void done(const Unit&, int) const {}
    bf16_t* KV;
    __device__ __forceinline__ void operator()(const Acc& acc, const Unit& u, int wr, int wc, int fr, int fq) const {
        const int row0 = u.pm * BM + wr * 64 + fr, col0 = u.pn * BM + wc * 32 + 4 * fq;
#pragma unroll
        for (int bj = 0; bj < 2; ++bj)
#pragma unroll
            for (int n = 0; n < 2; ++n) { const int c = col0 + bj * HALF + n * 16, h = c >> 7, part = (c >> 6) & 1, idx = c & 63, dc = h * KVH + (part ? 96 + idx : idx);
#pragma unroll
                for (int ai = 0; ai < 2; ++ai)
#pragma unroll
                    for (int m = 0; m < 4; ++m) { const int t = row0 + ai * HALF + m * 16; const f32x4 v = acc[ai][bj][m][n];
                        u32x2 w; w.x = cvt_pk_bf16(v[0], v[1]); w.y = cvt_pk_bf16(v[2], v[3]);
                        *(u32x2*)(KV + (size_t)t * KVP + dc) = w; } }
    }
};

template <class Epi, bool ALIGN_EPI, class Sched = StaticOrder>
__device__ __forceinline__ void gemm_phase(LAS unsigned char* lds, const Gemm g, const Sched& S, const Epi& E, int wave) {
    const int wid = wave, lane = lane_id_opaque(), tid = wid * 64 + lane, wr = wid >> 2, wc = wid & 3, fr = lane & 15, fq = lane >> 4;
    const int K = g.K, nt = K / BK;
    unsigned voffA[2], voffB[2];
#pragma unroll
    for (int i = 0; i < 2; ++i) { int R, C; stage_rc(tid * 16 + i * 8192, R, C);
        voffA[i] = (unsigned)(R * g.lda + C) * 2u; voffB[i] = (unsigned)(R * g.ldb + C) * 2u; }
    const size_t kstep = (size_t)(BK * 2);
    const size_t hstepA = (size_t)HALF * g.lda * 2, hstepB = (size_t)HALF * g.ldb * 2;
    const size_t tstepA = 2 * hstepA, tstepB = 2 * hstepB;
    const unsigned ldsw = (unsigned)wid * 1024u;
    const int aoff = lds_byte(wr * 64 + fr, fq * 8), boff = lds_byte(wc * 32 + fr, fq * 8);
#define PG8_SA(b, h) (((b) * 2 + (h)) * HTB)
#define PG8_SB(b, h) ((4 + (b) * 2 + (h)) * HTB)
#define PG8_STAGE(bufoff, gbase, voff) do { _Pragma("unroll") for (int _i = 0; _i < 2; ++_i) \
        __builtin_amdgcn_global_load_lds((const unsigned*)((const char*)(gbase) + (voff)[_i]), (LAS unsigned*)(lds + (bufoff) + ldsw + _i * 8192), 16, 0, 0); } while (0)
#define PG8_LDA(dst, b, h) do { _Pragma("unroll") for (int m = 0; m < 4; ++m) _Pragma("unroll") for (int k = 0; k < 2; ++k) dst[m][k] = *(const LAS bf16x8*)(lds + PG8_SA(b, h) + aoff + m * 2048 + k * 1024); } while (0)
#define PG8_LDB(dst, b, h) do { _Pragma("unroll") for (int n = 0; n < 2; ++n) _Pragma("unroll") for (int k = 0; k < 2; ++k) dst[n][k] = *(const LAS bf16x8*)(lds + PG8_SB(b, h) + boff + n * 2048 + k * 1024); } while (0)
#define PG8_MMA(ai, bj, At, Bt) do { __builtin_amdgcn_s_setprio(1); _Pragma("unroll") for (int m = 0; m < 4; ++m) _Pragma("unroll") for (int n = 0; n < 2; ++n) _Pragma("unroll") for (int k = 0; k < 2; ++k) \
        acc[ai][bj][m][n] = __builtin_amdgcn_mfma_f32_16x16x32_bf16(Bt[n][k], At[m][k], acc[ai][bj][m][n], 0, 0, 0); __builtin_amdgcn_s_setprio(0); } while (0)
#define PG8_WAIT_V(n) asm volatile("s_waitcnt vmcnt(" #n ")" ::: "memory")
#define PG8_WAIT_L(n) asm volatile("s_waitcnt lgkmcnt(" #n ")" ::: "memory")
#define PG8_BAR __builtin_amdgcn_s_barrier()
#define PG8_SCHED __builtin_amdgcn_sched_barrier(0)
    Unit cur, nxt; int ui = 0;
    if (!S.next(0, cur)) return;
    Acc acc;
#pragma unroll
    for (int a = 0; a < 2; ++a)
#pragma unroll
        for (int b = 0; b < 2; ++b)
#pragma unroll
            for (int m = 0; m < 4; ++m)
#pragma unroll
                for (int n = 0; n < 2; ++n) acc[a][b][m][n] = (f32x4){0.f, 0.f, 0.f, 0.f};
    bf16x8 At[4][2], B0[2][2], B1[2][2];
    const char* cA = (const char*)g.A + (size_t)cur.pm * tstepA; const char* cB = (const char*)g.Bt + (size_t)cur.pn * tstepB;
    PG8_STAGE(PG8_SB(0, 0), cB, voffB); PG8_STAGE(PG8_SB(0, 1), cB + hstepB, voffB); PG8_STAGE(PG8_SA(0, 0), cA, voffA); PG8_STAGE(PG8_SA(0, 1), cA + hstepA, voffA);
    if (wr == 1) PG8_BAR;
    PG8_WAIT_V(2); PG8_BAR;
    PG8_STAGE(PG8_SB(1, 0), cB + kstep, voffB); PG8_STAGE(PG8_SA(1, 0), cA + kstep, voffA); PG8_STAGE(PG8_SB(1, 1), cB + hstepB + kstep, voffB);
    PG8_WAIT_V(6); PG8_BAR;
    for (;;) {
        const bool has_next = S.next(ui + 1, nxt);
        const char* nA = has_next ? (const char*)g.A + (size_t)nxt.pm * tstepA : cA; const char* nB = has_next ? (const char*)g.Bt + (size_t)nxt.pn * tstepB : cB;
        for (int t = 0; t < nt; t += 2) {
            const bool last = (t == nt - 2);
            const char* a1 = cA + (size_t)(t + 1) * kstep;
            const char* a2 = last ? nA : cA + (size_t)(t + 2) * kstep; const char* b2 = last ? nB : cB + (size_t)(t + 2) * kstep;
            const char* a3 = a2 + kstep; const char* b3 = b2 + kstep;
            PG8_LDB(B0, 0, 0); PG8_LDB(B1, 0, 1); PG8_SCHED; PG8_LDA(At, 0, 0); PG8_STAGE(PG8_SA(1, 1), a1 + hstepA, voffA);
            PG8_WAIT_V(8); PG8_WAIT_L(0); PG8_BAR; PG8_MMA(0, 0, At, B0); PG8_MMA(0, 1, At, B1); PG8_BAR; PG8_SCHED;
            PG8_LDA(At, 0, 1); PG8_STAGE(PG8_SB(0, 0), b2, voffB); PG8_STAGE(PG8_SB(0, 1), b2 + hstepB, voffB); PG8_STAGE(PG8_SA(0, 0), a2, voffA);
            PG8_WAIT_V(8); PG8_WAIT_L(0); PG8_BAR; PG8_MMA(1, 0, At, B0); PG8_MMA(1, 1, At, B1); PG8_BAR; PG8_SCHED;
            PG8_LDB(B0, 1, 0); PG8_LDB(B1, 1, 1); PG8_SCHED; PG8_LDA(At, 1, 0); PG8_STAGE(PG8_SA(0, 1), a2 + hstepA, voffA);
            PG8_WAIT_V(8); PG8_WAIT_L(0); PG8_BAR; PG8_MMA(0, 0, At, B0); PG8_MMA(0, 1, At, B1); PG8_BAR; PG8_SCHED;
            PG8_LDA(At, 1, 1); PG8_STAGE(PG8_SB(1, 0), b3, voffB); PG8_STAGE(PG8_SB(1, 1), b3 + hstepB, voffB); PG8_STAGE(PG8_SA(1, 0), a3, voffA);
            PG8_WAIT_V(8); PG8_WAIT_L(0); PG8_BAR; PG8_MMA(1, 0, At, B0); PG8_MMA(1, 1, At, B1); PG8_BAR; PG8_SCHED;
        }
        if constexpr (ALIGN_EPI) { if (wr == 0) PG8_BAR; }
        { const int l2 = lane_id_opaque(); E(acc, cur, wr, wc, l2 & 15, l2 >> 4); E.done(cur, l2); }
        if (!has_next) break;
#pragma unroll
        for (int a = 0; a < 2; ++a)
#pragma unroll
            for (int b = 0; b < 2; ++b)
#pragma unroll
                for (int m = 0; m < 4; ++m)
#pragma unroll
                    for (int n = 0; n < 2; ++n) acc[a][b][m][n] = (f32x4){0.f, 0.f, 0.f, 0.f};
        cur = nxt; cA = nA; cB = nB; ++ui;
        if constexpr (ALIGN_EPI) { if (wr == 1) PG8_BAR; }
    }
    PG8_WAIT_V(0);
    if constexpr (!ALIGN_EPI) { if (wr == 0) PG8_BAR; }
    PG8_BAR;
#undef PG8_SA
#undef PG8_SB
#undef PG8_STAGE
#undef PG8_LDA
#undef PG8_LDB
#undef PG8_MMA
#undef PG8_WAIT_V
#undef PG8_WAIT_L
#undef PG8_BAR
#undef PG8_SCHED
}
}

namespace att {
constexpr int NW = 8, QBLK = 32, KVBLK = 64;
constexpr float SCALE = 0.10206207261596575f;
constexpr float THR = 8.f;
constexpr int SHM_V = 16384, SHM_K = 16384, SHM_ATTN = 2 * SHM_V + 2 * SHM_K + NW * 64 * 4;
#define KSWZ(row, colB) ((row) * 256 + ((colB) ^ (((row) & 7) << 4)))
#define SBAR() __builtin_amdgcn_sched_barrier(0)
__device__ __forceinline__ int crow(int r, int hi) { return (r & 3) + 8 * (r >> 2) + 4 * hi; }

__device__ __forceinline__ void partialSM(f32x16& p0, f32x16& p1, float& m_reg, float& mn, float& alpha) {
  constexpr float C = SCALE * 1.4426950408889634f;
  float pmax = p0[0];
#pragma unroll
  for (int r = 1; r < 16; ++r) pmax = fmaxf(pmax, p0[r]);
#pragma unroll
  for (int r = 0; r < 16; ++r) pmax = fmaxf(pmax, p1[r]);
  { auto rr = __builtin_amdgcn_permlane32_swap(__float_as_uint(pmax), __float_as_uint(pmax), false, false);
    pmax = fmaxf(__uint_as_float(rr[0]), __uint_as_float(rr[1])); }
  if (__builtin_expect(__all(pmax - m_reg <= THR / SCALE), 1)) { mn = m_reg; alpha = 1.f; }
  else { mn = fmaxf(m_reg, pmax); alpha = __builtin_amdgcn_exp2f((m_reg - mn) * C); m_reg = mn; }
  float mnC = -mn * C;
#pragma unroll
  for (int r = 0; r < 16; ++r) p0[r] = fmaf(p0[r], C, mnC);
#pragma unroll
  for (int r = 0; r < 16; ++r) p1[r] = fmaf(p1[r], C, mnC);
#pragma unroll
  for (int r = 0; r < 16; ++r) p0[r] = __builtin_amdgcn_exp2f(p0[r]);
}
__device__ __forceinline__ void finishSM(f32x16& p0, f32x16& p1, float alpha, float& l_reg, bf16x8& pa0, bf16x8& pa1, bf16x8& pa2, bf16x8& pa3) {
#pragma unroll
  for (int r = 0; r < 16; ++r) p1[r] = __builtin_amdgcn_exp2f(p1[r]);
  float ps = 0;
#pragma unroll
  for (int r = 0; r < 16; ++r) ps += p0[r];
#pragma unroll
  for (int r = 0; r < 16; ++r) ps += p1[r];
  { auto rr = __builtin_amdgcn_permlane32_swap(__float_as_uint(ps), __float_as_uint(ps), false, false);
    ps = __uint_as_float(rr[0]) + __uint_as_float(rr[1]); }
  l_reg = l_reg * alpha + ps;
#define PK4(P, BASE, OUT) do { unsigned a0 = cvt_pk_bf16(P[BASE + 0], P[BASE + 1]), a1 = cvt_pk_bf16(P[BASE + 2], P[BASE + 3]);   \
    unsigned b0 = cvt_pk_bf16(P[BASE + 4], P[BASE + 5]), b1 = cvt_pk_bf16(P[BASE + 6], P[BASE + 7]);                              \
    auto r0 = __builtin_amdgcn_permlane32_swap(a0, b0, false, false); auto r1 = __builtin_amdgcn_permlane32_swap(a1, b1, false, false); \
    u32x4 w = {r0[0], r1[0], r0[1], r1[1]}; OUT = __builtin_bit_cast(bf16x8, w); } while (0)
  PK4(p0, 0, pa0); PK4(p0, 8, pa1); PK4(p1, 0, pa2); PK4(p1, 8, pa3);
#undef PK4
}
__device__ __forceinline__ void qkt(f32x16& p0, f32x16& p1, const LAS char* Ks, const bf16x8* qr, int r32, int hi) {
  p0 = f32x16{}; p1 = f32x16{};
#pragma unroll
  for (int d0 = 0; d0 < 6; ++d0) { int cb = (d0 * 16 + hi * 8) * 2;
    bf16x8 b0 = *reinterpret_cast<const LAS bf16x8*>(Ks + KSWZ(r32, cb));
    bf16x8 b1 = *reinterpret_cast<const LAS bf16x8*>(Ks + KSWZ(32 + r32, cb));
    p0 = __builtin_amdgcn_mfma_f32_32x32x16_bf16(b0, qr[d0], p0, 0, 0, 0);
    p1 = __builtin_amdgcn_mfma_f32_32x32x16_bf16(b1, qr[d0], p1, 0, 0, 0); }
}
__device__ __forceinline__ int v_st(int k, int c) { const int kk = (k & ~0xC) | ((k & 4) << 1) | ((k & 8) >> 1); return ((kk >> 3) * 4 + (c >> 5)) * 512 + ((kk & 7) * 32 + (c & 31)) * 2; }
__device__ __forceinline__ int v_rd_base(int lane) { return ((lane & 3) << 3) | (((lane >> 2) & 3) << 6) | (((lane >> 4) & 1) << 5) | (((lane >> 5) & 1) << 8); }
constexpr int v_rd_off(int d0, int ks, int half) { return d0 * 512 + ks * 4096 + half * 2048; }
template <int OFF> __device__ __forceinline__ s16x4 tr_read(int vb) {
  s16x4 r; asm volatile("ds_read_b64_tr_b16 %0, %1 offset:%2" : "=&v"(r) : "v"(vb), "i"(OFF) : "memory"); return r;
}
template <int D0> __device__ __forceinline__ void pv_one(f32x16& od, int vb, bf16x8 pa0, bf16x8 pa1, bf16x8 pa2, bf16x8 pa3) {
  const s16x4 l0 = tr_read<v_rd_off(D0, 0, 0)>(vb), h0 = tr_read<v_rd_off(D0, 0, 1)>(vb), l1 = tr_read<v_rd_off(D0, 1, 0)>(vb), h1 = tr_read<v_rd_off(D0, 1, 1)>(vb);
  const s16x4 l2 = tr_read<v_rd_off(D0, 2, 0)>(vb), h2 = tr_read<v_rd_off(D0, 2, 1)>(vb), l3 = tr_read<v_rd_off(D0, 3, 0)>(vb), h3 = tr_read<v_rd_off(D0, 3, 1)>(vb);
  asm volatile("s_waitcnt lgkmcnt(0)" ::: "memory"); SBAR();
#define PK(L, H) (bf16x8){L[0], L[1], L[2], L[3], H[0], H[1], H[2], H[3]}
  od = __builtin_amdgcn_mfma_f32_32x32x16_bf16(pa0, PK(l0, h0), od, 0, 0, 0);
  od = __builtin_amdgcn_mfma_f32_32x32x16_bf16(pa1, PK(l1, h1), od, 0, 0, 0);
  od = __builtin_amdgcn_mfma_f32_32x32x16_bf16(pa2, PK(l2, h2), od, 0, 0, 0);
  od = __builtin_amdgcn_mfma_f32_32x32x16_bf16(pa3, PK(l3, h3), od, 0, 0, 0);
#undef PK
}
__device__ __forceinline__ void pv_d0(f32x16* o, int vb, bf16x8 pa0, bf16x8 pa1, bf16x8 pa2, bf16x8 pa3) {
  pv_one<0>(o[0], vb, pa0, pa1, pa2, pa3); pv_one<1>(o[1], vb, pa0, pa1, pa2, pa3);
}

__device__ __forceinline__ void attn_unit(const bf16* __restrict__ Qb, const bf16* __restrict__ KVh, bf16* __restrict__ Ob, int seq, LAS char* lds, int t0, const f32x2* __restrict__ tab, int wave) {
  const int wid = wave, lane = lane_id_opaque(), tid = wid * 64 + lane, r32 = lane & 31, hi = lane >> 5;
  LAS char* V_lds = lds; LAS char* K_lds = lds + 2 * SHM_V;
  LAS float* ws = (LAS float*)(lds + 2 * SHM_V + 2 * SHM_K) + wid * 64; LAS float* li_l = ws; LAS float* al_l = ws + 32;
  float m_reg = -1e30f, l_reg = 0; f32x16 o[2] = {}; bf16x8 qr[6];
  const bf16* Qw = Qb + (long)(wid * QBLK + r32) * QP + hi * 8;
#pragma unroll
  for (int d0 = 0; d0 < 6; ++d0) qr[d0] = *reinterpret_cast<const bf16x8*>(Qw + d0 * 16);
  {
    const int t = t0 + wid * QBLK + r32;
#pragma unroll
    for (int a = 0; a < 2; ++a) { const int pos = a ? (t & 63) : (t >> 6); const u32x4 w = __builtin_bit_cast(u32x4, qr[4 + a]); u32x4 o;
#pragma unroll
      for (int p = 0; p < 4; ++p) { const f32x2 cs = tab[pos * 8 + 4 * hi + p]; const float x1 = bflo(w[p]), x2 = bfhi(w[p]);
        o[p] = cvt_pk_bf16(x1 * cs.x - x2 * cs.y, x2 * cs.x + x1 * cs.y); }
      qr[4 + a] = __builtin_bit_cast(bf16x8, o); } }
  int goff[3], loff[3];
#pragma unroll
  for (int i = 0; i < 3; ++i) { int q = tid + 512 * i; if (q >= 1280) q -= 1280; const int key = q / 20, cc = q % 20;
    goff[i] = key * KVP + cc * 8;
    loff[i] = cc < 12 ? (2 * SHM_V + KSWZ(key, cc * 16)) : v_st(key, (cc - 12) * 8); }
  const bool w3 = tid < 256;
  const int vb0 = (int)(uintptr_t)V_lds + v_rd_base(lane);
  struct { bf16x8 c[3]; } sr_[2];
#define SLOAD(i, k0) do { _Pragma("unroll") for (int _j = 0; _j < 3; ++_j) sr_[i].c[_j] = *reinterpret_cast<const bf16x8*>(KVh + (long)(k0) * KVP + goff[_j]); } while (0)
#define SWRITE(b, i) do { *(LAS bf16x8*)(lds + (b) * SHM_V + loff[0]) = sr_[i].c[0]; *(LAS bf16x8*)(lds + (b) * SHM_V + loff[1]) = sr_[i].c[1]; \
    if (w3) *(LAS bf16x8*)(lds + (b) * SHM_V + loff[2]) = sr_[i].c[2]; } while (0)
#define SWAIT() asm volatile("s_waitcnt vmcnt(3)" ::: "memory")
#define RESC(a) do { if (__any((a) < 1.f)) { if (hi == 0) al_l[r32] = (a); asm volatile("s_waitcnt lgkmcnt(0)" ::: "memory"); \
    _Pragma("unroll") for (int d = 0; d < 2; ++d) _Pragma("unroll") for (int r = 0; r < 16; ++r) o[d][r] *= al_l[crow(r, hi)]; } } while (0)
  f32x16 pA0, pA1, pB0, pB1; float mnA, mnB, alA, alB; bf16x8 pa0, pa1, pa2, pa3; const int NT = seq / KVBLK;
  constexpr int SE = 0, SO = 1;
  SLOAD(SE, 0); asm volatile("s_waitcnt vmcnt(0)" ::: "memory"); SWRITE(0, SE); __syncthreads();
  qkt(pA0, pA1, K_lds, qr, r32, hi); partialSM(pA0, pA1, m_reg, mnA, alA);
  SLOAD(SO, KVBLK); if (2 < NT) SLOAD(SE, 2 * KVBLK);
  SWAIT(); SWRITE(1, SO); __syncthreads();
  for (int j = 1; j + 1 < NT; j += 2) {
    SBAR(); qkt(pB0, pB1, K_lds + SHM_K, qr, r32, hi);
    finishSM(pA0, pA1, alA, l_reg, pa0, pa1, pa2, pa3); SBAR();
    SLOAD(SO, (j + 2) * KVBLK); SBAR();
    pv_d0(o, vb0, pa0, pa1, pa2, pa3); partialSM(pB0, pB1, m_reg, mnB, alB);
    __syncthreads(); SWAIT(); SWRITE(0, SE);
    RESC(alB); __syncthreads();
    SBAR(); qkt(pA0, pA1, K_lds, qr, r32, hi);
    finishSM(pB0, pB1, alB, l_reg, pa0, pa1, pa2, pa3); SBAR();
    if (j + 3 < NT) SLOAD(SE, (j + 3) * KVBLK); SBAR();
    pv_d0(o, vb0 + SHM_V, pa0, pa1, pa2, pa3); partialSM(pA0, pA1, m_reg, mnA, alA);
    __syncthreads(); SWAIT(); SWRITE(1, SO);
    RESC(alA); __syncthreads();
  }
  SBAR(); qkt(pB0, pB1, K_lds + SHM_K, qr, r32, hi);
  finishSM(pA0, pA1, alA, l_reg, pa0, pa1, pa2, pa3); SBAR();
  pv_d0(o, vb0, pa0, pa1, pa2, pa3); partialSM(pB0, pB1, m_reg, mnB, alB);
  __syncthreads(); RESC(alB);
  finishSM(pB0, pB1, alB, l_reg, pa0, pa1, pa2, pa3); SBAR();
  pv_d0(o, vb0 + SHM_V, pa0, pa1, pa2, pa3);
  if (hi == 0) li_l[r32] = l_reg; asm volatile("s_waitcnt lgkmcnt(0)" ::: "memory");
  float rli[16];
#pragma unroll
  for (int r = 0; r < 16; ++r) rli[r] = __builtin_amdgcn_rcpf(li_l[crow(r, hi)]);
  bf16* Ow = Ob + (long)(wid * QBLK) * DM;
#pragma unroll
  for (int r = 0; r < 16; ++r) { int orow = crow(r, hi);
#pragma unroll
    for (int d0 = 0; d0 < 2; ++d0) Ow[(long)orow * DM + d0 * 32 + r32] = (bf16)f2bf(o[d0][r] * rli[r]); }
  __syncthreads();
#undef SLOAD
#undef SWRITE
#undef SWAIT
#undef RESC
}
}

typedef GAS unsigned gu32;
#define RLX_AGENT __ATOMIC_RELAXED, __HIP_MEMORY_SCOPE_AGENT
#define XB_TMO      128
#define XB_XCNT(j)  (256  + 64 * (j))
#define XB_XSUB(j)  (1280 + 64 * (j))
#define XB_XGEN(j)  (2304 + 64 * (j))
#define XB_TOP      3328
#define XB_TOPGEN   3392
#define XCD_BAR_WORDS 3456
#define XB_SPIN_CAP (1u << 21)
__device__ __forceinline__ unsigned xb_ld(unsigned* p)              { return __hip_atomic_load(p, __ATOMIC_RELAXED, __HIP_MEMORY_SCOPE_AGENT); }
__device__ __forceinline__ unsigned xb_add(unsigned* p, unsigned v) { return __hip_atomic_fetch_add(p, v, __ATOMIC_RELAXED, __HIP_MEMORY_SCOPE_AGENT); }
__device__ __forceinline__ unsigned xb_xcc_id() { return (unsigned)__builtin_amdgcn_s_getreg((3 << 11) | 20) & 0xFu; }
#define XB_CODE 192
#define XB_SPIN(cond, bar, code) do { unsigned _sp = 0; while (cond) { __builtin_amdgcn_s_sleep(1); \
    if ((++_sp & 255u) == 0u) { if (xb_ld(&(bar)[XB_TMO])) break; if (_sp > XB_SPIN_CAP) { atomicCAS(&(bar)[XB_CODE], 0u, (unsigned)(code)); atomicAdd(&(bar)[XB_TMO], 1u); break; } } } } while (0)
struct XcdBarrier { unsigned* bar; unsigned x; volatile LAS unsigned* st; };
__device__ __forceinline__ XcdBarrier xcd_barrier_post(unsigned* bar, volatile LAS unsigned* st, int tid) {
    XcdBarrier b; b.bar = bar; b.x = xb_xcc_id(); b.st = st;
    if (tid == 0) (void)xb_add(&bar[XB_XCNT(b.x)], 1u);
    return b;
}
__device__ __forceinline__ void xcd_barrier_complete(unsigned* bar, unsigned x, unsigned& nloc, unsigned& nx) {
    const unsigned G = gridDim.x * gridDim.y * gridDim.z;
    unsigned sum, cnt, mine, sp = 0u;
    for (;;) {
        sum = 0u; cnt = 0u; mine = 0u;
#pragma unroll
        for (unsigned j = 0; j < 16; ++j) { const unsigned c = xb_ld(&bar[XB_XCNT(j)]); sum += c; cnt += (c > 0u) ? 1u : 0u; mine = (j == x) ? c : mine; }
        if (sum == G) break;
        __builtin_amdgcn_s_sleep(1);
        if ((++sp & 255u) == 0u) { if (xb_ld(&bar[XB_TMO])) break; if (sp > XB_SPIN_CAP) { atomicCAS(&bar[XB_CODE], 0u, 1u); atomicAdd(&bar[XB_TMO], 1u); break; } }
    }
    nloc = mine > 0u ? mine : 1u; nx = cnt > 0u ? cnt : 1u;
}
__device__ __forceinline__ void xcd_barrier(const XcdBarrier& b, unsigned seq, int tid) {
    asm volatile("s_waitcnt vmcnt(0)" ::: "memory");
    __syncthreads();
    if (tid == 0) {
        unsigned* bar = b.bar;
        __builtin_amdgcn_s_waitcnt(0);
        unsigned nloc = b.st[0], nx = b.st[1];
        if (nloc == 0u) { xcd_barrier_complete(bar, b.x, nloc, nx); b.st[0] = nloc; b.st[1] = nx; }
        const unsigned old = xb_add(&bar[XB_XSUB(b.x)], 1u);
        const unsigned gen = old / nloc;
        if (old + 1u == (gen + 1u) * nloc) {
            __builtin_amdgcn_fence(__ATOMIC_RELEASE, "agent");
            asm volatile("s_waitcnt vmcnt(0)" ::: "memory");
            const unsigned og = xb_add(&bar[XB_TOP], 1u);
            const unsigned tg = og / nx;
            if (og + 1u == (tg + 1u) * nx) xb_add(&bar[XB_TOPGEN], 1u);
            else XB_SPIN(xb_ld(&bar[XB_TOPGEN]) == tg, bar, 10u * seq + 2u);
            __builtin_amdgcn_fence(__ATOMIC_ACQUIRE, "agent");
            xb_add(&bar[XB_XGEN(b.x)], 1u);
            asm volatile("s_waitcnt vmcnt(0)" ::: "memory");
        } else {
            XB_SPIN(xb_ld(&bar[XB_XGEN(b.x)]) == gen, bar, 10u * seq + 3u);
            __builtin_amdgcn_fence(__ATOMIC_ACQUIRE, "agent");
            asm volatile("s_waitcnt vmcnt(0)" ::: "memory");
        }
    }
    __syncthreads();
}

constexpr int NWAVES = 8;
constexpr int RING_OFF = 0, RING_BYTES = 131072;
constexpr int LDSCTL_OFF = RING_BYTES, MISC_OFF = LDSCTL_OFF + 320;
constexpr int LDS_BYTES = 147456;
static_assert(att::SHM_ATTN <= RING_BYTES, "attention LDS");

struct Frame {
    LAS unsigned char* lds;
    volatile LAS unsigned* MISC;
    int tid, lane, wave, vcu, G;
    const float* in[23]; float* out; unsigned char* ws;
};
enum { I_X = 0, I_C, I_CTX, I_CCTX, I_WADA, I_BADA, I_NPRE, I_NPOST, I_F1IN, I_F1OUT, I_F2IN, I_F2OUT, I_WIN, I_QNORM, I_WQB, I_KVNORM, I_WKVB,
       I_WAF, I_BAF, I_WAB, I_BAB, I_GNORM, I_WOUT };

template <class Map>
__device__ __forceinline__ void transpose_item(const float* W, int Ns, bf16* WT, int ldd, LAS float* scr, int k0, int n0, int lane, Map srcmap) {
    const int sc = srcmap(n0 + (lane & 31));
#pragma unroll 8
    for (int i = 0; i < 32; ++i) { const int kk = 2 * i + (lane >> 5); scr[kk * 33 + (lane & 31)] = sc >= 0 ? W[(size_t)(k0 + kk) * Ns + sc] : 0.f; }
    LDS_WAIT(); asm volatile("" ::: "memory");
    const int c = lane & 7;
#pragma unroll
    for (int j = 0; j < 4; ++j) { const int n = (lane >> 3) + 8 * j; const LAS float* s = scr + (8 * c) * 33 + n;
        u32x4 o; o.x = cvt_pk_bf16(s[0 * 33], s[1 * 33]); o.y = cvt_pk_bf16(s[2 * 33], s[3 * 33]); o.z = cvt_pk_bf16(s[4 * 33], s[5 * 33]); o.w = cvt_pk_bf16(s[6 * 33], s[7 * 33]);
        *(GAS u32x4*)(WT + (size_t)(n0 + n) * ldd + k0 + 8 * c) = o; }
    LDS_WAIT(); asm volatile("" ::: "memory");
}
struct MapId { __device__ int operator()(int n) const { return n; } };
struct MapFfnIn { __device__ int operator()(int n) const { const int pn = n >> 8, c = n & 255; return c < 128 ? 128 * pn + c : DFF + 128 * pn + (c - 128); } };
struct MapWin { __device__ int operator()(int n) const {
    if (n < 416) return n;
    if (n < 448) return 1952 + (n - 416);
    if (n < 512) return -1;
    if (n < 768) return 416 + (n - 512);
    if (n < 1024) return 672 + (n - 768);
    if (n < 1536) return 928 + (n - 1024);
    return 1440 + (n - 1536); } };
struct MapWqb { __device__ int operator()(int n) const { const int h = n / QH, j = n % QH; if (j < 64) return h * QH + j;
    const int jj = j - 64, i = jj >> 1, p = jj & 1, a = i >> 3, f = i & 7; return h * QH + 64 + 16 * a + 8 * p + f; } };

__device__ __forceinline__ void p0_prologue(Frame& F) {
    LAS float* scr = (LAS float*)(F.lds + RING_OFF + F.wave * 16384);
    const int gw = F.vcu * NWAVES + F.wave, NGW = F.G * NWAVES;
    for (int idx = F.vcu * 512 + F.tid; idx < 2048; idx += F.G * 512) {
        const int pos = idx >> 3, f = idx & 7;
        const float invf = f == 0 ? 1.0f : f == 1 ? 0.31622776601683794f : f == 2 ? 0.1f : f == 3 ? 0.031622776601683794f : f == 4 ? 0.01f : f == 5 ? 0.0031622776601683794f : f == 6 ? 0.001f : 0.00031622776601683794f;
        const float ang = (float)pos * invf;
        double t = (double)ang * 0.15915494309189535; t -= floor(t);
        const float tf = (float)t;
        f32x2 cs; cs.x = __builtin_amdgcn_cosf(tf); cs.y = __builtin_amdgcn_sinf(tf);
        ((f32x2*)(F.ws + WS_ROPE))[idx] = cs;
    }
    if (F.vcu < 144) {
        LAS float* sl = (LAS float*)(F.lds + 100 * 1024);
        LAS float* red = (LAS float*)(F.lds + 108 * 1024);
        for (int i = F.tid; i < 2048; i += 512) { const float v = i < 1024 ? F.in[I_C][i] : F.in[I_CCTX][i - 1024]; sl[i] = v / (1.0f + expf(-v)); }
        __syncthreads();
        for (int u = F.vcu; u < 144; u += F.G) {
            const int cq = F.tid & 15, kg = F.tid >> 4;
            const float* Wp = F.in[I_WADA] + (size_t)u * 64 + cq * 4;
            f32x4 al = {0.f, 0.f, 0.f, 0.f}, ac = {0.f, 0.f, 0.f, 0.f};
#pragma unroll 8
            for (int i = 0; i < 32; ++i) { const int k = kg + 32 * i; const f32x4 w = *(const f32x4*)(Wp + (size_t)k * NMODV); al += w * sl[k]; ac += w * sl[1024 + k]; }
            *(LAS f32x4*)(red + kg * 128 + cq * 4) = al; *(LAS f32x4*)(red + kg * 128 + 64 + cq * 4) = ac;
            __syncthreads();
            if (F.tid < 128) { float s = 0.f;
#pragma unroll
                for (int g = 0; g < 32; ++g) s += red[g * 128 + F.tid];
                const int ty = F.tid >> 6, col = u * 64 + (F.tid & 63);
                ((float*)(F.ws + WS_MOD))[ty * NMODV + col] = s + F.in[I_BADA][col]; }
            __syncthreads();
        }
    }
    constexpr int I_1IN = 16 * 176, I_1OUT = 44 * 32, I_WN = 16 * 64, I_QB = 4 * 24, I_KVB = 2 * 32, I_OUT = 16 * 32;
    constexpr int NITEMS = 2 * I_1IN + 2 * I_1OUT + I_WN + I_QB + I_KVB + I_OUT;
    for (int it = gw; it < NITEMS; it += NGW) {
        int r = it;
        if (r < I_1IN) { transpose_item(F.in[I_F1IN], 2 * DFF, (bf16*)(F.ws + WS_W1IN), DM, scr, 64 * (r / 176), 32 * (r % 176), F.lane, MapFfnIn()); continue; } r -= I_1IN;
        if (r < I_1IN) { transpose_item(F.in[I_F2IN], 2 * DFF, (bf16*)(F.ws + WS_W2IN), DM, scr, 64 * (r / 176), 32 * (r % 176), F.lane, MapFfnIn()); continue; } r -= I_1IN;
        if (r < I_1OUT) { transpose_item(F.in[I_F1OUT], DM, (bf16*)(F.ws + WS_W1OUT), DFF, scr, 64 * (r / 32), 32 * (r % 32), F.lane, MapId()); continue; } r -= I_1OUT;
        if (r < I_1OUT) { transpose_item(F.in[I_F2OUT], DM, (bf16*)(F.ws + WS_W2OUT), DFF, scr, 64 * (r / 32), 32 * (r % 32), F.lane, MapId()); continue; } r -= I_1OUT;
        if (r < I_WN) { transpose_item(F.in[I_WIN], 1984, (bf16*)(F.ws + WS_WIN), DM, scr, 64 * (r / 64), 32 * (r % 64), F.lane, MapWin()); continue; } r -= I_WN;
        if (r < I_QB) { transpose_item(F.in[I_WQB], QP, (bf16*)(F.ws + WS_WQB), 256, scr, 64 * (r / 24), 32 * (r % 24), F.lane, MapWqb()); continue; } r -= I_QB;
        if (r < I_KVB) { transpose_item(F.in[I_WKVB], 1024, (bf16*)(F.ws + WS_WKVB), 256, scr, 64 * (r / 32), 32 * (r % 32), F.lane, MapId()); continue; } r -= I_KVB;
        transpose_item(F.in[I_WOUT], DM, (bf16*)(F.ws + WS_WOUT), DM, scr, 64 * (r / 32), 32 * (r % 32), F.lane, MapId());
    }
    for (int i = F.vcu * 512 + F.tid; i < 1024 * 16; i += F.G * 512) { const int n = i >> 4, c = i & 15;
        *(GAS u32x4*)((bf16*)(F.ws + WS_WKVB) + (size_t)n * 256 + 128 + c * 8) = (u32x4){0u, 0u, 0u, 0u}; }
}

__device__ __forceinline__ void norm_row(int lane, const float* src, const float* y, float gsc, const float* gate, const float* gpost, float* resout,
                                         const float* gpre, const float* shift, const float* scale, bf16* hout, int nsl = 1, size_t sstride = 0) {
    f32x4 v[4];
#pragma unroll
    for (int j = 0; j < 4; ++j) v[j] = *((const f32x4*)src + lane + 64 * j);
    if (y) {
        f32x4 yv[4]; float s = 0.f;
#pragma unroll
        for (int j = 0; j < 4; ++j) { yv[j] = *((const f32x4*)y + lane + 64 * j);
            for (int sl = 1; sl < nsl; ++sl) yv[j] += *((const f32x4*)(y + sl * sstride) + lane + 64 * j);
            s += (yv[j].x * yv[j].x + yv[j].y * yv[j].y) + (yv[j].z * yv[j].z + yv[j].w * yv[j].w); }
        const float rstd = 1.0f / sqrtf(wave_sum(s) * (1.f / DM) + EPS);
#pragma unroll
        for (int j = 0; j < 4; ++j) { const f32x4 g = *((const f32x4*)gate + lane + 64 * j), p = *((const f32x4*)gpost + lane + 64 * j);
            v[j] = v[j] + (yv[j] * rstd) * p * g * gsc; }
    }
    if (resout) {
#pragma unroll
        for (int j = 0; j < 4; ++j) *((f32x4*)resout + lane + 64 * j) = v[j];
    }
    if (hout) {
        float s = 0.f;
#pragma unroll
        for (int j = 0; j < 4; ++j) s += (v[j].x * v[j].x + v[j].y * v[j].y) + (v[j].z * v[j].z + v[j].w * v[j].w);
        const float rstd = 1.0f / sqrtf(wave_sum(s) * (1.f / DM) + EPS);
#pragma unroll
        for (int j = 0; j < 4; ++j) { const f32x4 g = *((const f32x4*)gpre + lane + 64 * j), sh = *((const f32x4*)shift + lane + 64 * j), sc = *((const f32x4*)scale + lane + 64 * j);
            const f32x4 h = (v[j] * rstd) * g * (sc + 1.0f) + sh;
            u32x2 w; w.x = cvt_pk_bf16(h.x, h.y); w.y = cvt_pk_bf16(h.z, h.w);
            *((u32x2*)hout + lane + 64 * j) = w; }
    }
}

__device__ __forceinline__ void mixer_rows4(Frame& F, int rowb) {
    const int lane = lane_id_opaque();
    const bf16* Zq = (const bf16*)(F.ws + WS_ZQ); const float* Z1f = (const float*)(F.ws + WS_Z1F);
    bf16* KV = (bf16*)(F.ws + WS_KV);
    const bool lat = rowb >= CTX;
    u32x2 qw[4]; f32x4 cv[4]; float x1[4], x2[4];
    const int pi = lane & 15, pa = pi >> 3, pf = pi & 7;
#pragma unroll
    for (int k = 0; k < 4; ++k) { const size_t row = (size_t)(rowb + k);
        qw[k] = lat ? *((const u32x2*)(Zq + row * 256) + lane) : (u32x2){0u, 0u};
        cv[k] = lane < 32 ? *((const f32x4*)(Z1f + row * 256) + lane) : (f32x4){0.f, 0.f, 0.f, 0.f};
        x1[k] = Z1f[row * 256 + 128 + 16 * pa + pf]; x2[k] = Z1f[row * 256 + 128 + 16 * pa + 8 + pf]; }
    const f32x4 gq = *((const f32x4*)F.in[I_QNORM] + lane);
    const f32x4 gk = lane < 32 ? *((const f32x4*)F.in[I_KVNORM] + lane) : (f32x4){0.f, 0.f, 0.f, 0.f};
#pragma unroll
    for (int k = 0; k < 4; ++k) { const int row = rowb + k;
        if (lat) {
            const float a = bflo(qw[k].x), b = bfhi(qw[k].x), c = bflo(qw[k].y), d = bfhi(qw[k].y);
            const float rstd = 1.0f / sqrtf(wave_sum((a * a + b * b) + (c * c + d * d)) * (1.f / 256.f) + EPS);
            u32x2 o; o.x = cvt_pk_bf16(a * rstd * gq.x, b * rstd * gq.y); o.y = cvt_pk_bf16(c * rstd * gq.z, d * rstd * gq.w);
            *((u32x2*)((bf16*)(F.ws + WS_QN) + (size_t)(row - CTX) * 256) + lane) = o; }
        {
            const f32x4 v = cv[k];
            const float rstd = 1.0f / sqrtf(wave_sum((v.x * v.x + v.y * v.y) + (v.z * v.z + v.w * v.w)) * (1.f / 128.f) + EPS);
            u32x2 o; o.x = cvt_pk_bf16(v.x * rstd * gk.x, v.y * rstd * gk.y); o.y = cvt_pk_bf16(v.z * rstd * gk.z, v.w * rstd * gk.w);
            *((u32x2*)((bf16*)(F.ws + WS_KVN) + (size_t)row * 256) + lane) = o; }
        if (lane < 16) {
            float o1 = x1[k], o2 = x2[k];
            if (lat) { const int t = row - CTX, pos = pa ? (t & 63) : (t >> 6); const f32x2 cs = ((const f32x2*)(F.ws + WS_ROPE))[pos * 8 + pf];
                o1 = x1[k] * cs.x - x2[k] * cs.y; o2 = x2[k] * cs.x + x1[k] * cs.y; }
            const unsigned pk = cvt_pk_bf16(o1, o2);
#pragma unroll
            for (int h = 0; h < 8; ++h) *(unsigned*)(KV + (size_t)row * KVP + h * KVH + 64 + 2 * pi) = pk; } }
}

template <int DIR>
__device__ __forceinline__ void gla_prep_qk(Frame& F, int cn, int h, LAS float* gal) {
    const int lane = lane_id_opaque(), c = h * 64 + lane;
    const float* wa = F.in[DIR ? I_WAB : I_WAF]; const float bb = F.in[DIR ? I_BAB : I_BAF][c];
    const int row0 = cn * 64;
    {
        const float* gp = (const float*)(F.ws + WS_Z1F) + (size_t)(row0 + lane) * 256 + 160 + 16 * DIR;
#pragma unroll
        for (int q4 = 0; q4 < 4; ++q4) *(LAS f32x4*)(gal + lane * 16 + q4 * 4) = *(const f32x4*)(gp + q4 * 4);
    }
    float w[16];
#pragma unroll
    for (int r = 0; r < 16; ++r) w[r] = wa[r * 256 + c];
    LDS_WAIT(); asm volatile("" ::: "memory");
    const bf16* Zg = (const bf16*)(F.ws + WS_ZGQK);
    float Gs[64]; float G = 0.f;
#pragma unroll
    for (int s = 0; s < 64; ++s) { const int i = DIR ? 63 - s : s;
        float lg = bb;
#pragma unroll
        for (int q4 = 0; q4 < 4; ++q4) { const f32x4 g4 = *(const LAS f32x4*)(gal + i * 16 + q4 * 4);
            lg = fmaf(g4.x, w[4 * q4], lg); lg = fmaf(g4.y, w[4 * q4 + 1], lg); lg = fmaf(g4.z, w[4 * q4 + 2], lg); lg = fmaf(g4.w, w[4 * q4 + 3], lg); }
        const float la = (fminf(lg, 0.f) - __logf(1.0f + __expf(-fabsf(lg)))) * (1.0f / 16.0f);
        G += la; Gs[i] = G; }
    const float Glast = G, Gref = DIR ? Gs[32] : Gs[31];
    const size_t aidx = ((size_t)DIR * NCH + cn) * 256 + c;
    float* aux = (float*)(F.ws + WS_AUX);
    aux[aidx] = __expf(Glast); aux[AUX_N + aidx] = __expf(Glast - Gref); aux[2 * AUX_N + aidx] = __expf(Gref);
    bf16* Qt = (bf16*)(F.ws + WS_QT) + (size_t)DIR * ROWS * 256; bf16* Kt = (bf16*)(F.ws + WS_KT) + (size_t)DIR * ROWS * 256;
    bf16* KtT = (bf16*)(F.ws + WS_KTT) + (((size_t)DIR * NCH + cn) * 256 + c) * 64;
#pragma unroll
    for (int hf = 0; hf < 2; ++hf) { unsigned short qv[32], kv[32];
#pragma unroll
        for (int t = 0; t < 32; ++t) { const size_t ro = (size_t)(row0 + hf * 32 + t); qv[t] = Zg[ro * 512 + c]; kv[t] = Zg[ro * 512 + 256 + c]; }
#pragma unroll
        for (int g8 = 0; g8 < 4; ++g8) { float kt[8];
#pragma unroll
            for (int t = 0; t < 8; ++t) { const int i = hf * 32 + g8 * 8 + t; const size_t ro = (size_t)(row0 + i);
                const float qt = bf2f(qv[g8 * 8 + t]) * 0.125f * __expf(Gs[i] - Gref); kt[t] = bf2f(kv[g8 * 8 + t]) * __expf(Gref - Gs[i]);
                Qt[ro * 256 + c] = (bf16)f2bf(qt); Kt[ro * 256 + c] = (bf16)f2bf(kt[t]); }
            u32x4 o; o.x = cvt_pk_bf16(kt[0], kt[1]); o.y = cvt_pk_bf16(kt[2], kt[3]); o.z = cvt_pk_bf16(kt[4], kt[5]); o.w = cvt_pk_bf16(kt[6], kt[7]);
            *(u32x4*)(KtT + hf * 32 + g8 * 8) = o; } }
    LDS_WAIT(); asm volatile("" ::: "memory");
}
__device__ __forceinline__ void gla_prep_v(Frame& F, int cn, int grp) {
    const int col = grp * 64 + lane_id_opaque();
    const bf16* Zv = (const bf16*)(F.ws + WS_ZGV) + (size_t)cn * 64 * 512 + col;
    bf16* vT = (bf16*)(F.ws + WS_VT) + ((size_t)cn * 512 + col) * 64;
    unsigned short e[64];
#pragma unroll
    for (int t = 0; t < 64; ++t) e[t] = Zv[(size_t)t * 512];
#pragma unroll
    for (int g8 = 0; g8 < 8; ++g8) { u32x4 o; o.x = e[8 * g8 + 0] | ((unsigned)e[8 * g8 + 1] << 16); o.y = e[8 * g8 + 2] | ((unsigned)e[8 * g8 + 3] << 16);
        o.z = e[8 * g8 + 4] | ((unsigned)e[8 * g8 + 5] << 16); o.w = e[8 * g8 + 6] | ((unsigned)e[8 * g8 + 7] << 16);
        *(u32x4*)(vT + g8 * 8) = o; }
}

__device__ __forceinline__ void gla_pass_l(Frame& F, int task) {
    const int lane = lane_id_opaque(), r = lane & 31, hi = lane >> 5;
    const int cn = task % NCH, dh = task / NCH, h = dh & 3, dir = dh >> 2;
    const bf16* vTp = (const bf16*)(F.ws + WS_VT) + ((size_t)cn * 512 + h * 128) * 64;
    const bf16* kTp = (const bf16*)(F.ws + WS_KTT) + (((size_t)dir * NCH + cn) * 256 + h * 64) * 64;
    bf16* Lp = (bf16*)(F.ws + WS_LS) + (((size_t)(dir * 4 + h) * NCH + cn) * 128) * 64;
    bf16x8 bfr[2][4];
#pragma unroll
    for (int nt = 0; nt < 2; ++nt)
#pragma unroll
        for (int s = 0; s < 4; ++s) bfr[nt][s] = *(const bf16x8*)(kTp + (32 * nt + r) * 64 + 16 * s + 8 * hi);
#pragma unroll
    for (int mt = 0; mt < 4; ++mt) { bf16x8 afr[4]; bf16* pm = Lp + (4 * hi) * 64 + r + (32 * mt) * 64;
#pragma unroll
        for (int s = 0; s < 4; ++s) afr[s] = *(const bf16x8*)(vTp + (32 * mt + r) * 64 + 16 * s + 8 * hi);
#pragma unroll
        for (int nt = 0; nt < 2; ++nt) { f32x16 acc = {};
#pragma unroll
            for (int s = 0; s < 4; ++s) acc = __builtin_amdgcn_mfma_f32_32x32x16_bf16(afr[s], bfr[nt][s], acc, 0, 0, 0);
#pragma unroll
            for (int rg = 0; rg < 16; ++rg) pm[((rg & 3) + 8 * (rg >> 2)) * 64 + 32 * nt] = (bf16)f2bf(acc[rg]); } }
}

__device__ __forceinline__ void gla_pass_s(Frame& F) {
    const float* aux = (const float*)(F.ws + WS_AUX);
    for (int el = F.vcu * 256 + F.tid; F.tid < 256 && el < 65536; el += F.G * 256) {
        const int d = el & 63, e = (el >> 6) & 127, dh = el >> 13, h = dh & 3, dir = dh >> 2;
        bf16* Lp = (bf16*)(F.ws + WS_LS) + ((size_t)dh * NCH * 128 + e) * 64 + d;
        const float* ap = aux + (size_t)dir * NCH * 256 + h * 64 + d;
        float S = 0.f;
        for (int p0 = 0; p0 < NCH; p0 += 10) { float lv[10], dc[10], sc[10], er[10]; int cn[10];
#pragma unroll
            for (int u = 0; u < 10; ++u) { const int p = p0 + u; cn[u] = dir ? (p < 4 ? 3 - p : 263 - p) : p;
                lv[u] = bf2f(Lp[(size_t)cn[u] * 8192]); dc[u] = ap[cn[u] * 256]; sc[u] = ap[AUX_N + cn[u] * 256]; er[u] = ap[2 * AUX_N + cn[u] * 256]; }
#pragma unroll
            for (int u = 0; u < 10; ++u) { Lp[(size_t)cn[u] * 8192] = (bf16)f2bf(S * er[u]); S = dc[u] * S + sc[u] * lv[u]; } }
    }
}

template <int DIR, int IT>
__device__ __forceinline__ void gla_o_dir(Frame& F, f32x16 (&o)[4], int h, int cn, int r, int hi) {
    const size_t row0 = (size_t)cn * 64;
    const bf16* Qp = (const bf16*)(F.ws + WS_QT) + ((size_t)DIR * ROWS + row0) * 256 + h * 64;
    const bf16* Kp = (const bf16*)(F.ws + WS_KT) + ((size_t)DIR * ROWS + row0) * 256 + h * 64;
    const bf16* Sp = (const bf16*)(F.ws + WS_LS) + (((size_t)(DIR * 4 + h) * NCH + cn) * 128) * 64;
    const bf16* vTp = (const bf16*)(F.ws + WS_VT) + ((size_t)cn * 512 + h * 128) * 64;
    bf16x8 qf[4];
#pragma unroll
    for (int s = 0; s < 4; ++s) qf[s] = *(const bf16x8*)(Qp + (size_t)(32 * IT + r) * 256 + 16 * s + 8 * hi);
#pragma unroll
    for (int jt = 0; jt < 2; ++jt) {
        if (DIR == 0 ? (jt > IT) : (jt < IT)) continue;
        bf16x8 kf[4];
#pragma unroll
        for (int s = 0; s < 4; ++s) kf[s] = *(const bf16x8*)(Kp + (size_t)(32 * jt + r) * 256 + 16 * s + 8 * hi);
        f32x16 X = {};
#pragma unroll
        for (int s = 0; s < 4; ++s) X = __builtin_amdgcn_mfma_f32_32x32x16_bf16(kf[s], qf[s], X, 0, 0, 0);
        if (jt == IT) {
#pragma unroll
            for (int rg = 0; rg < 16; ++rg) { const int j = att::crow(rg, hi); const bool keep = DIR == 0 ? (j <= r) : (j >= r); X[rg] = keep ? X[rg] : 0.f; } }
        bf16x8 xa[2];
#pragma unroll
        for (int s2 = 0; s2 < 2; ++s2) { u32x4 w; w.x = cvt_pk_bf16(X[8 * s2 + 0], X[8 * s2 + 1]); w.y = cvt_pk_bf16(X[8 * s2 + 2], X[8 * s2 + 3]);
            w.z = cvt_pk_bf16(X[8 * s2 + 4], X[8 * s2 + 5]); w.w = cvt_pk_bf16(X[8 * s2 + 6], X[8 * s2 + 7]); xa[s2] = __builtin_bit_cast(bf16x8, w); }
#pragma unroll
        for (int nt = 0; nt < 4; ++nt)
#pragma unroll
            for (int s2 = 0; s2 < 2; ++s2) { const bf16* vp = vTp + (size_t)(32 * nt + r) * 64 + 32 * jt + 16 * s2 + 4 * hi;
                const u32x2 lo = *(const u32x2*)vp, hi8 = *(const u32x2*)(vp + 8);
                const u32x4 bw = {lo.x, lo.y, hi8.x, hi8.y};
                o[nt] = __builtin_amdgcn_mfma_f32_32x32x16_bf16(xa[s2], __builtin_bit_cast(bf16x8, bw), o[nt], 0, 0, 0); }
    }
#pragma unroll
    for (int nt = 0; nt < 4; ++nt)
#pragma unroll
        for (int s = 0; s < 4; ++s) { const bf16x8 sf = *(const bf16x8*)(Sp + (size_t)(32 * nt + r) * 64 + 16 * s + 8 * hi);
            o[nt] = __builtin_amdgcn_mfma_f32_32x32x16_bf16(qf[s], sf, o[nt], 0, 0, 0); }
}
template <int IT>
__device__ __forceinline__ void gla_pass_o(Frame& F, int h, int cn) {
    const int lane = lane_id_opaque(), r = lane & 31, hi = lane >> 5;
    f32x16 o[4];
#pragma unroll
    for (int nt = 0; nt < 4; ++nt) o[nt] = f32x16{};
    gla_o_dir<0, IT>(F, o, h, cn, r, hi);
    gla_o_dir<1, IT>(F, o, h, cn, r, hi);
    const bf16* Zgg = (const bf16*)(F.ws + WS_ZGG); bf16* mix = (bf16*)(F.ws + WS_MIX);
    float gn[4];
#pragma unroll
    for (int nt = 0; nt < 4; ++nt) gn[nt] = F.in[I_GNORM][32 * nt + r];
#pragma unroll
    for (int rg = 0; rg < 16; ++rg) {
        float ss = 0.f;
#pragma unroll
        for (int nt = 0; nt < 4; ++nt) ss += o[nt][rg] * o[nt][rg];
        ss = half_sum(ss);
        const float rstd = 1.0f / sqrtf(ss * (1.f / 128.f) + EPS);
        const int i = 32 * IT + att::crow(rg, hi); const size_t row = (size_t)cn * 64 + i;
#pragma unroll
        for (int nt = 0; nt < 4; ++nt) { const int e = 32 * nt + r; const float gg = bf2f(Zgg[row * 512 + h * 128 + e]);
            const float val = o[nt][rg] * rstd * gn[nt] * (gg / (1.0f + expf(-gg)));
            mix[(row - CTX) * DM + 512 + h * 128 + e] = (bf16)f2bf(val); } }
}

#ifndef PHM
#define PHM 0xFFFF
#endif
#define PH(k) ((PHM >> (k)) & 1)
struct Args { const float* in[23]; float* out; unsigned char* ws; };
__global__ void __launch_bounds__(NWAVES * 64, 2) fwd_megakernel(Args args) {
    extern __shared__ __attribute__((aligned(16))) unsigned char lds[];
    Frame F;
    F.lds = (LAS unsigned char*)lds;
    F.MISC = (volatile LAS unsigned*)(F.lds + MISC_OFF);
    F.wave = __builtin_amdgcn_readfirstlane((int)threadIdx.x >> 6); F.lane = lane_id_opaque(); F.tid = F.wave * 64 + F.lane;
    F.G = gridDim.x; { const int bx = blockIdx.x; F.vcu = (F.G % 8 == 0) ? (bx % 8) * (F.G / 8) + bx / 8 : bx; }
#pragma unroll
    for (int i = 0; i < 23; ++i) F.in[i] = args.in[i];
    F.out = args.out; F.ws = args.ws;
    for (int u = F.tid; u < (LDS_BYTES - LDSCTL_OFF) / 4; u += NWAVES * 64) ((LAS unsigned*)(F.lds + LDSCTL_OFF))[u] = 0u;
    __syncthreads();
    XcdBarrier bar = xcd_barrier_post((unsigned*)(F.ws + WS_CTL), F.MISC + 8, F.tid);
unsigned bseq = 0;
#ifdef TIMEPH
#define TSTAMP(k) do { if (blockIdx.x == 0 && F.tid == 0) ((unsigned long long*)(F.ws + WS_CTL + 32768))[k] = __builtin_amdgcn_s_memrealtime(); } while (0)
#else
#define TSTAMP(k) do { } while (0)
#endif
#define GRID_BAR() do { ++bseq; { const int l_ = lane_id_opaque(); xcd_barrier(bar, bseq, F.wave * 64 + l_); } F.lane = lane_id_opaque(); F.tid = F.wave * 64 + F.lane; TSTAMP(bseq); } while (0)
    const int gw = F.vcu * NWAVES + F.wave, NGW = F.G * NWAVES;
    const float* modl = (const float*)(F.ws + WS_MOD); const float* modc = modl + NMODV;
    bf16* hA = (bf16*)(F.ws + WS_A); float* Y = (float*)(F.ws + WS_Y);
    const float* npre = F.in[I_NPRE]; const float* npost = F.in[I_NPOST];
    LAS unsigned char* ring = F.lds + RING_OFF;

    TSTAMP(0);
    if (PH(0)) p0_prologue(F);
    GRID_BAR();
    if (PH(1)) for (int row = gw; row < ROWS; row += NGW) {
        const bool isc = row < CTX; const float* md = isc ? modc : modl;
        const float* src = isc ? F.in[I_CTX] + (size_t)row * DM : F.in[I_X] + (size_t)(row - CTX) * DM;
        norm_row(F.lane, src, nullptr, 0.f, nullptr, nullptr, nullptr, npre, md, md + DM, hA + (size_t)row * DM);
    }
    GRID_BAR();
    if (PH(2)) { unsigned* ccnt = (unsigned*)(F.ws + WS_CTL + CTL_CTXCNT);
      { const int cj = (int)blockIdx.x - (F.G >> 1);
        if (cj >= 0 && cj < 22) { pg8::Gemm g0{hA, (const bf16*)(F.ws + WS_W1IN), CTX, 2 * DFF, DM, DM, DM}; pg8::OneUnit S0{true, cj};
          pg8::EpiSwiGLU E0{(bf16*)(F.ws + WS_ACT), DFF, ccnt};
          pg8::gemm_phase<pg8::EpiSwiGLU, false, pg8::OneUnit>(ring, g0, S0, E0, F.wave); } }
      { pg8::Gemm g{hA + (size_t)CTX * DM, (const bf16*)(F.ws + WS_W1IN), SEQ, 2 * DFF, DM, DM, DM}; pg8::StaticOrder S; S.init(SEQ, 2 * DFF, F.G, (int)blockIdx.x);
        pg8::EpiSwiGLU E{(bf16*)(F.ws + WS_ACT) + (size_t)CTX * DFF, DFF, nullptr};
        pg8::gemm_phase<pg8::EpiSwiGLU, true>(ring, g, S, E, F.wave); }
      for (int j = F.G - 1 - (int)blockIdx.x; j < 4 * NSPLIT; j += F.G) { const int pn = j & 3, sp = j >> 2;
          if (F.wave == 0) { unsigned sp_ = 0; while (xb_ld(ccnt) < 22u * 8u) { __builtin_amdgcn_s_sleep(2); if (++sp_ > XB_SPIN_CAP) break; }
              __builtin_amdgcn_fence(__ATOMIC_ACQUIRE, "agent"); asm volatile("s_waitcnt vmcnt(0)" ::: "memory"); }
          __syncthreads();
          pg8::Gemm g2{(const bf16*)(F.ws + WS_ACT) + sp * 256, (const bf16*)(F.ws + WS_W1OUT) + sp * 256, 256, DM, 256, DFF, DFF}; pg8::OneUnit S2{true, pn};
          pg8::EpiF32 E2{(float*)(F.ws + WS_SLAB) + (size_t)sp * 256 * DM, DM};
          pg8::gemm_phase<pg8::EpiF32, false, pg8::OneUnit>(ring, g2, S2, E2, F.wave); } }
    GRID_BAR();
    if (PH(3)) { pg8::Gemm g{(const bf16*)(F.ws + WS_ACT) + (size_t)CTX * DFF, (const bf16*)(F.ws + WS_W1OUT), SEQ, DM, DFF, DFF, DFF}; pg8::StaticOrder S; S.init(SEQ, DM, F.G, (int)blockIdx.x);
      pg8::EpiF32 E{Y + (size_t)CTX * DM, DM};
      pg8::gemm_phase<pg8::EpiF32, true>(ring, g, S, E, F.wave); }
    GRID_BAR();
    if (PH(4)) for (int row = gw; row < ROWS; row += NGW) {
        const bool isc = row < CTX; const float* md = isc ? modc : modl;
        const float* src = isc ? F.in[I_CTX] + (size_t)row * DM : F.in[I_X] + (size_t)(row - CTX) * DM;
        float* ro = isc ? nullptr : F.out + (size_t)(row - CTX) * DM;
        const float* yr = isc ? (const float*)(F.ws + WS_SLAB) + (size_t)row * DM : Y + (size_t)row * DM;
        norm_row(F.lane, src, yr, 0.5f, md + 2 * DM, npost, ro, npre + DM, md + 3 * DM, md + 4 * DM, hA + (size_t)row * DM, isc ? NSPLIT : 1, (size_t)256 * DM);
    }
    GRID_BAR();
#if defined(STOPAT) && STOPAT == 4
    return;
#endif
    if (PH(5)) { pg8::Gemm g{hA, (const bf16*)(F.ws + WS_WIN), ROWS, 2048, DM, DM, DM}; pg8::StaticOrder S; S.init(ROWS, 2048, F.G, (int)blockIdx.x);
      pg8::EpiZ E{(bf16*)(F.ws + WS_ZQ), (bf16*)(F.ws + WS_ZGQK), (bf16*)(F.ws + WS_ZGV), (bf16*)(F.ws + WS_ZGG), (float*)(F.ws + WS_Z1F)};
      pg8::gemm_phase<pg8::EpiZ, true>(ring, g, S, E, F.wave); }
    GRID_BAR();
    if (PH(6)) for (int rb = gw * 4; rb < ROWS; rb += NGW * 4) mixer_rows4(F, rb);
    if (PH(6)) { LAS float* gal = (LAS float*)(ring + F.wave * 4096);
        for (int t = gw; t < 16 * NCH; t += NGW) { const int cn = t % NCH, sub = t / NCH;
            if (sub < 4) gla_prep_qk<0>(F, cn, sub, gal); else if (sub < 8) gla_prep_qk<1>(F, cn, sub - 4, gal); else gla_prep_v(F, cn, sub - 8); } }
    GRID_BAR();
    if (PH(7)) { pg8::Gemm g{(const bf16*)(F.ws + WS_QN), (const bf16*)(F.ws + WS_WQB), SEQ, QP, 256, 256, 256}; pg8::StaticOrder S; S.init(SEQ, QP, F.G, (int)blockIdx.x);
      pg8::EpiQ E{(bf16*)(F.ws + WS_Q)};
      pg8::gemm_phase<pg8::EpiQ, true>(ring, g, S, E, F.wave); }
    if (PH(7)) { pg8::Gemm g{(const bf16*)(F.ws + WS_KVN), (const bf16*)(F.ws + WS_WKVB), ROWS, 1024, 256, 256, 256}; pg8::StaticOrder S; S.init(ROWS, 1024, F.G, (int)((blockIdx.x + 64) % F.G));
      pg8::EpiKV E{(bf16*)(F.ws + WS_KV)};
      pg8::gemm_phase<pg8::EpiKV, true>(ring, g, S, E, F.wave); }
    if (PH(8)) for (int t = gw; t < 8 * NCH; t += NGW) gla_pass_l(F, t);
    GRID_BAR();
#if defined(STOPAT) && STOPAT == 6
    { const bf16* Qp = (const bf16*)(F.ws + WS_Q); const bf16* KVp = (const bf16*)(F.ws + WS_KV);
      for (size_t i = (size_t)blockIdx.x * 512 + F.tid; i < (size_t)SEQ * DM; i += (size_t)F.G * 512) { const size_t t = i >> 10; const int c = (int)(i & 1023);
        F.out[i] = c < 768 ? bf2f(Qp[t * QP + c]) : bf2f(KVp[(t + CTX) * KVP + (c - 768)]) + bf2f(KVp[(t + CTX) * KVP + 256 + (c - 768)]) + bf2f(KVp[t * KVP + 1024 + (c - 768)]); } }
    return;
#endif
#if defined(STOPAT) && STOPAT == 7
    { const bf16* Qt = (const bf16*)(F.ws + WS_QT); const bf16* Kt = (const bf16*)(F.ws + WS_KT); const bf16* KtT = (const bf16*)(F.ws + WS_KTT); const bf16* vT = (const bf16*)(F.ws + WS_VT);
      const bf16* LS = (const bf16*)(F.ws + WS_LS); const float* aux = (const float*)(F.ws + WS_AUX);
      for (size_t i = (size_t)blockIdx.x * 512 + F.tid; i < (size_t)SEQ * DM; i += (size_t)F.G * 512) { const size_t t = i >> 10; const int c = (int)(i & 1023);
        float v;
        if (c < 256) v = bf2f(Qt[t * 256 + c]) + bf2f(Qt[((size_t)ROWS + t) * 256 + c]);
        else if (c < 512) v = bf2f(Kt[t * 256 + c - 256]) + bf2f(Kt[((size_t)ROWS + t) * 256 + c - 256]);
        else if (c < 768) v = bf2f(KtT[i]) + bf2f(vT[i >> 1]);
        else v = bf2f(LS[i]) + bf2f(LS[i + (size_t)SEQ * DM]) + aux[i % (3 * AUX_N)];
        F.out[i] = v; } }
    return;
#endif
    if (PH(9)) gla_pass_s(F);
    TSTAMP(20);
    if (PH(10)) for (int u = F.vcu; u < 512; u += F.G) {
        const int h = (u & 255) >> 5, qb = (u & 31) + 32 * (u >> 8);
        att::attn_unit((const bf16*)(F.ws + WS_Q) + (size_t)qb * 256 * QP + h * QH, (const bf16*)(F.ws + WS_KV) + h * KVH,
                       (bf16*)(F.ws + WS_MIX) + (size_t)qb * 256 * DM + h * 64, ROWS, (LAS char*)ring, qb * 256, (const f32x2*)(F.ws + WS_ROPE), F.wave);
    }
    GRID_BAR();
#if defined(STOPAT) && STOPAT == 9
    { const bf16* LS = (const bf16*)(F.ws + WS_LS);
      for (size_t i = (size_t)blockIdx.x * 512 + F.tid; i < (size_t)SEQ * DM; i += (size_t)F.G * 512) F.out[i] = bf2f(LS[i]); }
    return;
#endif
    if (PH(11)) for (int t = gw; t < 8 * (NCH - 4); t += NGW) { const int h = (t >> 1) & 3, cn = 4 + (t >> 3); if (t & 1) gla_pass_o<1>(F, h, cn); else gla_pass_o<0>(F, h, cn); }
    GRID_BAR();
#if defined(STOPAT) && STOPAT == 8
    { const bf16* mixp = (const bf16*)(F.ws + WS_MIX);
      for (size_t i = (size_t)blockIdx.x * 512 + F.tid; i < (size_t)SEQ * DM; i += (size_t)F.G * 512) F.out[i] = bf2f(mixp[i]); }
    return;
#endif
    if (PH(12)) { pg8::Gemm g{(const bf16*)(F.ws + WS_MIX), (const bf16*)(F.ws + WS_WOUT), SEQ, DM, DM, DM, DM}; pg8::StaticOrder S; S.init(SEQ, DM, F.G, (int)blockIdx.x);
      pg8::EpiF32 E{Y, DM};
      pg8::gemm_phase<pg8::EpiF32, true>(ring, g, S, E, F.wave); }
    GRID_BAR();
    if (PH(13)) for (int row = gw; row < SEQ; row += NGW) {
        float* hr = F.out + (size_t)row * DM;
        norm_row(F.lane, hr, Y + (size_t)row * DM, 1.0f, modl + 5 * DM, npost + DM, hr, npre + 2 * DM, modl + 6 * DM, modl + 7 * DM, hA + (size_t)row * DM);
    }
    GRID_BAR();
    if (PH(14)) { pg8::Gemm g{hA, (const bf16*)(F.ws + WS_W2IN), SEQ, 2 * DFF, DM, DM, DM}; pg8::StaticOrder S; S.init(SEQ, 2 * DFF, F.G, (int)blockIdx.x);
      pg8::EpiSwiGLU E{(bf16*)(F.ws + WS_ACT), DFF, nullptr};
      pg8::gemm_phase<pg8::EpiSwiGLU, true>(ring, g, S, E, F.wave); }
    GRID_BAR();
#ifdef DIAG
    GRID_BAR();
    for (int row = gw; row < SEQ; row += NGW) { float* hr = F.out + (size_t)row * DM;
        for (int j = 0; j < 4; ++j) *((f32x4*)hr + F.lane + 64 * j) = (f32x4){0.f, 0.f, 0.f, 0.f}; }
    GRID_BAR();
    if (blockIdx.x == 0 && F.tid == 0) { unsigned* bw = (unsigned*)(F.ws + WS_CTL);
        const unsigned code = xb_ld(&bw[XB_CODE]), tmo = xb_ld(&bw[XB_TMO]);
        unsigned val = DIAG == 0 ? code : DIAG == 1 ? tmo : DIAG == 2 ? (unsigned)F.G : DIAG == 3 ? F.MISC[8] : F.MISC[9];
        F.out[(size_t)(gw) * DM] = 1.0e6f * (float)(val + 1u); }
    return;
#endif
    if (PH(15)) { pg8::Gemm g{(const bf16*)(F.ws + WS_ACT), (const bf16*)(F.ws + WS_W2OUT), SEQ, DM, DFF, DFF, DFF}; pg8::StaticOrder S; S.init(SEQ, DM, F.G, (int)blockIdx.x);
      pg8::EpiF32 E{Y, DM};
      pg8::gemm_phase<pg8::EpiF32, true>(ring, g, S, E, F.wave); }
    GRID_BAR();
    for (int row = gw; row < SEQ; row += NGW) {
        float* hr = F.out + (size_t)row * DM;
        norm_row(F.lane, hr, Y + (size_t)row * DM, 0.5f, modl + 8 * DM, npost + 2 * DM, hr, nullptr, nullptr, nullptr, nullptr);
    }
#ifdef TIMEPH
    TSTAMP(15);
    GRID_BAR();
    if (blockIdx.x == 0) { volatile unsigned long long* ts = (volatile unsigned long long*)(F.ws + WS_CTL + 32768);
        const unsigned long long d = TIMEPH < 0 ? 10000ull : ts[TIMEPH_B] - ts[TIMEPH];
        long n = (long)((double)d * 0.01 * TIMEPH_K); if (n > 330000) n = 330000;
        for (long i = F.tid; i < n; i += 512) F.out[i] += 0.05f; }
#endif
}

extern "C" void kernel_launch(void* const* d_in, const int* in_sizes, int n_in, void* d_out, int out_size, void* d_ws, size_t ws_size, hipStream_t stream) {
    static int grid = 0;
    if (grid == 0) {
        if (n_in != 23 || in_sizes[0] != SEQ * DM || out_size != SEQ * DM || ws_size < WS_END) {
            fprintf(stderr, "kernel_launch: unexpected shapes: n_in %d in0 %d out %d ws %zu\n", n_in, n_in > 0 ? in_sizes[0] : -1, out_size, ws_size); grid = -1; return; }
        int dev = 0, cus = 0, per_cu = 0;
        if (hipGetDevice(&dev) != hipSuccess || hipDeviceGetAttribute(&cus, hipDeviceAttributeMultiprocessorCount, dev) != hipSuccess) { fprintf(stderr, "kernel_launch: device query failed\n"); grid = -1; return; }
        if (hipFuncSetAttribute((const void*)fwd_megakernel, hipFuncAttributeMaxDynamicSharedMemorySize, LDS_BYTES) != hipSuccess) { fprintf(stderr, "kernel_launch: hipFuncSetAttribute failed\n"); grid = -1; return; }
        if (hipOccupancyMaxActiveBlocksPerMultiprocessor(&per_cu, (const void*)fwd_megakernel, NWAVES * 64, LDS_BYTES) != hipSuccess || per_cu < 1) {
            fprintf(stderr, "kernel_launch: occupancy query reports %d workgroups per CU\n", per_cu); (void)hipGetLastError(); grid = -1; return; }
        grid = cus;
    }
    if (grid < 0) return;
    if (hipMemsetAsync((char*)d_ws + WS_CTL, 0, CTL_ZERO_BYTES, stream) != hipSuccess) { fprintf(stderr, "kernel_launch: memset failed\n"); return; }
    Args a{};
    for (int i = 0; i < 23; ++i) a.in[i] = (const float*)d_in[i];
    a.out = (float*)d_out; a.ws = (unsigned char*)d_ws;
    hipLaunchKernelGGL(fwd_megakernel, dim3(grid), dim3(NWAVES * 64), LDS_BYTES, stream, a);
    const hipError_t le = hipPeekAtLastError();
    if (le != hipSuccess) fprintf(stderr, "kernel_launch: launch failed: %s\n", hipGetErrorName(le));
}
```

```cpp
#include <hip/hip_runtime.h>
#include <cstdio>
#include <cstdint>

#define GAS __attribute__((address_space(1)))
#define LAS __attribute__((address_space(3)))
typedef unsigned short bf16;
typedef short bf16x8 __attribute__((ext_vector_type(8)));
typedef short s16x4 __attribute__((ext_vector_type(4)));
typedef float f32x4 __attribute__((ext_vector_type(4)));
typedef float f32x2 __attribute__((ext_vector_type(2)));
typedef float f32x16 __attribute__((ext_vector_type(16)));
typedef unsigned u32x4 __attribute__((ext_vector_type(4)));
typedef unsigned u32x2 __attribute__((ext_vector_type(2)));

constexpr int DM = 1024, SEQ = 16384, CTX = 256, ROWS = SEQ + CTX, DFF = 2816, NMODV = 9 * DM;
constexpr int NCH = ROWS / 64;
constexpr float EPS = 1e-6f;
constexpr int KVP = 1280, KVH = 160;
constexpr int QP = 768, QH = 96;

constexpr size_t MiB = 1u << 20;
constexpr size_t WS_CTL = 0, CTL_ZERO_BYTES = 64 * 1024;
constexpr size_t WS_MOD = 1 * MiB;
constexpr size_t WS_ROPE = 1 * MiB + 128 * 1024;
constexpr size_t WS_W1IN = 2 * MiB;
constexpr size_t WS_W1OUT = WS_W1IN + 11 * MiB;
constexpr size_t WS_W2IN = WS_W1OUT + 5 * MiB + 512 * 1024;
constexpr size_t WS_W2OUT = WS_W2IN + 11 * MiB;
constexpr size_t WS_WIN = WS_W2OUT + 5 * MiB + 512 * 1024;
constexpr size_t WS_WQB = WS_WIN + 4 * MiB;
constexpr size_t WS_WKVB = WS_WQB + 384 * 1024;
constexpr size_t WS_WOUT = WS_WKVB + 512 * 1024;
constexpr size_t WS_A = 42 * MiB;
constexpr size_t WS_QN = WS_A;
constexpr size_t WS_KVN = WS_A + 8 * MiB;
constexpr size_t WS_MIX = WS_A;
constexpr size_t WS_B = WS_A + (size_t)ROWS * DM * 2;
constexpr size_t WS_ZQ = WS_B;
constexpr size_t WS_Z1F = WS_ZQ + (size_t)ROWS * 256 * 2;
constexpr size_t WS_Q = WS_B;
constexpr size_t WS_C = WS_Z1F + (size_t)ROWS * 256 * 4;
constexpr size_t WS_ZGQK = WS_C;
constexpr size_t WS_ZGV = WS_ZGQK + (size_t)ROWS * 512 * 2;
constexpr size_t WS_LS = WS_C;
constexpr size_t WS_ZGG = WS_ZGV + (size_t)ROWS * 512 * 2;
constexpr size_t WS_KV = WS_ZGG + (size_t)ROWS * 512 * 2;
constexpr size_t WS_QT = WS_KV + (size_t)ROWS * KVP * 2;
constexpr size_t WS_KT = WS_QT + (size_t)2 * ROWS * 256 * 2;
constexpr size_t WS_KTT = WS_KT + (size_t)2 * ROWS * 256 * 2;
constexpr size_t WS_VT = WS_KTT + (size_t)2 * ROWS * 256 * 2;
constexpr size_t WS_AUX = WS_VT + (size_t)ROWS * 512 * 2;
constexpr size_t AUX_N = (size_t)2 * NCH * 256;
constexpr size_t WS_AUX_END = WS_AUX + 3 * AUX_N * 4;
constexpr size_t WS_ACT = WS_B;
constexpr size_t WS_Y = 164 * MiB;
constexpr size_t WS_SLAB = 230 * MiB;
constexpr int NSPLIT = 11;
constexpr size_t CTL_CTXCNT = 16384;
constexpr size_t WS_END = 256 * MiB;
static_assert(WS_WOUT + 2 * MiB <= WS_A, "weights");
static_assert(WS_KVN + (size_t)ROWS * 256 * 2 <= WS_B, "qn/kvn in A");
static_assert(WS_Q + (size_t)SEQ * QP * 2 <= WS_C, "Q in B");
static_assert(WS_LS + (size_t)8 * NCH * 8192 * 2 <= WS_ZGG, "LS in C");
static_assert(WS_AUX_END <= WS_END, "aux");
static_assert(WS_ACT + (size_t)ROWS * DFF * 2 <= WS_Y && WS_Y + (size_t)ROWS * DM * 4 <= WS_END, "ffn map");
static_assert(WS_MIX + (size_t)SEQ * DM * 2 <= WS_Y, "mix below y");

typedef __bf16 bf16x2_t __attribute__((ext_vector_type(2)));
__device__ __forceinline__ unsigned cvt_pk_bf16(float lo, float hi) { f32x2 v = {lo, hi}; bf16x2_t b = __builtin_convertvector(v, bf16x2_t); return __builtin_bit_cast(unsigned, b); }
__device__ __forceinline__ unsigned f2bf(float f) { unsigned u = __builtin_bit_cast(unsigned, f); return (u + 0x7fffu + ((u >> 16) & 1u)) >> 16; }
__device__ __forceinline__ float bf2f(unsigned short b) { return __builtin_bit_cast(float, (unsigned)b << 16); }
__device__ __forceinline__ float bflo(unsigned w) { return __builtin_bit_cast(float, w << 16); }
__device__ __forceinline__ float bfhi(unsigned w) { return __builtin_bit_cast(float, w & 0xffff0000u); }
__device__ __forceinline__ float fast_silu(float a) { return a * __builtin_amdgcn_rcpf(1.0f + __builtin_amdgcn_exp2f(-a * 1.4426950408889634f)); }
template <int M> __device__ __forceinline__ float swz_xor(float v) { return __builtin_bit_cast(float, __builtin_amdgcn_ds_swizzle(__builtin_bit_cast(int, v), (M << 10) | 0x1f)); }
__device__ __forceinline__ float half_sum(float v) {
    v += swz_xor<1>(v); v += swz_xor<2>(v); v += swz_xor<4>(v); v += swz_xor<8>(v); v += swz_xor<16>(v); return v;
}
__device__ __forceinline__ float wave_sum(float v) {
    v = half_sum(v);
    auto rr = __builtin_amdgcn_permlane32_swap(__float_as_uint(v), __float_as_uint(v), false, false);
    return __uint_as_float(rr[0]) + __uint_as_float(rr[1]);
}
__device__ __forceinline__ int lane_id_opaque() { int l; asm volatile("v_mbcnt_lo_u32_b32 %0, -1, 0\n\tv_mbcnt_hi_u32_b32 %0, -1, %0" : "=v"(l)); return l; }
#define LDS_WAIT() asm volatile("s_waitcnt lgkmcnt(0)" ::: "memory")
#define VM_WAIT() asm volatile("s_waitcnt vmcnt(0)" ::: "memory")

namespace pg8 {
typedef unsigned short bf16_t;
constexpr int BM = 256, BK = 64, HALF = 128, HTB = HALF * BK * 2, STAGE_BYTES = 8 * HTB, NXCD = 8, WGM = 8;
__host__ __device__ __forceinline__ int lds_byte(int r, int c) { const int st = (r >> 4) * 2 + (c >> 5), rr = r & 15, cc = c & 31, ob = rr * 64 + cc * 2; return st * 1024 + (ob ^ (((ob >> 9) & 1) << 5)); }
__host__ __device__ __forceinline__ void stage_rc(int b, int& R, int& C) { const int st = b / 1024, sb = b % 1024, swz = sb ^ (((sb >> 9) & 1) << 5); R = (st >> 1) * 16 + swz / 64; C = (st & 1) * 32 + (swz % 64) / 2; }

struct Unit { int pm, pn; };
struct OneUnit { bool has; int pn;
    __device__ bool next(int i, Unit& u) const { if (i > 0 || !has) return false; u.pm = 0; u.pn = pn; return true; } };
struct Gemm { const bf16_t* A; const bf16_t* Bt; int M, N, K, lda, ldb; };

struct StaticOrder {
    int nM, nN, nwg, G, c;
    __host__ __device__ void init(int M, int N, int G_, int c_) { nM = M / BM; nN = N / BM; nwg = nM * nN; G = G_; c = c_; }
    __host__ __device__ bool next(int i, Unit& u) const {
        const long L = (long)i * G + c; if (L >= nwg) return false;
        int wgid = (int)L; { const int q = nwg / NXCD, r = nwg % NXCD, xcd = wgid % NXCD, off = wgid / NXCD; wgid = (xcd < r ? xcd * (q + 1) : r * (q + 1) + (xcd - r) * q) + off; }
        const int nig = WGM * nN, gid = wgid / nig, fm = gid * WGM, gsz = (nM - fm) < WGM ? (nM - fm) : WGM;
        u.pm = fm + ((wgid % nig) % gsz); u.pn = (wgid % nig) / gsz; return true;
    }
};

typedef f32x4 Acc[2][2][4][2];

struct EpiF32 {
    __device__ __forceinline__ void done(const Unit&, int) const {}
    float* C; int ldc;
    __device__ __forceinline__ void operator()(const Acc& acc, const Unit& u, int wr, int wc, int fr, int fq) const {
        const int row0 = u.pm * BM + wr * 64 + fr, col0 = u.pn * BM + wc * 32 + 4 * fq;
#pragma unroll
        for (int ai = 0; ai < 2; ++ai)
#pragma unroll
            for (int m = 0; m < 4; ++m) { float* rowp = C + (size_t)(row0 + ai * HALF + m * 16) * ldc + col0;
#pragma unroll
                for (int bj = 0; bj < 2; ++bj)
#pragma unroll
                    for (int n = 0; n < 2; ++n) *(f32x4*)(rowp + bj * HALF + n * 16) = acc[ai][bj][m][n]; }
    }
};
struct EpiSwiGLU {
    bf16_t* O; int ldo; unsigned* cnt;
    __device__ __forceinline__ void done(const Unit& u, int lane) const {
        if (cnt != nullptr && u.pm == 0) { asm volatile("s_waitcnt vmcnt(0)" ::: "memory");
            if (lane == 0) __hip_atomic_fetch_add(cnt, 1u, __ATOMIC_RELAXED, __HIP_MEMORY_SCOPE_AGENT); } }
    __device__ __forceinline__ void operator()(const Acc& acc, const Unit& u, int wr, int wc, int fr, int fq) const {
        const int row0 = u.pm * BM + wr * 64 + fr, col0 = u.pn * HALF + wc * 32 + 4 * fq;
        const bool wt = cnt != nullptr && u.pm == 0;
#pragma unroll
        for (int ai = 0; ai < 2; ++ai)
#pragma unroll
            for (int m = 0; m < 4; ++m) { bf16_t* rowp = O + (size_t)(row0 + ai * HALF + m * 16) * ldo + col0;
#pragma unroll
                for (int n = 0; n < 2; ++n) { const f32x4 a = acc[ai][0][m][n], b = acc[ai][1][m][n];
                    u32x2 w; w.x = cvt_pk_bf16(fast_silu(a[0]) * b[0], fast_silu(a[1]) * b[1]); w.y = cvt_pk_bf16(fast_silu(a[2]) * b[2], fast_silu(a[3]) * b[3]);
                    if (wt) __hip_atomic_store((unsigned long long*)(rowp + n * 16), ((unsigned long long)w.y << 32) | w.x, __ATOMIC_RELAXED, __HIP_MEMORY_SCOPE_AGENT);
                    else *(u32x2*)(rowp + n * 16) = w; } }
    }
};
struct EpiZ {
    __device__ __forceinline__ void done(const Unit&, int) const {}
    bf16_t *Zq, *Zgqk, *Zgv, *Zgg; float* Z1f;
    __device__ __forceinline__ void operator()(const Acc& acc, const Unit& u, int wr, int wc, int fr, int fq) const {
        const int row0 = u.pm * BM + wr * 64 + fr, cl = wc * 32 + 4 * fq, pn = u.pn;
        if (pn == 1) {
#pragma unroll
            for (int ai = 0; ai < 2; ++ai)
#pragma unroll
                for (int m = 0; m < 4; ++m) { float* rowp = Z1f + (size_t)(row0 + ai * HALF + m * 16) * 256 + cl;
#pragma unroll
                    for (int bj = 0; bj < 2; ++bj)
#pragma unroll
                        for (int n = 0; n < 2; ++n) *(f32x4*)(rowp + bj * HALF + n * 16) = acc[ai][bj][m][n]; }
        } else {
            bf16_t* base; int ld, cb;
            if (pn == 0) { base = Zq; ld = 256; cb = 0; }
            else if (pn < 4) { base = Zgqk; ld = 512; cb = (pn - 2) * 256; }
            else if (pn < 6) { base = Zgv; ld = 512; cb = (pn - 4) * 256; }
            else { base = Zgg; ld = 512; cb = (pn - 6) * 256; }
#pragma unroll
            for (int ai = 0; ai < 2; ++ai)
#pragma unroll
                for (int m = 0; m < 4; ++m) { bf16_t* rowp = base + (size_t)(row0 + ai * HALF + m * 16) * ld + cb + cl;
#pragma unroll
                    for (int bj = 0; bj < 2; ++bj)
#pragma unroll
                        for (int n = 0; n < 2; ++n) { const f32x4 v = acc[ai][bj][m][n]; u32x2 w; w.x = cvt_pk_bf16(v[0], v[1]); w.y = cvt_pk_bf16(v[2], v[3]);
                            *(u32x2*)(rowp + bj * HALF + n * 16) = w; } }
        }
    }
};
struct EpiQ {
    __device__ __forceinline__ void done(const Unit&, int) const {}
    bf16_t* Q; float qscale;
    __device__ __forceinline__ void operator()(const Acc& acc, const Unit& u, int wr, int wc, int fr, int fq) const {
        const int row0 = u.pm * BM + wr * 64 + fr, col0 = u.pn * BM + wc * 32 + 4 * fq;
#pragma unroll
        for (int ai = 0; ai < 2; ++ai)
#pragma unroll
            for (int m = 0; m < 4; ++m) { bf16_t* rowp = Q + (size_t)(row0 + ai * HALF + m * 16) * QP + col0;
#pragma unroll
                for (int bj = 0; bj < 2; ++bj)
#pragma unroll
                    for (int n = 0; n < 2; ++n) { const f32x4 v = acc[ai][bj][m][n] * qscale; u32x2 w; w.x = cvt_pk_bf16(v[0], v[1]); w.y = cvt_pk_bf16(v[2], v[3]);
                        *(u32x2*)(rowp + bj * HALF + n * 16) = w; } }
    }
};
struct EpiKV {
    __device__ __forceinline__ void done(const Unit&, int) const {}
    bf16_t* KV;
    __device__ __forceinline__ void operator()(const Acc& acc, const Unit& u, int wr, int wc, int fr, int fq) const {
        const int row0 = u.pm * BM + wr * 64 + fr, col0 = u.pn * BM + wc * 32 + 4 * fq;
#pragma unroll
        for (int bj = 0; bj < 2; ++bj)
#pragma unroll
            for (int n = 0; n < 2; ++n) { const int c = col0 + bj * HALF + n * 16, h = c >> 7, part = (c >> 6) & 1, idx = c & 63, dc = h * KVH + (part ? 96 + idx : idx);
#pragma unroll
                for (int ai = 0; ai < 2; ++ai)
#pragma unroll
                    for (int m = 0; m < 4; ++m) { const int t = row0 + ai * HALF + m * 16; const f32x4 v = acc[ai][bj][m][n];
                        u32x2 w; w.x = cvt_pk_bf16(v[0], v[1]); w.y = cvt_pk_bf16(v[2], v[3]);
                        *(u32x2*)(KV + (size_t)t * KVP + dc) = w; } }
    }
};

template <class Epi, bool ALIGN_EPI, class Sched = StaticOrder>
__device__ __forceinline__ void gemm_phase(LAS unsigned char* lds, const Gemm g, const Sched& S, const Epi& E, int wave) {
    const int wid = wave, lane = lane_id_opaque(), tid = wid * 64 + lane, wr = wid >> 2, wc = wid & 3, fr = lane & 15, fq = lane >> 4;
    const int K = g.K, nt = K / BK;
    unsigned voffA[2], voffB[2];
#pragma unroll
    for (int i = 0; i < 2; ++i) { int R, C; stage_rc(tid * 16 + i * 8192, R, C);
        voffA[i] = (unsigned)(R * g.lda + C) * 2u; voffB[i] = (unsigned)(R * g.ldb + C) * 2u; }
    const size_t kstep = (size_t)(BK * 2);
    const size_t hstepA = (size_t)HALF * g.lda * 2, hstepB = (size_t)HALF * g.ldb * 2;
    const size_t tstepA = 2 * hstepA, tstepB = 2 * hstepB;
    const unsigned ldsw = (unsigned)wid * 1024u;
    const int aoff = lds_byte(wr * 64 + fr, fq * 8), boff = lds_byte(wc * 32 + fr, fq * 8);
#define PG8_SA(b, h) (((b) * 2 + (h)) * HTB)
#define PG8_SB(b, h) ((4 + (b) * 2 + (h)) * HTB)
#define PG8_STAGE(bufoff, gbase, voff) do { _Pragma("unroll") for (int _i = 0; _i < 2; ++_i) \
        __builtin_amdgcn_global_load_lds((const unsigned*)((const char*)(gbase) + (voff)[_i]), (LAS unsigned*)(lds + (bufoff) + ldsw + _i * 8192), 16, 0, 0); } while (0)
#define PG8_LDA(dst, b, h) do { _Pragma("unroll") for (int m = 0; m < 4; ++m) _Pragma("unroll") for (int k = 0; k < 2; ++k) dst[m][k] = *(const LAS bf16x8*)(lds + PG8_SA(b, h) + aoff + m * 2048 + k * 1024); } while (0)
#define PG8_LDB(dst, b, h) do { _Pragma("unroll") for (int n = 0; n < 2; ++n) _Pragma("unroll") for (int k = 0; k < 2; ++k) dst[n][k] = *(const LAS bf16x8*)(lds + PG8_SB(b, h) + boff + n * 2048 + k * 1024); } while (0)
#define PG8_MMA(ai, bj, At, Bt) do { __builtin_amdgcn_s_setprio(1); _Pragma("unroll") for (int m = 0; m < 4; ++m) _Pragma("unroll") for (int n = 0; n < 2; ++n) _Pragma("unroll") for (int k = 0; k < 2; ++k) \
        acc[ai][bj][m][n] = __builtin_amdgcn_mfma_f32_16x16x32_bf16(Bt[n][k], At[m][k], acc[ai][bj][m][n], 0, 0, 0); __builtin_amdgcn_s_setprio(0); } while (0)
#define PG8_WAIT_V(n) asm volatile("s_waitcnt vmcnt(" #n ")" ::: "memory")
#define PG8_WAIT_L(n) asm volatile("s_waitcnt lgkmcnt(" #n ")" ::: "memory")
#define PG8_BAR __builtin_amdgcn_s_barrier()
#define PG8_SCHED __builtin_amdgcn_sched_barrier(0)
    Unit cur, nxt; int ui = 0;
    if (!S.next(0, cur)) return;
    Acc acc;
#pragma unroll
    for (int a = 0; a < 2; ++a)
#pragma unroll
        for (int b = 0; b < 2; ++b)
#pragma unroll
            for (int m = 0; m < 4; ++m)
#pragma unroll
                for (int n = 0; n < 2; ++n) acc[a][b][m][n] = (f32x4){0.f, 0.f, 0.f, 0.f};
    bf16x8 At[4][2], B0[2][2], B1[2][2];
    const char* cA = (const char*)g.A + (size_t)cur.pm * tstepA; const char* cB = (const char*)g.Bt + (size_t)cur.pn * tstepB;
    PG8_STAGE(PG8_SB(0, 0), cB, voffB); PG8_STAGE(PG8_SB(0, 1), cB + hstepB, voffB); PG8_STAGE(PG8_SA(0, 0), cA, voffA); PG8_STAGE(PG8_SA(0, 1), cA + hstepA, voffA);
    if (wr == 1) PG8_BAR;
    PG8_WAIT_V(2); PG8_BAR;
    PG8_STAGE(PG8_SB(1, 0), cB + kstep, voffB); PG8_STAGE(PG8_SA(1, 0), cA + kstep, voffA); PG8_STAGE(PG8_SB(1, 1), cB + hstepB + kstep, voffB);
    PG8_WAIT_V(6); PG8_BAR;
    for (;;) {
        const bool has_next = S.next(ui + 1, nxt);
        const char* nA = has_next ? (const char*)g.A + (size_t)nxt.pm * tstepA : cA; const char* nB = has_next ? (const char*)g.Bt + (size_t)nxt.pn * tstepB : cB;
        for (int t = 0; t < nt; t += 2) {
            const bool last = (t == nt - 2);
            const char* a1 = cA + (size_t)(t + 1) * kstep;
            const char* a2 = last ? nA : cA + (size_t)(t + 2) * kstep; const char* b2 = last ? nB : cB + (size_t)(t + 2) * kstep;
            const char* a3 = a2 + kstep; const char* b3 = b2 + kstep;
            PG8_LDB(B0, 0, 0); PG8_LDB(B1, 0, 1); PG8_SCHED; PG8_LDA(At, 0, 0); PG8_STAGE(PG8_SA(1, 1), a1 + hstepA, voffA);
            PG8_WAIT_V(8); PG8_WAIT_L(0); PG8_BAR; PG8_MMA(0, 0, At, B0); PG8_MMA(0, 1, At, B1); PG8_BAR; PG8_SCHED;
            PG8_LDA(At, 0, 1); PG8_STAGE(PG8_SB(0, 0), b2, voffB); PG8_STAGE(PG8_SB(0, 1), b2 + hstepB, voffB); PG8_STAGE(PG8_SA(0, 0), a2, voffA);
            PG8_WAIT_V(8); PG8_WAIT_L(0); PG8_BAR; PG8_MMA(1, 0, At, B0); PG8_MMA(1, 1, At, B1); PG8_BAR; PG8_SCHED;
            PG8_LDB(B0, 1, 0); PG8_LDB(B1, 1, 1); PG8_SCHED; PG8_LDA(At, 1, 0); PG8_STAGE(PG8_SA(0, 1), a2 + hstepA, voffA);
            PG8_WAIT_V(8); PG8_WAIT_L(0); PG8_BAR; PG8_MMA(0, 0, At, B0); PG8_MMA(0, 1, At, B1); PG8_BAR; PG8_SCHED;
            PG8_LDA(At, 1, 1); PG8_STAGE(PG8_SB(1, 0), b3, voffB); PG8_STAGE(PG8_SB(1, 1), b3 + hstepB, voffB); PG8_STAGE(PG8_SA(1, 0), a3, voffA);
            PG8_WAIT_V(8); PG8_WAIT_L(0); PG8_BAR; PG8_MMA(1, 0, At, B0); PG8_MMA(1, 1, At, B1); PG8_BAR; PG8_SCHED;
        }
        if constexpr (ALIGN_EPI) { if (wr == 0) PG8_BAR; }
        { const int l2 = lane_id_opaque(); E(acc, cur, wr, wc, l2 & 15, l2 >> 4); E.done(cur, l2); }
        if (!has_next) break;
#pragma unroll
        for (int a = 0; a < 2; ++a)
#pragma unroll
            for (int b = 0; b < 2; ++b)
#pragma unroll
                for (int m = 0; m < 4; ++m)
#pragma unroll
                    for (int n = 0; n < 2; ++n) acc[a][b][m][n] = (f32x4){0.f, 0.f, 0.f, 0.f};
        cur = nxt; cA = nA; cB = nB; ++ui;
        if constexpr (ALIGN_EPI) { if (wr == 1) PG8_BAR; }
    }
    PG8_WAIT_V(0);
    if constexpr (!ALIGN_EPI) { if (wr == 0) PG8_BAR; }
    PG8_BAR;
#undef PG8_SA
#undef PG8_SB
#undef PG8_STAGE
#undef PG8_LDA
#undef PG8_LDB
#undef PG8_MMA
#undef PG8_WAIT_V
#undef PG8_WAIT_L
#undef PG8_BAR
#undef PG8_SCHED
}
}

#ifndef ATT_V2
#define ATT_V2 1
#endif
#if ATT_V2
#define ATT_QSCALE (0.10206207261596575f * 1.4426950408889634f)
#else
#define ATT_QSCALE 1.0f
#endif
namespace att {
constexpr int NW = 8, QBLK = 32, KVBLK = 64;
constexpr float SCALE = 0.10206207261596575f;
constexpr float THR = 8.f;
constexpr int SHM_V = 16384, SHM_K = 16384, SHM_ATTN = 2 * SHM_V + 2 * SHM_K + NW * 64 * 4;
#define KSWZ(row, colB) ((row) * 256 + ((colB) ^ (((row) & 7) << 4)))
#define SBAR() __builtin_amdgcn_sched_barrier(0)
__device__ __forceinline__ int crow(int r, int hi) { return (r & 3) + 8 * (r >> 2) + 4 * hi; }

__device__ __forceinline__ void partialSM(f32x16& p0, f32x16& p1, float& m_reg, float& mn, float& alpha) {
  constexpr float C = SCALE * 1.4426950408889634f;
  float pmax = p0[0];
#pragma unroll
  for (int r = 1; r < 16; ++r) pmax = fmaxf(pmax, p0[r]);
#pragma unroll
  for (int r = 0; r < 16; ++r) pmax = fmaxf(pmax, p1[r]);
  { auto rr = __builtin_amdgcn_permlane32_swap(__float_as_uint(pmax), __float_as_uint(pmax), false, false);
    pmax = fmaxf(__uint_as_float(rr[0]), __uint_as_float(rr[1])); }
  if (__builtin_expect(__all(pmax - m_reg <= THR / SCALE), 1)) { mn = m_reg; alpha = 1.f; }
  else { mn = fmaxf(m_reg, pmax); alpha = __builtin_amdgcn_exp2f((m_reg - mn) * C); m_reg = mn; }
  float mnC = -mn * C;
#pragma unroll
  for (int r = 0; r < 16; ++r) p0[r] = fmaf(p0[r], C, mnC);
#pragma unroll
  for (int r = 0; r < 16; ++r) p1[r] = fmaf(p1[r], C, mnC);
#pragma unroll
  for (int r = 0; r < 16; ++r) p0[r] = __builtin_amdgcn_exp2f(p0[r]);
}
__device__ __forceinline__ void finishSM(f32x16& p0, f32x16& p1, float alpha, float& l_reg, bf16x8& pa0, bf16x8& pa1, bf16x8& pa2, bf16x8& pa3) {
#pragma unroll
  for (int r = 0; r < 16; ++r) p1[r] = __builtin_amdgcn_exp2f(p1[r]);
  float ps = 0;
#pragma unroll
  for (int r = 0; r < 16; ++r) ps += p0[r];
#pragma unroll
  for (int r = 0; r < 16; ++r) ps += p1[r];
  { auto rr = __builtin_amdgcn_permlane32_swap(__float_as_uint(ps), __float_as_uint(ps), false, false);
    ps = __uint_as_float(rr[0]) + __uint_as_float(rr[1]); }
  l_reg = l_reg * alpha + ps;
#define PK4(P, BASE, OUT) do { unsigned a0 = cvt_pk_bf16(P[BASE + 0], P[BASE + 1]), a1 = cvt_pk_bf16(P[BASE + 2], P[BASE + 3]);   \
    unsigned b0 = cvt_pk_bf16(P[BASE + 4], P[BASE + 5]), b1 = cvt_pk_bf16(P[BASE + 6], P[BASE + 7]);                              \
    auto r0 = __builtin_amdgcn_permlane32_swap(a0, b0, false, false); auto r1 = __builtin_amdgcn_permlane32_swap(a1, b1, false, false); \
    u32x4 w = {r0[0], r1[0], r0[1], r1[1]}; OUT = __builtin_bit_cast(bf16x8, w); } while (0)
  PK4(p0, 0, pa0); PK4(p0, 8, pa1); PK4(p1, 0, pa2); PK4(p1, 8, pa3);
#undef PK4
}
__device__ __forceinline__ void qkt(f32x16& p0, f32x16& p1, const LAS char* Ks, const bf16x8* qr, int r32, int hi) {
  p0 = f32x16{}; p1 = f32x16{};
#pragma unroll
  for (int d0 = 0; d0 < 6; ++d0) { int cb = (d0 * 16 + hi * 8) * 2;
    bf16x8 b0 = *reinterpret_cast<const LAS bf16x8*>(Ks + KSWZ(r32, cb));
    bf16x8 b1 = *reinterpret_cast<const LAS bf16x8*>(Ks + KSWZ(32 + r32, cb));
    p0 = __builtin_amdgcn_mfma_f32_32x32x16_bf16(b0, qr[d0], p0, 0, 0, 0);
    p1 = __builtin_amdgcn_mfma_f32_32x32x16_bf16(b1, qr[d0], p1, 0, 0, 0); }
}
__device__ __forceinline__ int v_st(int k, int c) { const int kk = (k & ~0xC) | ((k & 4) << 1) | ((k & 8) >> 1); return ((kk >> 3) * 4 + (c >> 5)) * 512 + ((kk & 7) * 32 + (c & 31)) * 2; }
__device__ __forceinline__ int v_rd_base(int lane) { return ((lane & 3) << 3) | (((lane >> 2) & 3) << 6) | (((lane >> 4) & 1) << 5) | (((lane >> 5) & 1) << 8); }
constexpr int v_rd_off(int d0, int ks, int half) { return d0 * 512 + ks * 4096 + half * 2048; }
template <int OFF> __device__ __forceinline__ s16x4 tr_read(int vb) {
  s16x4 r; asm volatile("ds_read_b64_tr_b16 %0, %1 offset:%2" : "=&v"(r) : "v"(vb), "i"(OFF) : "memory"); return r;
}
template <int D0> __device__ __forceinline__ void pv_one(f32x16& od, int vb, bf16x8 pa0, bf16x8 pa1, bf16x8 pa2, bf16x8 pa3) {
  const s16x4 l0 = tr_read<v_rd_off(D0, 0, 0)>(vb), h0 = tr_read<v_rd_off(D0, 0, 1)>(vb), l1 = tr_read<v_rd_off(D0, 1, 0)>(vb), h1 = tr_read<v_rd_off(D0, 1, 1)>(vb);
  const s16x4 l2 = tr_read<v_rd_off(D0, 2, 0)>(vb), h2 = tr_read<v_rd_off(D0, 2, 1)>(vb), l3 = tr_read<v_rd_off(D0, 3, 0)>(vb), h3 = tr_read<v_rd_off(D0, 3, 1)>(vb);
  asm volatile("s_waitcnt lgkmcnt(0)" ::: "memory"); SBAR();
#define PK(L, H) (bf16x8){L[0], L[1], L[2], L[3], H[0], H[1], H[2], H[3]}
  od = __builtin_amdgcn_mfma_f32_32x32x16_bf16(pa0, PK(l0, h0), od, 0, 0, 0);
  od = __builtin_amdgcn_mfma_f32_32x32x16_bf16(pa1, PK(l1, h1), od, 0, 0, 0);
  od = __builtin_amdgcn_mfma_f32_32x32x16_bf16(pa2, PK(l2, h2), od, 0, 0, 0);
  od = __builtin_amdgcn_mfma_f32_32x32x16_bf16(pa3, PK(l3, h3), od, 0, 0, 0);
#undef PK
}
__device__ __forceinline__ void pv_d0(f32x16* o, int vb, bf16x8 pa0, bf16x8 pa1, bf16x8 pa2, bf16x8 pa3) {
  pv_one<0>(o[0], vb, pa0, pa1, pa2, pa3); pv_one<1>(o[1], vb, pa0, pa1, pa2, pa3);
}

__device__ __forceinline__ void attn_unit(const bf16* __restrict__ Qb, const bf16* __restrict__ KVh, bf16* __restrict__ Ob, int seq, LAS char* lds, int t0, const f32x2* __restrict__ tab, int wave) {
  const int wid = wave, lane = lane_id_opaque(), tid = wid * 64 + lane, r32 = lane & 31, hi = lane >> 5;
  LAS char* V_lds = lds; LAS char* K_lds = lds + 2 * SHM_V;
  LAS float* ws = (LAS float*)(lds + 2 * SHM_V + 2 * SHM_K) + wid * 64; LAS float* li_l = ws; LAS float* al_l = ws + 32;
  float m_reg = -1e30f, l_reg = 0; f32x16 o[2] = {}; bf16x8 qr[6];
  const bf16* Qw = Qb + (long)(wid * QBLK + r32) * QP + hi * 8;
#pragma unroll
  for (int d0 = 0; d0 < 6; ++d0) qr[d0] = *reinterpret_cast<const bf16x8*>(Qw + d0 * 16);
  {
    const int t = t0 + wid * QBLK + r32;
#pragma unroll
    for (int a = 0; a < 2; ++a) { const int pos = a ? (t & 63) : (t >> 6); const u32x4 w = __builtin_bit_cast(u32x4, qr[4 + a]); u32x4 o;
#pragma unroll
      for (int p = 0; p < 4; ++p) { const f32x2 cs = tab[pos * 8 + 4 * hi + p]; const float x1 = bflo(w[p]), x2 = bfhi(w[p]);
        o[p] = cvt_pk_bf16(x1 * cs.x - x2 * cs.y, x2 * cs.x + x1 * cs.y); }
      qr[4 + a] = __builtin_bit_cast(bf16x8, o); } }
  int goff[3], loff[3];
#pragma unroll
  for (int i = 0; i < 3; ++i) { int q = tid + 512 * i; if (q >= 1280) q -= 1280; const int key = q / 20, cc = q % 20;
    goff[i] = key * KVP + cc * 8;
    loff[i] = cc < 12 ? (2 * SHM_V + KSWZ(key, cc * 16)) : v_st(key, (cc - 12) * 8); }
  const bool w3 = tid < 256;
  const int vb0 = (int)(uintptr_t)V_lds + v_rd_base(lane);
  struct { bf16x8 c[3]; } sr_[2];
#define SLOAD(i, k0) do { _Pragma("unroll") for (int _j = 0; _j < 3; ++_j) sr_[i].c[_j] = *reinterpret_cast<const bf16x8*>(KVh + (long)(k0) * KVP + goff[_j]); } while (0)
#define SWRITE(b, i) do { *(LAS bf16x8*)(lds + (b) * SHM_V + loff[0]) = sr_[i].c[0]; *(LAS bf16x8*)(lds + (b) * SHM_V + loff[1]) = sr_[i].c[1]; \
    if (w3) *(LAS bf16x8*)(lds + (b) * SHM_V + loff[2]) = sr_[i].c[2]; } while (0)
#define SWAIT() asm volatile("s_waitcnt vmcnt(3)" ::: "memory")
#define RESC(a) do { if (__any((a) < 1.f)) { if (hi == 0) al_l[r32] = (a); asm volatile("s_waitcnt lgkmcnt(0)" ::: "memory"); \
    _Pragma("unroll") for (int d = 0; d < 2; ++d) _Pragma("unroll") for (int r = 0; r < 16; ++r) o[d][r] *= al_l[crow(r, hi)]; } } while (0)
  f32x16 pA0, pA1, pB0, pB1; float mnA, mnB, alA, alB; bf16x8 pa0, pa1, pa2, pa3; const int NT = seq / KVBLK;
  constexpr int SE = 0, SO = 1;
  SLOAD(SE, 0); asm volatile("s_waitcnt vmcnt(0)" ::: "memory"); SWRITE(0, SE); __syncthreads();
  qkt(pA0, pA1, K_lds, qr, r32, hi); partialSM(pA0, pA1, m_reg, mnA, alA);
  SLOAD(SO, KVBLK); if (2 < NT) SLOAD(SE, 2 * KVBLK);
  SWAIT(); SWRITE(1, SO); __syncthreads();
  for (int j = 1; j + 1 < NT; j += 2) {
    SBAR(); qkt(pB0, pB1, K_lds + SHM_K, qr, r32, hi);
    finishSM(pA0, pA1, alA, l_reg, pa0, pa1, pa2, pa3); SBAR();
    SLOAD(SO, (j + 2) * KVBLK); SBAR();
    pv_d0(o, vb0, pa0, pa1, pa2, pa3); partialSM(pB0, pB1, m_reg, mnB, alB);
    __syncthreads(); SWAIT(); SWRITE(0, SE);
    RESC(alB); __syncthreads();
    SBAR(); qkt(pA0, pA1, K_lds, qr, r32, hi);
    finishSM(pB0, pB1, alB, l_reg, pa0, pa1, pa2, pa3); SBAR();
    if (j + 3 < NT) SLOAD(SE, (j + 3) * KVBLK); SBAR();
    pv_d0(o, vb0 + SHM_V, pa0, pa1, pa2, pa3); partialSM(pA0, pA1, m_reg, mnA, alA);
    __syncthreads(); SWAIT(); SWRITE(1, SO);
    RESC(alA); __syncthreads();
  }
  SBAR(); qkt(pB0, pB1, K_lds + SHM_K, qr, r32, hi);
  finishSM(pA0, pA1, alA, l_reg, pa0, pa1, pa2, pa3); SBAR();
  pv_d0(o, vb0, pa0, pa1, pa2, pa3); partialSM(pB0, pB1, m_reg, mnB, alB);
  __syncthreads(); RESC(alB);
  finishSM(pB0, pB1, alB, l_reg, pa0, pa1, pa2, pa3); SBAR();
  pv_d0(o, vb0 + SHM_V, pa0, pa1, pa2, pa3);
  if (hi == 0) li_l[r32] = l_reg; asm volatile("s_waitcnt lgkmcnt(0)" ::: "memory");
  float rli[16];
#pragma unroll
  for (int r = 0; r < 16; ++r) rli[r] = __builtin_amdgcn_rcpf(li_l[crow(r, hi)]);
  bf16* Ow = Ob + (long)(wid * QBLK) * DM;
#pragma unroll
  for (int r = 0; r < 16; ++r) { int orow = crow(r, hi);
#pragma unroll
    for (int d0 = 0; d0 < 2; ++d0) Ow[(long)orow * DM + d0 * 32 + r32] = (bf16)f2bf(o[d0][r] * rli[r]); }
  __syncthreads();
#undef SLOAD
#undef SWRITE
#undef SWAIT
#undef RESC
}
}


namespace att2 {
constexpr int NW = 8, QBLK = 32, QB = 256, KVBLK = 64, NT = ROWS / KVBLK;
__device__ __forceinline__ int crow(int r, int hi) { return (r & 3) + 8 * (r >> 2) + 4 * hi; }
#define SBAR() __builtin_amdgcn_sched_barrier(0)
constexpr int NSLOT = 3, VSLOTB = 8192, KSLOTB = 16384;
constexpr int LDS_K = 0, LDS_V = NSLOT * KSLOTB, LDS_WS = LDS_V + NSLOT * VSLOTB, LDS_OST = LDS_WS + NW * 64 * 4, LDS_BYTES2 = LDS_OST + NW * 4096;
constexpr float C2 = 0.10206207261596575f * 1.4426950408889634f;
__device__ __forceinline__ void glds16(const void* gsrc, unsigned lds_dst) { unsigned keep;
  asm volatile("s_mov_b32 %0, m0\n\ts_mov_b32 m0, %2\n\ts_nop 0\n\tglobal_load_lds_dwordx4 %1, off\n\ts_mov_b32 m0, %0" : "=&s"(keep) : "v"(gsrc), "s"(lds_dst) : "memory"); }
__device__ __forceinline__ float max3f(float a, float b, float c) { float r; asm("v_max3_f32 %0, %1, %2, %3" : "=v"(r) : "v"(a), "v"(b), "v"(c)); return r; }
__device__ __forceinline__ float max2f(float a, float b) { float r; asm("v_max_f32_e32 %0, %1, %2" : "=v"(r) : "v"(a), "v"(b)); return r; }
__device__ __forceinline__ float fadd_s(float a, float b) { float r; asm("v_add_f32_e32 %0, %1, %2" : "=v"(r) : "v"(a), "v"(b)); return r; }
__device__ __forceinline__ float fsub_s(float a, float b) { float r; asm("v_sub_f32_e32 %0, %1, %2" : "=v"(r) : "v"(a), "v"(b)); return r; }
#define WAIT_BAR(N) asm volatile("s_waitcnt vmcnt(" #N ") lgkmcnt(0)\n\ts_barrier" ::: "memory")
typedef LAS const char* lds_cptr;
typedef short v4i16_t __attribute__((ext_vector_type(4)));
__device__ __forceinline__ void qkt0(f32x16& p0, f32x16& p1, lds_cptr Kslot, const bf16x8* qr, const f32x16& negm, int r32, int hi) {
  lds_cptr kb = Kslot + hi * 1024 + r32 * 16;
#pragma unroll
  for (int d0 = 0; d0 < 6; ++d0) {
    const bf16x8 b0 = *reinterpret_cast<const LAS bf16x8*>(kb + d0 * 2048);
    const bf16x8 b1 = *reinterpret_cast<const LAS bf16x8*>(kb + d0 * 2048 + 512);
    if (d0 == 0) { p0 = __builtin_amdgcn_mfma_f32_32x32x16_bf16(b0, qr[0], negm, 0, 0, 0); p1 = __builtin_amdgcn_mfma_f32_32x32x16_bf16(b1, qr[0], negm, 0, 0, 0); }
    else { p0 = __builtin_amdgcn_mfma_f32_32x32x16_bf16(b0, qr[d0], p0, 0, 0, 0); p1 = __builtin_amdgcn_mfma_f32_32x32x16_bf16(b1, qr[d0], p1, 0, 0, 0); } }
}
__device__ __forceinline__ void kload2(bf16x8* kf, lds_cptr kp, int j) { kf[2 * j] = *(const LAS bf16x8*)(kp + j * 2048); kf[2 * j + 1] = *(const LAS bf16x8*)(kp + j * 2048 + 512); }
__device__ __forceinline__ s16x4 vtr(lds_cptr p) { return __builtin_bit_cast(s16x4, __builtin_amdgcn_ds_read_tr16_b64_v4i16((LAS v4i16_t*)p)); }
__device__ __forceinline__ float rowmax(const f32x16& p0, const f32x16& p1) {
  float a = max3f(p0[0], p0[1], p1[0]), b = max3f(p0[2], p0[3], p1[1]); a = max3f(a, p1[2], p1[3]);
#pragma unroll
  for (int r = 4; r < 16; r += 4) { a = max3f(a, p0[r], p0[r + 1]); b = max3f(b, p0[r + 2], p0[r + 3]); a = max3f(a, p1[r], p1[r + 1]); b = max3f(b, p1[r + 2], p1[r + 3]); }
  const float m = max2f(a, b);
  auto rr = __builtin_amdgcn_permlane32_swap(__float_as_uint(m), __float_as_uint(m), false, false);
  return max2f(__uint_as_float(rr[0]), __uint_as_float(rr[1]));
}
__device__ __forceinline__ void pv(f32x16* o, int vb, bf16x8 pa0, bf16x8 pa1, bf16x8 pa2, bf16x8 pa3) {
#pragma unroll
  for (int d0 = 0; d0 < 2; ++d0) { s16x4 lo[4], hi[4];
#pragma unroll
    for (int ks = 0; ks < 4; ++ks) {
      asm volatile("ds_read_b64_tr_b16 %0,%1 offset:%c2" : "=&v"(lo[ks]) : "v"(vb), "i"(d0 * 4096 + ks * 1024) : "memory");
      asm volatile("ds_read_b64_tr_b16 %0,%1 offset:%c2" : "=&v"(hi[ks]) : "v"(vb), "i"(d0 * 4096 + ks * 1024 + 512) : "memory"); }
    asm volatile("s_waitcnt lgkmcnt(0)" ::: "memory"); SBAR();
#define PK(k) (bf16x8){lo[k][0], lo[k][1], lo[k][2], lo[k][3], hi[k][0], hi[k][1], hi[k][2], hi[k][3]}
    o[d0] = __builtin_amdgcn_mfma_f32_32x32x16_bf16(pa0, PK(0), o[d0], 0, 0, 0);
    o[d0] = __builtin_amdgcn_mfma_f32_32x32x16_bf16(pa1, PK(1), o[d0], 0, 0, 0);
    o[d0] = __builtin_amdgcn_mfma_f32_32x32x16_bf16(pa2, PK(2), o[d0], 0, 0, 0);
    o[d0] = __builtin_amdgcn_mfma_f32_32x32x16_bf16(pa3, PK(3), o[d0], 0, 0, 0);
#undef PK
  }
}
template <int THRL> __device__ __forceinline__ void attn_unit(int h, int q0, const bf16* Q, const bf16* __restrict__ KV, bf16* O, char* shm, const f32x2* __restrict__ tab, int wave) {
  const int lane = lane_id_opaque(), r32 = lane & 31, hi = lane >> 5; const int wid = wave;
  const bf16* Qw = Q + (long)(q0 + wid * QBLK) * QP + h * QH;
  const bf16* Kh = KV + h * KVH; const bf16* Vh = KV + h * KVH + 96;
  const unsigned lds0 = (unsigned)(uintptr_t)shm;
  float* wsf = (float*)(shm + LDS_WS) + wid * 64;
  const bf16* ksrc0 = Kh + (long)lane * KVP + wid * 8; const bf16* ksrc1 = ksrc0 + 64;
  const bf16* vsrc = Vh + (long)(16 * (wid & 3) + (lane >> 2)) * KVP + (wid >> 2) * 32 + (lane & 3) * 8;
  const unsigned kdst = lds0 + LDS_K + wid * 1024, vdst = lds0 + LDS_V + wid * 1024;
#define DMA_K(t, vsl) do { glds16(ksrc0 + (long)(t) * KVBLK * KVP, (unsigned)__builtin_amdgcn_readfirstlane(kdst + 2 * (vsl))); glds16(ksrc1 + (long)(t) * KVBLK * KVP, (unsigned)__builtin_amdgcn_readfirstlane(kdst + 8192 + 2 * (vsl))); } while (0)
#define DMA_V(t, vsl) glds16(vsrc + (long)(t) * KVBLK * KVP, (unsigned)__builtin_amdgcn_readfirstlane(vdst + (vsl)))
  const int vb0 = (int)(lds0 + LDS_V) + ((lane >> 4) & 1) * 32 + (lane & 3) * 8 + (4 * hi + ((lane & 15) >> 2)) * 64;
  bf16x8 kf[12];
  const lds_cptr shm3 = (lds_cptr)(LAS char*)(uintptr_t)lds0; const lds_cptr kp0 = shm3 + LDS_K + hi * 1024 + r32 * 16; const lds_cptr vp0 = shm3 + LDS_V + ((lane >> 4) & 1) * 32 + (lane & 3) * 8 + (4 * hi + ((lane & 15) >> 2)) * 64;
  DMA_K(0, 0); DMA_V(0, 0); DMA_K(1, VSLOTB);
  bf16x8 qr[6];
#pragma unroll
  for (int d0 = 0; d0 < 6; ++d0) qr[d0] = *reinterpret_cast<const bf16x8*>(&Qw[(long)r32 * QP + d0 * 16 + hi * 8]);
  { const int t = q0 + wid * QBLK + r32;
#pragma unroll
    for (int a = 0; a < 2; ++a) { const int pos = a ? (t & 63) : (t >> 6); const u32x4 w = __builtin_bit_cast(u32x4, qr[4 + a]); u32x4 ow;
#pragma unroll
      for (int p = 0; p < 4; ++p) { const f32x2 cs = tab[pos * 8 + 4 * hi + p]; const float x1 = bflo(w[p]), x2 = bfhi(w[p]);
        ow[p] = cvt_pk_bf16(x1 * cs.x - x2 * cs.y, x2 * cs.x + x1 * cs.y); }
      qr[4 + a] = __builtin_bit_cast(bf16x8, ow); } }
  float mhat = 0.f, l_reg = 0.f; f32x16 o[2]; o[0] = f32x16{}; o[1] = f32x16{}; f32x16 negm = f32x16{}; asm volatile("" : "+v"(negm));
  bool resc = false;
#define START(P0, P1) do { const float rm = rowmax(P0, P1); resc = false; \
    { const float dl = rm; mhat = fadd_s(mhat, dl); \
      _Pragma("unroll") for (int r = 0; r < 16; ++r) { P0[r] = fsub_s(P0[r], dl); P1[r] = fsub_s(P1[r], dl); } \
      _Pragma("unroll") for (int r = 0; r < 16; ++r) negm[r] = -mhat; asm volatile("" : "+v"(negm)); } \
    _Pragma("unroll") for (int r = 0; r < 16; ++r) P0[r] = __builtin_amdgcn_exp2f(P0[r]); } while (0)
#define RESC() do { if (resc) { asm volatile("s_waitcnt lgkmcnt(0)" ::: "memory"); \
      _Pragma("unroll") for (int d_ = 0; d_ < 2; ++d_) _Pragma("unroll") for (int r = 0; r < 16; ++r) o[d_][r] *= wsf[crow(r, hi)]; } } while (0)
  f32x16 pA0, pA1, pB0, pB1;
  int sl_prev = 0, sl_cur = 0, sl_next = VSLOTB;
#define ROT() do { sl_prev = sl_cur; sl_cur = sl_next; sl_next = (sl_next == (NSLOT - 1) * VSLOTB) ? 0 : sl_next + VSLOTB; } while (0)
  DMA_K(2, 2 * VSLOTB);
  WAIT_BAR(2);
  qkt0(pA0, pA1, shm3 + LDS_K, qr, negm, r32, hi); asm volatile("s_nop 15\n\ts_nop 7" : "+v"(pA0), "+v"(pA1));
  START(pA0, pA1);
  _Pragma("unroll") for (int r = 0; r < 16; ++r) pA1[r] = __builtin_amdgcn_exp2f(pA1[r]);
  WAIT_BAR(0);
  DMA_K(3, 0); DMA_V(1, VSLOTB);
  ROT();
  kload2(kf, kp0 + 2 * sl_cur, 0); kload2(kf, kp0 + 2 * sl_cur, 1); kload2(kf, kp0 + 2 * sl_cur, 2); kload2(kf, kp0 + 2 * sl_cur, 3); kload2(kf, kp0 + 2 * sl_cur, 4); kload2(kf, kp0 + 2 * sl_cur, 5);
  WAIT_BAR(3);
  s16x4 vlo[8], vhi[8]; u32x4 pw0, pw1, pw2, pw3;
#define PKW(P, B) cvt_pk_bf16(P[B], P[B + 1])
#define PAF(k) __builtin_bit_cast(bf16x8, pw##k)
#define VFR(i) (bf16x8){vlo[i][0], vlo[i][1], vlo[i][2], vlo[i][3], vhi[i][0], vhi[i][1], vhi[i][2], vhi[i][3]}
#define PIN(x) asm volatile("" : "+v"(x))
#define MX3(a, b, c) __builtin_fmaxf(__builtin_fmaxf((a), (b)), (c))
#define GAPA(MF, A0, A1, A2, W0, PW) do { MF; sacc += A0; sacc += A1; sacc += A2; PIN(sacc); W0; PIN(PW); SBAR(); } while (0)
#define GAPA2(MF, A0, A1, A2, W0, W1, PW) do { MF; sacc += A0; sacc += A1; sacc += A2; PIN(sacc); W0; W1; PIN(PW); SBAR(); } while (0)
#define GAPA3(MF, W0, W1, PW) do { MF; W0; W1; PIN(PW); SBAR(); } while (0)
#define EX(v) __builtin_amdgcn_exp2f(v)
#define GAPB(MF, X, B) do { MF; X[B] = EX(X[B]); X[B + 1] = EX(X[B + 1]); X[B + 2] = EX(X[B + 2]); X[B + 3] = EX(X[B + 3]); PIN(X); SBAR(); } while (0)
#define VRD(i) do { vlo[i] = vtr(vp_ + (((i) >> 2) * 4096 + ((i) & 3) * 1024)); vhi[i] = vtr(vp_ + (((i) >> 2) * 4096 + ((i) & 3) * 1024 + 512)); } while (0)
#define KRD(G, j) do { if (G) { kload2(kf, kp0 + 2 * sl_next, j); SBAR(); } } while (0)
#define MFM(a, b, c) __builtin_amdgcn_mfma_f32_32x32x16_bf16(a, b, c, 0, 0, 0)
#define STEP(C0, C1, P0, P1, t, GK, GV, GL) do { SBAR(); \
    const lds_cptr vp_ = vp0 + sl_prev; \
    VRD(0); SBAR(); float sacc = (P0[0] + P0[1]); \
    GAPA(C0 = MFM(kf[0], qr[0], negm), P0[2], P0[3], P0[4], pw0[0] = PKW(P0, 0), pw0); \
    VRD(4); SBAR(); GAPA(C1 = MFM(kf[1], qr[0], negm), P0[5], P0[6], P0[7], pw0[1] = PKW(P0, 2), pw0); \
    VRD(1); SBAR(); GAPA(C0 = MFM(kf[2], qr[1], C0), P0[8], P0[9], P0[10], pw0[2] = PKW(P0, 4), pw0); \
    VRD(5); SBAR(); GAPA(C1 = MFM(kf[3], qr[1], C1), P0[11], P0[12], P0[13], pw0[3] = PKW(P0, 6), pw0); \
    VRD(2); SBAR(); GAPA(C0 = MFM(kf[4], qr[2], C0), P0[14], P0[15], P1[0], pw1[0] = PKW(P0, 8), pw1); \
    VRD(6); SBAR(); GAPA(C1 = MFM(kf[5], qr[2], C1), P1[1], P1[2], P1[3], pw1[1] = PKW(P0, 10), pw1); \
    VRD(3); SBAR(); GAPA(C0 = MFM(kf[6], qr[3], C0), P1[4], P1[5], P1[6], pw1[2] = PKW(P0, 12), pw1); \
    VRD(7); SBAR(); GAPA(C1 = MFM(kf[7], qr[3], C1), P1[7], P1[8], P1[9], pw1[3] = PKW(P0, 14), pw1); \
    GAPA2(C0 = MFM(kf[8], qr[4], C0), P1[10], P1[11], P1[12], pw2[0] = PKW(P1, 0), pw2[1] = PKW(P1, 2), pw2); \
    GAPA2(C1 = MFM(kf[9], qr[4], C1), P1[13], P1[14], P1[15], pw2[2] = PKW(P1, 4), pw2[3] = PKW(P1, 6), pw2); \
    GAPA3(C0 = MFM(kf[10], qr[5], C0), pw3[0] = PKW(P1, 8), pw3[1] = PKW(P1, 10), pw3); \
    GAPA3(C1 = MFM(kf[11], qr[5], C1), pw3[2] = PKW(P1, 12), pw3[3] = PKW(P1, 14), pw3); \
    l_reg += sacc; \
    if (GK) { DMA_K((t) + 3, sl_cur); } if (GV) { DMA_V((t) + 1, sl_next); } \
    { float a = MX3(C0[0], C0[1], C1[0]), b = MX3(C0[2], C0[3], C1[1]); a = MX3(a, C1[2], C1[3]); \
      _Pragma("unroll") for (int r = 4; r < 16; r += 4) { a = MX3(a, C0[r], C0[r + 1]); b = MX3(b, C0[r + 2], C0[r + 3]); a = MX3(a, C1[r], C1[r + 1]); b = MX3(b, C1[r + 2], C1[r + 3]); } \
      float rm = __builtin_fmaxf(a, b); { auto rr = __builtin_amdgcn_permlane32_swap(__float_as_uint(rm), __float_as_uint(rm), false, false); rm = __builtin_fmaxf(__uint_as_float(rr[0]), __uint_as_float(rr[1])); } \
      resc = false; \
      if (__builtin_expect(__any(rm > (float)THRL), 0)) { const float dl = __builtin_fmaxf(rm, 0.f); mhat += dl; \
        _Pragma("unroll") for (int r = 0; r < 16; ++r) { C0[r] -= dl; C1[r] -= dl; } \
        _Pragma("unroll") for (int r = 0; r < 16; ++r) negm[r] = -mhat; asm volatile("" : "+v"(negm)); \
        const float f = __builtin_amdgcn_exp2f(-dl); l_reg *= f; if (hi == 0) wsf[r32] = f; resc = true; } } \
    SBAR(); \
    GAPB(o[0] = MFM(PAF(0), VFR(0), o[0]), C0, 0); \
    KRD(GL, 0); GAPB(o[1] = MFM(PAF(0), VFR(4), o[1]), C0, 4); \
    KRD(GL, 1); GAPB(o[0] = MFM(PAF(1), VFR(1), o[0]), C0, 8); \
    KRD(GL, 2); GAPB(o[1] = MFM(PAF(1), VFR(5), o[1]), C0, 12); \
    KRD(GL, 3); GAPB(o[0] = MFM(PAF(2), VFR(2), o[0]), C1, 0); \
    KRD(GL, 4); GAPB(o[1] = MFM(PAF(2), VFR(6), o[1]), C1, 4); \
    KRD(GL, 5); GAPB(o[0] = MFM(PAF(3), VFR(3), o[0]), C1, 8); \
    GAPB(o[1] = MFM(PAF(3), VFR(7), o[1]), C1, 12); \
    } while (0)
  int t = 1;
  for (; t + 4 < NT; t += 2) {
    STEP(pB0, pB1, pA0, pA1, t, true, true, true);     WAIT_BAR(3); RESC(); ROT();
    STEP(pA0, pA1, pB0, pB1, t + 1, true, true, true); WAIT_BAR(3); RESC(); ROT();
  }
  STEP(pB0, pB1, pA0, pA1, NT - 3, false, true, true);  WAIT_BAR(1); RESC(); ROT();
  STEP(pA0, pA1, pB0, pB1, NT - 2, false, true, true);  WAIT_BAR(0); RESC(); ROT();
  STEP(pB0, pB1, pA0, pA1, NT - 1, false, false, false); RESC();
  { float sacc = pB0[0] + pB0[1];
    _Pragma("unroll") for (int r = 2; r < 16; ++r) sacc += pB0[r];
    _Pragma("unroll") for (int r = 0; r < 16; ++r) sacc += pB1[r];
    l_reg += sacc;
    pw0 = (u32x4){PKW(pB0, 0), PKW(pB0, 2), PKW(pB0, 4), PKW(pB0, 6)}; pw1 = (u32x4){PKW(pB0, 8), PKW(pB0, 10), PKW(pB0, 12), PKW(pB0, 14)};
    pw2 = (u32x4){PKW(pB1, 0), PKW(pB1, 2), PKW(pB1, 4), PKW(pB1, 6)}; pw3 = (u32x4){PKW(pB1, 8), PKW(pB1, 10), PKW(pB1, 12), PKW(pB1, 14)};
    SBAR(); pv(o, vb0 + sl_cur, PAF(0), PAF(1), PAF(2), PAF(3)); }
  { auto rr = __builtin_amdgcn_permlane32_swap(__float_as_uint(l_reg), __float_as_uint(l_reg), false, false); l_reg = __uint_as_float(rr[0]) + __uint_as_float(rr[1]); }
  if (hi == 0) wsf[32 + r32] = l_reg; asm volatile("s_waitcnt lgkmcnt(0)" ::: "memory");
  float rli[16];
#pragma unroll
  for (int r = 0; r < 16; ++r) rli[r] = __builtin_amdgcn_rcpf(wsf[32 + crow(r, hi)]);
  bf16* Ow = O + (long)(q0 + wid * QBLK) * DM + h * 64;
  { bf16* stg = (bf16*)(shm + LDS_OST) + wid * 2048;
#pragma unroll
    for (int r = 0; r < 16; ++r) { const int orow = crow(r, hi);
#pragma unroll
      for (int d0 = 0; d0 < 2; ++d0) stg[orow * 64 + d0 * 32 + r32] = (bf16)f2bf(o[d0][r] * rli[r]); }
    asm volatile("s_waitcnt lgkmcnt(0)" ::: "memory");
#pragma unroll
    for (int i = 0; i < 4; ++i) { const int row = i * 8 + (lane >> 3), ch = lane & 7; const u32x4 v = *(const u32x4*)(stg + row * 64 + ch * 8); *(u32x4*)(Ow + (long)row * DM + ch * 8) = v; } }
  asm volatile("s_waitcnt vmcnt(0) lgkmcnt(0)\n\ts_barrier" ::: "memory");
#undef DMA_K
#undef DMA_V
#undef START
#undef RESC
#undef ROT
#undef PKW
#undef PAF
#undef VFR
#undef PIN
#undef MX3
#undef GAPA
#undef GAPA2
#undef GAPA3
#undef EX
#undef GAPB
#undef VRD
#undef KRD
#undef MFM
#undef STEP
}
#undef SBAR
#undef WAIT_BAR
}

typedef GAS unsigned gu32;
#define RLX_AGENT __ATOMIC_RELAXED, __HIP_MEMORY_SCOPE_AGENT
#define XB_TMO      128
#define XB_XCNT(j)  (256  + 64 * (j))
#define XB_XSUB(j)  (1280 + 64 * (j))
#define XB_XGEN(j)  (2304 + 64 * (j))
#define XB_TOP      3328
#define XB_TOPGEN   3392
#define XCD_BAR_WORDS 3456
#define XB_SPIN_CAP (1u << 21)
__device__ __forceinline__ unsigned xb_ld(unsigned* p)              { return __hip_atomic_load(p, __ATOMIC_RELAXED, __HIP_MEMORY_SCOPE_AGENT); }
__device__ __forceinline__ unsigned xb_add(unsigned* p, unsigned v) { return __hip_atomic_fetch_add(p, v, __ATOMIC_RELAXED, __HIP_MEMORY_SCOPE_AGENT); }
__device__ __forceinline__ unsigned xb_xcc_id() { return (unsigned)__builtin_amdgcn_s_getreg((3 << 11) | 20) & 0xFu; }
#define XB_CODE 192
#define XB_SPIN(cond, bar, code) do { unsigned _sp = 0; while (cond) { __builtin_amdgcn_s_sleep(1); \
    if ((++_sp & 255u) == 0u) { if (xb_ld(&(bar)[XB_TMO])) break; if (_sp > XB_SPIN_CAP) { atomicCAS(&(bar)[XB_CODE], 0u, (unsigned)(code)); atomicAdd(&(bar)[XB_TMO], 1u); break; } } } } while (0)
struct XcdBarrier { unsigned* bar; unsigned x; volatile LAS unsigned* st; };
__device__ __forceinline__ XcdBarrier xcd_barrier_post(unsigned* bar, volatile LAS unsigned* st, int tid) {
    XcdBarrier b; b.bar = bar; b.x = xb_xcc_id(); b.st = st;
    if (tid == 0) (void)xb_add(&bar[XB_XCNT(b.x)], 1u);
    return b;
}
__device__ __forceinline__ void xcd_barrier_complete(unsigned* bar, unsigned x, unsigned& nloc, unsigned& nx) {
    const unsigned G = gridDim.x * gridDim.y * gridDim.z;
    unsigned sum, cnt, mine, sp = 0u;
    for (;;) {
        sum = 0u; cnt = 0u; mine = 0u;
#pragma unroll
        for (unsigned j = 0; j < 16; ++j) { const unsigned c = xb_ld(&bar[XB_XCNT(j)]); sum += c; cnt += (c > 0u) ? 1u : 0u; mine = (j == x) ? c : mine; }
        if (sum == G) break;
        __builtin_amdgcn_s_sleep(1);
        if ((++sp & 255u) == 0u) { if (xb_ld(&bar[XB_TMO])) break; if (sp > XB_SPIN_CAP) { atomicCAS(&bar[XB_CODE], 0u, 1u); atomicAdd(&bar[XB_TMO], 1u); break; } }
    }
    nloc = mine > 0u ? mine : 1u; nx = cnt > 0u ? cnt : 1u;
}
__device__ __forceinline__ void xcd_barrier(const XcdBarrier& b, unsigned seq, int tid) {
    asm volatile("s_waitcnt vmcnt(0)" ::: "memory");
    __syncthreads();
    if (tid == 0) {
        unsigned* bar = b.bar;
        __builtin_amdgcn_s_waitcnt(0);
        unsigned nloc = b.st[0], nx = b.st[1];
        if (nloc == 0u) { xcd_barrier_complete(bar, b.x, nloc, nx); b.st[0] = nloc; b.st[1] = nx; }
        const unsigned old = xb_add(&bar[XB_XSUB(b.x)], 1u);
        const unsigned gen = old / nloc;
        if (old + 1u == (gen + 1u) * nloc) {
            __builtin_amdgcn_fence(__ATOMIC_RELEASE, "agent");
            asm volatile("s_waitcnt vmcnt(0)" ::: "memory");
            const unsigned og = xb_add(&bar[XB_TOP], 1u);
            const unsigned tg = og / nx;
            if (og + 1u == (tg + 1u) * nx) xb_add(&bar[XB_TOPGEN], 1u);
            else XB_SPIN(xb_ld(&bar[XB_TOPGEN]) == tg, bar, 10u * seq + 2u);
            __builtin_amdgcn_fence(__ATOMIC_ACQUIRE, "agent");
            xb_add(&bar[XB_XGEN(b.x)], 1u);
            asm volatile("s_waitcnt vmcnt(0)" ::: "memory");
        } else {
            XB_SPIN(xb_ld(&bar[XB_XGEN(b.x)]) == gen, bar, 10u * seq + 3u);
            __builtin_amdgcn_fence(__ATOMIC_ACQUIRE, "agent");
            asm volatile("s_waitcnt vmcnt(0)" ::: "memory");
        }
    }
    __syncthreads();
}

constexpr int NWAVES = 8;
constexpr int RING_OFF = 0, RING_BYTES = 131072;
constexpr int LDSCTL_OFF = RING_BYTES, MISC_OFF = LDSCTL_OFF + 320;
constexpr int LDS_BYTES = 147456;
static_assert(att::SHM_ATTN <= RING_BYTES, "attention LDS");

struct Frame {
    LAS unsigned char* lds;
    volatile LAS unsigned* MISC;
    int tid, lane, wave, vcu, G;
    const float* in[23]; float* out; unsigned char* ws;
};
enum { I_X = 0, I_C, I_CTX, I_CCTX, I_WADA, I_BADA, I_NPRE, I_NPOST, I_F1IN, I_F1OUT, I_F2IN, I_F2OUT, I_WIN, I_QNORM, I_WQB, I_KVNORM, I_WKVB,
       I_WAF, I_BAF, I_WAB, I_BAB, I_GNORM, I_WOUT };

template <class Map>
__device__ __forceinline__ void transpose_item(const float* W, int Ns, bf16* WT, int ldd, LAS float* scr, int k0, int n0, int lane, Map srcmap) {
    const int sc = srcmap(n0 + (lane & 31));
#pragma unroll 8
    for (int i = 0; i < 32; ++i) { const int kk = 2 * i + (lane >> 5); scr[kk * 33 + (lane & 31)] = sc >= 0 ? W[(size_t)(k0 + kk) * Ns + sc] : 0.f; }
    LDS_WAIT(); asm volatile("" ::: "memory");
    const int c = lane & 7;
#pragma unroll
    for (int j = 0; j < 4; ++j) { const int n = (lane >> 3) + 8 * j; const LAS float* s = scr + (8 * c) * 33 + n;
        u32x4 o; o.x = cvt_pk_bf16(s[0 * 33], s[1 * 33]); o.y = cvt_pk_bf16(s[2 * 33], s[3 * 33]); o.z = cvt_pk_bf16(s[4 * 33], s[5 * 33]); o.w = cvt_pk_bf16(s[6 * 33], s[7 * 33]);
        *(GAS u32x4*)(WT + (size_t)(n0 + n) * ldd + k0 + 8 * c) = o; }
    LDS_WAIT(); asm volatile("" ::: "memory");
}
struct MapId { __device__ int operator()(int n) const { return n; } };
struct MapFfnIn { __device__ int operator()(int n) const { const int pn = n >> 8, c = n & 255; return c < 128 ? 128 * pn + c : DFF + 128 * pn + (c - 128); } };
struct MapWin { __device__ int operator()(int n) const {
    if (n < 416) return n;
    if (n < 448) return 1952 + (n - 416);
    if (n < 512) return -1;
    if (n < 768) return 416 + (n - 512);
    if (n < 1024) return 672 + (n - 768);
    if (n < 1536) return 928 + (n - 1024);
    return 1440 + (n - 1536); } };
struct MapWqb { __device__ int operator()(int n) const { const int h = n / QH, j = n % QH; if (j < 64) return h * QH + j;
    const int jj = j - 64, i = jj >> 1, p = jj & 1, a = i >> 3, f = i & 7; return h * QH + 64 + 16 * a + 8 * p + f; } };

__device__ __forceinline__ void p0_prologue(Frame& F) {
    LAS float* scr = (LAS float*)(F.lds + RING_OFF + F.wave * 16384);
    const int gw = F.vcu * NWAVES + F.wave, NGW = F.G * NWAVES;
    for (int idx = F.vcu * 512 + F.tid; idx < 2048; idx += F.G * 512) {
        const int pos = idx >> 3, f = idx & 7;
        const float invf = f == 0 ? 1.0f : f == 1 ? 0.31622776601683794f : f == 2 ? 0.1f : f == 3 ? 0.031622776601683794f : f == 4 ? 0.01f : f == 5 ? 0.0031622776601683794f : f == 6 ? 0.001f : 0.00031622776601683794f;
        const float ang = (float)pos * invf;
        double t = (double)ang * 0.15915494309189535; t -= floor(t);
        const float tf = (float)t;
        f32x2 cs; cs.x = __builtin_amdgcn_cosf(tf); cs.y = __builtin_amdgcn_sinf(tf);
        ((f32x2*)(F.ws + WS_ROPE))[idx] = cs;
    }
    if (F.vcu < 144) {
        LAS float* sl = (LAS float*)(F.lds + 100 * 1024);
        LAS float* red = (LAS float*)(F.lds + 108 * 1024);
        for (int i = F.tid; i < 2048; i += 512) { const float v = i < 1024 ? F.in[I_C][i] : F.in[I_CCTX][i - 1024]; sl[i] = v / (1.0f + expf(-v)); }
        __syncthreads();
        for (int u = F.vcu; u < 144; u += F.G) {
            const int cq = F.tid & 15, kg = F.tid >> 4;
            const float* Wp = F.in[I_WADA] + (size_t)u * 64 + cq * 4;
            f32x4 al = {0.f, 0.f, 0.f, 0.f}, ac = {0.f, 0.f, 0.f, 0.f};
#pragma unroll 8
            for (int i = 0; i < 32; ++i) { const int k = kg + 32 * i; const f32x4 w = *(const f32x4*)(Wp + (size_t)k * NMODV); al += w * sl[k]; ac += w * sl[1024 + k]; }
            *(LAS f32x4*)(red + kg * 128 + cq * 4) = al; *(LAS f32x4*)(red + kg * 128 + 64 + cq * 4) = ac;
            __syncthreads();
            if (F.tid < 128) { float s = 0.f;
#pragma unroll
                for (int g = 0; g < 32; ++g) s += red[g * 128 + F.tid];
                const int ty = F.tid >> 6, col = u * 64 + (F.tid & 63);
                ((float*)(F.ws + WS_MOD))[ty * NMODV + col] = s + F.in[I_BADA][col]; }
            __syncthreads();
        }
    }
    constexpr int I_1IN = 16 * 176, I_1OUT = 44 * 32, I_WN = 16 * 64, I_QB = 4 * 24, I_KVB = 2 * 32, I_OUT = 16 * 32;
    constexpr int NITEMS = 2 * I_1IN + 2 * I_1OUT + I_WN + I_QB + I_KVB + I_OUT;
    for (int it = gw; it < NITEMS; it += NGW) {
        int r = it;
        if (r < I_1IN) { transpose_item(F.in[I_F1IN], 2 * DFF, (bf16*)(F.ws + WS_W1IN), DM, scr, 64 * (r / 176), 32 * (r % 176), F.lane, MapFfnIn()); continue; } r -= I_1IN;
        if (r < I_1IN) { transpose_item(F.in[I_F2IN], 2 * DFF, (bf16*)(F.ws + WS_W2IN), DM, scr, 64 * (r / 176), 32 * (r % 176), F.lane, MapFfnIn()); continue; } r -= I_1IN;
        if (r < I_1OUT) { transpose_item(F.in[I_F1OUT], DM, (bf16*)(F.ws + WS_W1OUT), DFF, scr, 64 * (r / 32), 32 * (r % 32), F.lane, MapId()); continue; } r -= I_1OUT;
        if (r < I_1OUT) { transpose_item(F.in[I_F2OUT], DM, (bf16*)(F.ws + WS_W2OUT), DFF, scr, 64 * (r / 32), 32 * (r % 32), F.lane, MapId()); continue; } r -= I_1OUT;
        if (r < I_WN) { transpose_item(F.in[I_WIN], 1984, (bf16*)(F.ws + WS_WIN), DM, scr, 64 * (r / 64), 32 * (r % 64), F.lane, MapWin()); continue; } r -= I_WN;
        if (r < I_QB) { transpose_item(F.in[I_WQB], QP, (bf16*)(F.ws + WS_WQB), 256, scr, 64 * (r / 24), 32 * (r % 24), F.lane, MapWqb()); continue; } r -= I_QB;
        if (r < I_KVB) { transpose_item(F.in[I_WKVB], 1024, (bf16*)(F.ws + WS_WKVB), 256, scr, 64 * (r / 32), 32 * (r % 32), F.lane, MapId()); continue; } r -= I_KVB;
        transpose_item(F.in[I_WOUT], DM, (bf16*)(F.ws + WS_WOUT), DM, scr, 64 * (r / 32), 32 * (r % 32), F.lane, MapId());
    }
    for (int i = F.vcu * 512 + F.tid; i < 1024 * 16; i += F.G * 512) { const int n = i >> 4, c = i & 15;
        *(GAS u32x4*)((bf16*)(F.ws + WS_WKVB) + (size_t)n * 256 + 128 + c * 8) = (u32x4){0u, 0u, 0u, 0u}; }
}

__device__ __forceinline__ void norm_row(int lane, const float* src, const float* y, float gsc, const float* gate, const float* gpost, float* resout,
                                         const float* gpre, const float* shift, const float* scale, bf16* hout, int nsl = 1, size_t sstride = 0) {
    f32x4 v[4];
#pragma unroll
    for (int j = 0; j < 4; ++j) v[j] = *((const f32x4*)src + lane + 64 * j);
    if (y) {
        f32x4 yv[4]; float s = 0.f;
#pragma unroll
        for (int j = 0; j < 4; ++j) { yv[j] = *((const f32x4*)y + lane + 64 * j);
            for (int sl = 1; sl < nsl; ++sl) yv[j] += *((const f32x4*)(y + sl * sstride) + lane + 64 * j);
            s += (yv[j].x * yv[j].x + yv[j].y * yv[j].y) + (yv[j].z * yv[j].z + yv[j].w * yv[j].w); }
        const float rstd = 1.0f / sqrtf(wave_sum(s) * (1.f / DM) + EPS);
#pragma unroll
        for (int j = 0; j < 4; ++j) { const f32x4 g = *((const f32x4*)gate + lane + 64 * j), p = *((const f32x4*)gpost + lane + 64 * j);
            v[j] = v[j] + (yv[j] * rstd) * p * g * gsc; }
    }
    if (resout) {
#pragma unroll
        for (int j = 0; j < 4; ++j) *((f32x4*)resout + lane + 64 * j) = v[j];
    }
    if (hout) {
        float s = 0.f;
#pragma unroll
        for (int j = 0; j < 4; ++j) s += (v[j].x * v[j].x + v[j].y * v[j].y) + (v[j].z * v[j].z + v[j].w * v[j].w);
        const float rstd = 1.0f / sqrtf(wave_sum(s) * (1.f / DM) + EPS);
#pragma unroll
        for (int j = 0; j < 4; ++j) { const f32x4 g = *((const f32x4*)gpre + lane + 64 * j), sh = *((const f32x4*)shift + lane + 64 * j), sc = *((const f32x4*)scale + lane + 64 * j);
            const f32x4 h = (v[j] * rstd) * g * (sc + 1.0f) + sh;
            u32x2 w; w.x = cvt_pk_bf16(h.x, h.y); w.y = cvt_pk_bf16(h.z, h.w);
            *((u32x2*)hout + lane + 64 * j) = w; }
    }
}

__device__ __forceinline__ void mixer_rows4(Frame& F, int rowb) {
    const int lane = lane_id_opaque();
    const bf16* Zq = (const bf16*)(F.ws + WS_ZQ); const float* Z1f = (const float*)(F.ws + WS_Z1F);
    bf16* KV = (bf16*)(F.ws + WS_KV);
    const bool lat = rowb >= CTX;
    u32x2 qw[4]; f32x4 cv[4]; float x1[4], x2[4];
    const int pi = lane & 15, pa = pi >> 3, pf = pi & 7;
#pragma unroll
    for (int k = 0; k < 4; ++k) { const size_t row = (size_t)(rowb + k);
        qw[k] = lat ? *((const u32x2*)(Zq + row * 256) + lane) : (u32x2){0u, 0u};
        cv[k] = lane < 32 ? *((const f32x4*)(Z1f + row * 256) + lane) : (f32x4){0.f, 0.f, 0.f, 0.f};
        x1[k] = Z1f[row * 256 + 128 + 16 * pa + pf]; x2[k] = Z1f[row * 256 + 128 + 16 * pa + 8 + pf]; }
    const f32x4 gq = *((const f32x4*)F.in[I_QNORM] + lane);
    const f32x4 gk = lane < 32 ? *((const f32x4*)F.in[I_KVNORM] + lane) : (f32x4){0.f, 0.f, 0.f, 0.f};
#pragma unroll
    for (int k = 0; k < 4; ++k) { const int row = rowb + k;
        if (lat) {
            const float a = bflo(qw[k].x), b = bfhi(qw[k].x), c = bflo(qw[k].y), d = bfhi(qw[k].y);
            const float rstd = 1.0f / sqrtf(wave_sum((a * a + b * b) + (c * c + d * d)) * (1.f / 256.f) + EPS);
            u32x2 o; o.x = cvt_pk_bf16(a * rstd * gq.x, b * rstd * gq.y); o.y = cvt_pk_bf16(c * rstd * gq.z, d * rstd * gq.w);
            *((u32x2*)((bf16*)(F.ws + WS_QN) + (size_t)(row - CTX) * 256) + lane) = o; }
        {
            const f32x4 v = cv[k];
            const float rstd = 1.0f / sqrtf(wave_sum((v.x * v.x + v.y * v.y) + (v.z * v.z + v.w * v.w)) * (1.f / 128.f) + EPS);
            u32x2 o; o.x = cvt_pk_bf16(v.x * rstd * gk.x, v.y * rstd * gk.y); o.y = cvt_pk_bf16(v.z * rstd * gk.z, v.w * rstd * gk.w);
            *((u32x2*)((bf16*)(F.ws + WS_KVN) + (size_t)row * 256) + lane) = o; }
        if (lane < 16) {
            float o1 = x1[k], o2 = x2[k];
            if (lat) { const int t = row - CTX, pos = pa ? (t & 63) : (t >> 6); const f32x2 cs = ((const f32x2*)(F.ws + WS_ROPE))[pos * 8 + pf];
                o1 = x1[k] * cs.x - x2[k] * cs.y; o2 = x2[k] * cs.x + x1[k] * cs.y; }
            const unsigned pk = cvt_pk_bf16(o1, o2);
#pragma unroll
            for (int h = 0; h < 8; ++h) *(unsigned*)(KV + (size_t)row * KVP + h * KVH + 64 + 2 * pi) = pk; } }
}

template <int DIR>
__device__ __forceinline__ void gla_prep_qk(Frame& F, int cn, int h, LAS float* gal) {
    const int lane = lane_id_opaque(), c = h * 64 + lane;
    const float* wa = F.in[DIR ? I_WAB : I_WAF]; const float bb = F.in[DIR ? I_BAB : I_BAF][c];
    const int row0 = cn * 64;
    {
        const float* gp = (const float*)(F.ws + WS_Z1F) + (size_t)(row0 + lane) * 256 + 160 + 16 * DIR;
#pragma unroll
        for (int q4 = 0; q4 < 4; ++q4) *(LAS f32x4*)(gal + lane * 16 + q4 * 4) = *(const f32x4*)(gp + q4 * 4);
    }
    float w[16];
#pragma unroll
    for (int r = 0; r < 16; ++r) w[r] = wa[r * 256 + c];
    LDS_WAIT(); asm volatile("" ::: "memory");
    const bf16* Zg = (const bf16*)(F.ws + WS_ZGQK);
    float Gs[64]; float G = 0.f;
#pragma unroll
    for (int s = 0; s < 64; ++s) { const int i = DIR ? 63 - s : s;
        float lg = bb;
#pragma unroll
        for (int q4 = 0; q4 < 4; ++q4) { const f32x4 g4 = *(const LAS f32x4*)(gal + i * 16 + q4 * 4);
            lg = fmaf(g4.x, w[4 * q4], lg); lg = fmaf(g4.y, w[4 * q4 + 1], lg); lg = fmaf(g4.z, w[4 * q4 + 2], lg); lg = fmaf(g4.w, w[4 * q4 + 3], lg); }
        const float la = (fminf(lg, 0.f) - __logf(1.0f + __expf(-fabsf(lg)))) * (1.0f / 16.0f);
        G += la; Gs[i] = G; }
    const float Glast = G, Gref = DIR ? Gs[32] : Gs[31];
    const size_t aidx = ((size_t)DIR * NCH + cn) * 256 + c;
    float* aux = (float*)(F.ws + WS_AUX);
    aux[aidx] = __expf(Glast); aux[AUX_N + aidx] = __expf(Glast - Gref); aux[2 * AUX_N + aidx] = __expf(Gref);
    bf16* Qt = (bf16*)(F.ws + WS_QT) + (size_t)DIR * ROWS * 256; bf16* Kt = (bf16*)(F.ws + WS_KT) + (size_t)DIR * ROWS * 256;
    bf16* KtT = (bf16*)(F.ws + WS_KTT) + (((size_t)DIR * NCH + cn) * 256 + c) * 64;
#pragma unroll
    for (int hf = 0; hf < 2; ++hf) { unsigned short qv[32], kv[32];
#pragma unroll
        for (int t = 0; t < 32; ++t) { const size_t ro = (size_t)(row0 + hf * 32 + t); qv[t] = Zg[ro * 512 + c]; kv[t] = Zg[ro * 512 + 256 + c]; }
#pragma unroll
        for (int g8 = 0; g8 < 4; ++g8) { float kt[8];
#pragma unroll
            for (int t = 0; t < 8; ++t) { const int i = hf * 32 + g8 * 8 + t; const size_t ro = (size_t)(row0 + i);
                const float qt = bf2f(qv[g8 * 8 + t]) * 0.125f * __expf(Gs[i] - Gref); kt[t] = bf2f(kv[g8 * 8 + t]) * __expf(Gref - Gs[i]);
                Qt[ro * 256 + c] = (bf16)f2bf(qt); Kt[ro * 256 + c] = (bf16)f2bf(kt[t]); }
            u32x4 o; o.x = cvt_pk_bf16(kt[0], kt[1]); o.y = cvt_pk_bf16(kt[2], kt[3]); o.z = cvt_pk_bf16(kt[4], kt[5]); o.w = cvt_pk_bf16(kt[6], kt[7]);
            *(u32x4*)(KtT + hf * 32 + g8 * 8) = o; } }
    LDS_WAIT(); asm volatile("" ::: "memory");
}
__device__ __forceinline__ void gla_prep_v(Frame& F, int cn, int grp) {
    const int col = grp * 64 + lane_id_opaque();
    const bf16* Zv = (const bf16*)(F.ws + WS_ZGV) + (size_t)cn * 64 * 512 + col;
    bf16* vT = (bf16*)(F.ws + WS_VT) + ((size_t)cn * 512 + col) * 64;
    unsigned short e[64];
#pragma unroll
    for (int t = 0; t < 64; ++t) e[t] = Zv[(size_t)t * 512];
#pragma unroll
    for (int g8 = 0; g8 < 8; ++g8) { u32x4 o; o.x = e[8 * g8 + 0] | ((unsigned)e[8 * g8 + 1] << 16); o.y = e[8 * g8 + 2] | ((unsigned)e[8 * g8 + 3] << 16);
        o.z = e[8 * g8 + 4] | ((unsigned)e[8 * g8 + 5] << 16); o.w = e[8 * g8 + 6] | ((unsigned)e[8 * g8 + 7] << 16);
        *(u32x4*)(vT + g8 * 8) = o; }
}

__device__ __forceinline__ void gla_pass_l(Frame& F, int task) {
    const int lane = lane_id_opaque(), r = lane & 31, hi = lane >> 5;
    const int cn = task % NCH, dh = task / NCH, h = dh & 3, dir = dh >> 2;
    const bf16* vTp = (const bf16*)(F.ws + WS_VT) + ((size_t)cn * 512 + h * 128) * 64;
    const bf16* kTp = (const bf16*)(F.ws + WS_KTT) + (((size_t)dir * NCH + cn) * 256 + h * 64) * 64;
    bf16* Lp = (bf16*)(F.ws + WS_LS) + (((size_t)(dir * 4 + h) * NCH + cn) * 128) * 64;
    bf16x8 bfr[2][4];
#pragma unroll
    for (int nt = 0; nt < 2; ++nt)
#pragma unroll
        for (int s = 0; s < 4; ++s) bfr[nt][s] = *(const bf16x8*)(kTp + (32 * nt + r) * 64 + 16 * s + 8 * hi);
#pragma unroll
    for (int mt = 0; mt < 4; ++mt) { bf16x8 afr[4]; bf16* pm = Lp + (4 * hi) * 64 + r + (32 * mt) * 64;
#pragma unroll
        for (int s = 0; s < 4; ++s) afr[s] = *(const bf16x8*)(vTp + (32 * mt + r) * 64 + 16 * s + 8 * hi);
#pragma unroll
        for (int nt = 0; nt < 2; ++nt) { f32x16 acc = {};
#pragma unroll
            for (int s = 0; s < 4; ++s) acc = __builtin_amdgcn_mfma_f32_32x32x16_bf16(afr[s], bfr[nt][s], acc, 0, 0, 0);
#pragma unroll
            for (int rg = 0; rg < 16; ++rg) pm[((rg & 3) + 8 * (rg >> 2)) * 64 + 32 * nt] = (bf16)f2bf(acc[rg]); } }
}

__device__ __forceinline__ void gla_pass_s(Frame& F) {
    const float* aux = (const float*)(F.ws + WS_AUX);
    for (int el = F.vcu * 256 + F.tid; F.tid < 256 && el < 65536; el += F.G * 256) {
        const int d = el & 63, e = (el >> 6) & 127, dh = el >> 13, h = dh & 3, dir = dh >> 2;
        bf16* Lp = (bf16*)(F.ws + WS_LS) + ((size_t)dh * NCH * 128 + e) * 64 + d;
        const float* ap = aux + (size_t)dir * NCH * 256 + h * 64 + d;
        float S = 0.f;
        for (int p0 = 0; p0 < NCH; p0 += 10) { float lv[10], dc[10], sc[10], er[10]; int cn[10];
#pragma unroll
            for (int u = 0; u < 10; ++u) { const int p = p0 + u; cn[u] = dir ? (p < 4 ? 3 - p : 263 - p) : p;
                lv[u] = bf2f(Lp[(size_t)cn[u] * 8192]); dc[u] = ap[cn[u] * 256]; sc[u] = ap[AUX_N + cn[u] * 256]; er[u] = ap[2 * AUX_N + cn[u] * 256]; }
#pragma unroll
            for (int u = 0; u < 10; ++u) { Lp[(size_t)cn[u] * 8192] = (bf16)f2bf(S * er[u]); S = dc[u] * S + sc[u] * lv[u]; } }
    }
}

template <int DIR, int IT>
__device__ __forceinline__ void gla_o_dir(Frame& F, f32x16 (&o)[4], int h, int cn, int r, int hi) {
    const size_t row0 = (size_t)cn * 64;
    const bf16* Qp = (const bf16*)(F.ws + WS_QT) + ((size_t)DIR * ROWS + row0) * 256 + h * 64;
    const bf16* Kp = (const bf16*)(F.ws + WS_KT) + ((size_t)DIR * ROWS + row0) * 256 + h * 64;
    const bf16* Sp = (const bf16*)(F.ws + WS_LS) + (((size_t)(DIR * 4 + h) * NCH + cn) * 128) * 64;
    const bf16* vTp = (const bf16*)(F.ws + WS_VT) + ((size_t)cn * 512 + h * 128) * 64;
    bf16x8 qf[4];
#pragma unroll
    for (int s = 0; s < 4; ++s) qf[s] = *(const bf16x8*)(Qp + (size_t)(32 * IT + r) * 256 + 16 * s + 8 * hi);
#pragma unroll
    for (int jt = 0; jt < 2; ++jt) {
        if (DIR == 0 ? (jt > IT) : (jt < IT)) continue;
        bf16x8 kf[4];
#pragma unroll
        for (int s = 0; s < 4; ++s) kf[s] = *(const bf16x8*)(Kp + (size_t)(32 * jt + r) * 256 + 16 * s + 8 * hi);
        f32x16 X = {};
#pragma unroll
        for (int s = 0; s < 4; ++s) X = __builtin_amdgcn_mfma_f32_32x32x16_bf16(kf[s], qf[s], X, 0, 0, 0);
        if (jt == IT) {
#pragma unroll
            for (int rg = 0; rg < 16; ++rg) { const int j = att::crow(rg, hi); const bool keep = DIR == 0 ? (j <= r) : (j >= r); X[rg] = keep ? X[rg] : 0.f; } }
        bf16x8 xa[2];
#pragma unroll
        for (int s2 = 0; s2 < 2; ++s2) { u32x4 w; w.x = cvt_pk_bf16(X[8 * s2 + 0], X[8 * s2 + 1]); w.y = cvt_pk_bf16(X[8 * s2 + 2], X[8 * s2 + 3]);
            w.z = cvt_pk_bf16(X[8 * s2 + 4], X[8 * s2 + 5]); w.w = cvt_pk_bf16(X[8 * s2 + 6], X[8 * s2 + 7]); xa[s2] = __builtin_bit_cast(bf16x8, w); }
#pragma unroll
        for (int nt = 0; nt < 4; ++nt)
#pragma unroll
            for (int s2 = 0; s2 < 2; ++s2) { const bf16* vp = vTp + (size_t)(32 * nt + r) * 64 + 32 * jt + 16 * s2 + 4 * hi;
                const u32x2 lo = *(const u32x2*)vp, hi8 = *(const u32x2*)(vp + 8);
                const u32x4 bw = {lo.x, lo.y, hi8.x, hi8.y};
                o[nt] = __builtin_amdgcn_mfma_f32_32x32x16_bf16(xa[s2], __builtin_bit_cast(bf16x8, bw), o[nt], 0, 0, 0); }
    }
#pragma unroll
    for (int nt = 0; nt < 4; ++nt)
#pragma unroll
        for (int s = 0; s < 4; ++s) { const bf16x8 sf = *(const bf16x8*)(Sp + (size_t)(32 * nt + r) * 64 + 16 * s + 8 * hi);
            o[nt] = __builtin_amdgcn_mfma_f32_32x32x16_bf16(qf[s], sf, o[nt], 0, 0, 0); }
}
template <int IT>
__device__ __forceinline__ void gla_pass_o(Frame& F, int h, int cn) {
    const int lane = lane_id_opaque(), r = lane & 31, hi = lane >> 5;
    f32x16 o[4];
#pragma unroll
    for (int nt = 0; nt < 4; ++nt) o[nt] = f32x16{};
    gla_o_dir<0, IT>(F, o, h, cn, r, hi);
    gla_o_dir<1, IT>(F, o, h, cn, r, hi);
    const bf16* Zgg = (const bf16*)(F.ws + WS_ZGG); bf16* mix = (bf16*)(F.ws + WS_MIX);
    float gn[4];
#pragma unroll
    for (int nt = 0; nt < 4; ++nt) gn[nt] = F.in[I_GNORM][32 * nt + r];
#pragma unroll
    for (int rg = 0; rg < 16; ++rg) {
        float ss = 0.f;
#pragma unroll
        for (int nt = 0; nt < 4; ++nt) ss += o[nt][rg] * o[nt][rg];
        ss = half_sum(ss);
        const float rstd = 1.0f / sqrtf(ss * (1.f / 128.f) + EPS);
        const int i = 32 * IT + att::crow(rg, hi); const size_t row = (size_t)cn * 64 + i;
#pragma unroll
        for (int nt = 0; nt < 4; ++nt) { const int e = 32 * nt + r; const float gg = bf2f(Zgg[row * 512 + h * 128 + e]);
            const float val = o[nt][rg] * rstd * gn[nt] * (gg / (1.0f + expf(-gg)));
            mix[(row - CTX) * DM + 512 + h * 128 + e] = (bf16)f2bf(val); } }
}

#ifndef PHM
#define PHM 0xFFFF
#endif
#define PH(k) ((PHM >> (k)) & 1)
struct Args { const float* in[23]; float* out; unsigned char* ws; };
__global__ void __launch_bounds__(NWAVES * 64, 2) fwd_megakernel(Args args) {
    extern __shared__ __attribute__((aligned(16))) unsigned char lds[];
    Frame F;
    F.lds = (LAS unsigned char*)lds;
    F.MISC = (volatile LAS unsigned*)(F.lds + MISC_OFF);
    F.wave = __builtin_amdgcn_readfirstlane((int)threadIdx.x >> 6); F.lane = lane_id_opaque(); F.tid = F.wave * 64 + F.lane;
    F.G = gridDim.x; { const int bx = blockIdx.x; F.vcu = (F.G % 8 == 0) ? (bx % 8) * (F.G / 8) + bx / 8 : bx; }
#pragma unroll
    for (int i = 0; i < 23; ++i) F.in[i] = args.in[i];
    F.out = args.out; F.ws = args.ws;
    for (int u = F.tid; u < (LDS_BYTES - LDSCTL_OFF) / 4; u += NWAVES * 64) ((LAS unsigned*)(F.lds + LDSCTL_OFF))[u] = 0u;
    __syncthreads();
    XcdBarrier bar = xcd_barrier_post((unsigned*)(F.ws + WS_CTL), F.MISC + 8, F.tid);
unsigned bseq = 0;
#ifdef TIMEPH
#define TSTAMP(k) do { if (blockIdx.x == 0 && F.tid == 0) ((unsigned long long*)(F.ws + WS_CTL + 32768))[k] = __builtin_amdgcn_s_memrealtime(); } while (0)
#else
#define TSTAMP(k) do { } while (0)
#endif
#define GRID_BAR() do { ++bseq; { const int l_ = lane_id_opaque(); xcd_barrier(bar, bseq, F.wave * 64 + l_); } F.lane = lane_id_opaque(); F.tid = F.wave * 64 + F.lane; TSTAMP(bseq); } while (0)
    const int gw = F.vcu * NWAVES + F.wave, NGW = F.G * NWAVES;
    const float* modl = (const float*)(F.ws + WS_MOD); const float* modc = modl + NMODV;
    bf16* hA = (bf16*)(F.ws + WS_A); float* Y = (float*)(F.ws + WS_Y);
    const float* npre = F.in[I_NPRE]; const float* npost = F.in[I_NPOST];
    LAS unsigned char* ring = F.lds + RING_OFF;

    TSTAMP(0);
    if (PH(0)) p0_prologue(F);
    GRID_BAR();
    if (PH(1)) for (int row = gw; row < ROWS; row += NGW) {
        const bool isc = row < CTX; const float* md = isc ? modc : modl;
        const float* src = isc ? F.in[I_CTX] + (size_t)row * DM : F.in[I_X] + (size_t)(row - CTX) * DM;
        norm_row(F.lane, src, nullptr, 0.f, nullptr, nullptr, nullptr, npre, md, md + DM, hA + (size_t)row * DM);
    }
    GRID_BAR();
    if (PH(2)) { unsigned* ccnt = (unsigned*)(F.ws + WS_CTL + CTL_CTXCNT);
      { const int cj = (int)blockIdx.x - (F.G >> 1);
        if (cj >= 0 && cj < 22) { pg8::Gemm g0{hA, (const bf16*)(F.ws + WS_W1IN), CTX, 2 * DFF, DM, DM, DM}; pg8::OneUnit S0{true, cj};
          pg8::EpiSwiGLU E0{(bf16*)(F.ws + WS_ACT), DFF, ccnt};
          pg8::gemm_phase<pg8::EpiSwiGLU, false, pg8::OneUnit>(ring, g0, S0, E0, F.wave); } }
      { pg8::Gemm g{hA + (size_t)CTX * DM, (const bf16*)(F.ws + WS_W1IN), SEQ, 2 * DFF, DM, DM, DM}; pg8::StaticOrder S; S.init(SEQ, 2 * DFF, F.G, (int)blockIdx.x);
        pg8::EpiSwiGLU E{(bf16*)(F.ws + WS_ACT) + (size_t)CTX * DFF, DFF, nullptr};
        pg8::gemm_phase<pg8::EpiSwiGLU, true>(ring, g, S, E, F.wave); }
      for (int j = F.G - 1 - (int)blockIdx.x; j < 4 * NSPLIT; j += F.G) { const int pn = j & 3, sp = j >> 2;
          if (F.wave == 0) { unsigned sp_ = 0; while (xb_ld(ccnt) < 22u * 8u) { __builtin_amdgcn_s_sleep(2); if (++sp_ > XB_SPIN_CAP) break; }
              __builtin_amdgcn_fence(__ATOMIC_ACQUIRE, "agent"); asm volatile("s_waitcnt vmcnt(0)" ::: "memory"); }
          __syncthreads();
          pg8::Gemm g2{(const bf16*)(F.ws + WS_ACT) + sp * 256, (const bf16*)(F.ws + WS_W1OUT) + sp * 256, 256, DM, 256, DFF, DFF}; pg8::OneUnit S2{true, pn};
          pg8::EpiF32 E2{(float*)(F.ws + WS_SLAB) + (size_t)sp * 256 * DM, DM};
          pg8::gemm_phase<pg8::EpiF32, false, pg8::OneUnit>(ring, g2, S2, E2, F.wave); } }
    GRID_BAR();
    if (PH(3)) { pg8::Gemm g{(const bf16*)(F.ws + WS_ACT) + (size_t)CTX * DFF, (const bf16*)(F.ws + WS_W1OUT), SEQ, DM, DFF, DFF, DFF}; pg8::StaticOrder S; S.init(SEQ, DM, F.G, (int)blockIdx.x);
      pg8::EpiF32 E{Y + (size_t)CTX * DM, DM};
      pg8::gemm_phase<pg8::EpiF32, true>(ring, g, S, E, F.wave); }
    GRID_BAR();
    if (PH(4)) for (int row = gw; row < ROWS; row += NGW) {
        const bool isc = row < CTX; const float* md = isc ? modc : modl;
        const float* src = isc ? F.in[I_CTX] + (size_t)row * DM : F.in[I_X] + (size_t)(row - CTX) * DM;
        float* ro = isc ? nullptr : F.out + (size_t)(row - CTX) * DM;
        const float* yr = isc ? (const float*)(F.ws + WS_SLAB) + (size_t)row * DM : Y + (size_t)row * DM;
        norm_row(F.lane, src, yr, 0.5f, md + 2 * DM, npost, ro, npre + DM, md + 3 * DM, md + 4 * DM, hA + (size_t)row * DM, isc ? NSPLIT : 1, (size_t)256 * DM);
    }
    GRID_BAR();
#if defined(STOPAT) && STOPAT == 4
    return;
#endif
    if (PH(5)) { pg8::Gemm g{hA, (const bf16*)(F.ws + WS_WIN), ROWS, 2048, DM, DM, DM}; pg8::StaticOrder S; S.init(ROWS, 2048, F.G, (int)blockIdx.x);
      pg8::EpiZ E{(bf16*)(F.ws + WS_ZQ), (bf16*)(F.ws + WS_ZGQK), (bf16*)(F.ws + WS_ZGV), (bf16*)(F.ws + WS_ZGG), (float*)(F.ws + WS_Z1F)};
      pg8::gemm_phase<pg8::EpiZ, true>(ring, g, S, E, F.wave); }
    GRID_BAR();
    if (PH(6)) for (int rb = gw * 4; rb < ROWS; rb += NGW * 4) mixer_rows4(F, rb);
    if (PH(6)) { LAS float* gal = (LAS float*)(ring + F.wave * 4096);
        for (int t = gw; t < 16 * NCH; t += NGW) { const int cn = t % NCH, sub = t / NCH;
            if (sub < 4) gla_prep_qk<0>(F, cn, sub, gal); else if (sub < 8) gla_prep_qk<1>(F, cn, sub - 4, gal); else gla_prep_v(F, cn, sub - 8); } }
    GRID_BAR();
    if (PH(7)) { pg8::Gemm g{(const bf16*)(F.ws + WS_QN), (const bf16*)(F.ws + WS_WQB), SEQ, QP, 256, 256, 256}; pg8::StaticOrder S; S.init(SEQ, QP, F.G, (int)blockIdx.x);
      pg8::EpiQ E{(bf16*)(F.ws + WS_Q), ATT_QSCALE};
      pg8::gemm_phase<pg8::EpiQ, true>(ring, g, S, E, F.wave); }
    if (PH(7)) { pg8::Gemm g{(const bf16*)(F.ws + WS_KVN), (const bf16*)(F.ws + WS_WKVB), ROWS, 1024, 256, 256, 256}; pg8::StaticOrder S; S.init(ROWS, 1024, F.G, (int)((blockIdx.x + 64) % F.G));
      pg8::EpiKV E{(bf16*)(F.ws + WS_KV)};
      pg8::gemm_phase<pg8::EpiKV, true>(ring, g, S, E, F.wave); }
    if (PH(8)) for (int t = gw; t < 8 * NCH; t += NGW) gla_pass_l(F, t);
    GRID_BAR();
#if defined(STOPAT) && STOPAT == 6
    { const bf16* Qp = (const bf16*)(F.ws + WS_Q); const bf16* KVp = (const bf16*)(F.ws + WS_KV);
      for (size_t i = (size_t)blockIdx.x * 512 + F.tid; i < (size_t)SEQ * DM; i += (size_t)F.G * 512) { const size_t t = i >> 10; const int c = (int)(i & 1023);
        F.out[i] = c < 768 ? bf2f(Qp[t * QP + c]) : bf2f(KVp[(t + CTX) * KVP + (c - 768)]) + bf2f(KVp[(t + CTX) * KVP + 256 + (c - 768)]) + bf2f(KVp[t * KVP + 1024 + (c - 768)]); } }
    return;
#endif
#if defined(STOPAT) && STOPAT == 7
    { const bf16* Qt = (const bf16*)(F.ws + WS_QT); const bf16* Kt = (const bf16*)(F.ws + WS_KT); const bf16* KtT = (const bf16*)(F.ws + WS_KTT); const bf16* vT = (const bf16*)(F.ws + WS_VT);
      const bf16* LS = (const bf16*)(F.ws + WS_LS); const float* aux = (const float*)(F.ws + WS_AUX);
      for (size_t i = (size_t)blockIdx.x * 512 + F.tid; i < (size_t)SEQ * DM; i += (size_t)F.G * 512) { const size_t t = i >> 10; const int c = (int)(i & 1023);
        float v;
        if (c < 256) v = bf2f(Qt[t * 256 + c]) + bf2f(Qt[((size_t)ROWS + t) * 256 + c]);
        else if (c < 512) v = bf2f(Kt[t * 256 + c - 256]) + bf2f(Kt[((size_t)ROWS + t) * 256 + c - 256]);
        else if (c < 768) v = bf2f(KtT[i]) + bf2f(vT[i >> 1]);
        else v = bf2f(LS[i]) + bf2f(LS[i + (size_t)SEQ * DM]) + aux[i % (3 * AUX_N)];
        F.out[i] = v; } }
    return;
#endif
    if (PH(9)) gla_pass_s(F);
    TSTAMP(20);
#if ATT_V2
    if (PH(10)) for (int u = F.vcu; u < 512; u += F.G) {
        const int h = (u & 255) >> 5, qb = (u & 31) + 32 * (u >> 8);
        att2::attn_unit<8>(h, qb * 256, (const bf16*)(F.ws + WS_Q), (const bf16*)(F.ws + WS_KV), (bf16*)(F.ws + WS_MIX), (char*)lds + RING_OFF, (const f32x2*)(F.ws + WS_ROPE), F.wave);
    }
#else
    if (PH(10)) for (int u = F.vcu; u < 512; u += F.G) {
        const int h = (u & 255) >> 5, qb = (u & 31) + 32 * (u >> 8);
        att::attn_unit((const bf16*)(F.ws + WS_Q) + (size_t)qb * 256 * QP + h * QH, (const bf16*)(F.ws + WS_KV) + h * KVH,
                       (bf16*)(F.ws + WS_MIX) + (size_t)qb * 256 * DM + h * 64, ROWS, (LAS char*)ring, qb * 256, (const f32x2*)(F.ws + WS_ROPE), F.wave);
    }
#endif
    GRID_BAR();
#if defined(STOPAT) && STOPAT == 9
    { const bf16* LS = (const bf16*)(F.ws + WS_LS);
      for (size_t i = (size_t)blockIdx.x * 512 + F.tid; i < (size_t)SEQ * DM; i += (size_t)F.G * 512) F.out[i] = bf2f(LS[i]); }
    return;
#endif
    if (PH(11)) for (int t = gw; t < 8 * (NCH - 4); t += NGW) { const int h = (t >> 1) & 3, cn = 4 + (t >> 3); if (t & 1) gla_pass_o<1>(F, h, cn); else gla_pass_o<0>(F, h, cn); }
    GRID_BAR();
#if defined(STOPAT) && STOPAT == 8
    { const bf16* mixp = (const bf16*)(F.ws + WS_MIX);
      for (size_t i = (size_t)blockIdx.x * 512 + F.tid; i < (size_t)SEQ * DM; i += (size_t)F.G * 512) F.out[i] = bf2f(mixp[i]); }
    return;
#endif
    if (PH(12)) { pg8::Gemm g{(const bf16*)(F.ws + WS_MIX), (const bf16*)(F.ws + WS_WOUT), SEQ, DM, DM, DM, DM}; pg8::StaticOrder S; S.init(SEQ, DM, F.G, (int)blockIdx.x);
      pg8::EpiF32 E{Y, DM};
      pg8::gemm_phase<pg8::EpiF32, true>(ring, g, S, E, F.wave); }
    GRID_BAR();
    if (PH(13)) for (int row = gw; row < SEQ; row += NGW) {
        float* hr = F.out + (size_t)row * DM;
        norm_row(F.lane, hr, Y + (size_t)row * DM, 1.0f, modl + 5 * DM, npost + DM, hr, npre + 2 * DM, modl + 6 * DM, modl + 7 * DM, hA + (size_t)row * DM);
    }
    GRID_BAR();
    if (PH(14)) { pg8::Gemm g{hA, (const bf16*)(F.ws + WS_W2IN), SEQ, 2 * DFF, DM, DM, DM}; pg8::StaticOrder S; S.init(SEQ, 2 * DFF, F.G, (int)blockIdx.x);
      pg8::EpiSwiGLU E{(bf16*)(F.ws + WS_ACT), DFF, nullptr};
      pg8::gemm_phase<pg8::EpiSwiGLU, true>(ring, g, S, E, F.wave); }
    GRID_BAR();
#ifdef DIAG
    GRID_BAR();
    for (int row = gw; row < SEQ; row += NGW) { float* hr = F.out + (size_t)row * DM;
        for (int j = 0; j < 4; ++j) *((f32x4*)hr + F.lane + 64 * j) = (f32x4){0.f, 0.f, 0.f, 0.f}; }
    GRID_BAR();
    if (blockIdx.x == 0 && F.tid == 0) { unsigned* bw = (unsigned*)(F.ws + WS_CTL);
        const unsigned code = xb_ld(&bw[XB_CODE]), tmo = xb_ld(&bw[XB_TMO]);
        unsigned val = DIAG == 0 ? code : DIAG == 1 ? tmo : DIAG == 2 ? (unsigned)F.G : DIAG == 3 ? F.MISC[8] : F.MISC[9];
        F.out[(size_t)(gw) * DM] = 1.0e6f * (float)(val + 1u); }
    return;
#endif
    if (PH(15)) { pg8::Gemm g{(const bf16*)(F.ws + WS_ACT), (const bf16*)(F.ws + WS_W2OUT), SEQ, DM, DFF, DFF, DFF}; pg8::StaticOrder S; S.init(SEQ, DM, F.G, (int)blockIdx.x);
      pg8::EpiF32 E{Y, DM};
      pg8::gemm_phase<pg8::EpiF32, true>(ring, g, S, E, F.wave); }
    GRID_BAR();
    for (int row = gw; row < SEQ; row += NGW) {
        float* hr = F.out + (size_t)row * DM;
        norm_row(F.lane, hr, Y + (size_t)row * DM, 0.5f, modl + 8 * DM, npost + 2 * DM, hr, nullptr, nullptr, nullptr, nullptr);
    }
#ifdef TIMEPH
    TSTAMP(15);
    GRID_BAR();
    if (blockIdx.x == 0) { volatile unsigned long long* ts = (volatile unsigned long long*)(F.ws + WS_CTL + 32768);
        const unsigned long long d = TIMEPH < 0 ? 10000ull : ts[TIMEPH_B] - ts[TIMEPH];
        long n = (long)((double)d * 0.01 * TIMEPH_K); if (n > 330000) n = 330000;
        for (long i = F.tid; i < n; i += 512) F.out[i] += 0.05f; }
#endif
}

extern "C" void kernel_launch(void* const* d_in, const int* in_sizes, int n_in, void* d_out, int out_size, void* d_ws, size_t ws_size, hipStream_t stream) {
    static int grid = 0;
    if (grid == 0) {
        if (n_in != 23 || in_sizes[0] != SEQ * DM || out_size != SEQ * DM || ws_size < WS_END) {
            fprintf(stderr, "kernel_launch: unexpected shapes: n_in %d in0 %d out %d ws %zu\n", n_in, n_in > 0 ? in_sizes[0] : -1, out_size, ws_size); grid = -1; return; }
        int dev = 0, cus = 0, per_cu = 0;
        if (hipGetDevice(&dev) != hipSuccess || hipDeviceGetAttribute(&cus, hipDeviceAttributeMultiprocessorCount, dev) != hipSuccess) { fprintf(stderr, "kernel_launch: device query failed\n"); grid = -1; return; }
        if (hipFuncSetAttribute((const void*)fwd_megakernel, hipFuncAttributeMaxDynamicSharedMemorySize, LDS_BYTES) != hipSuccess) { fprintf(stderr, "kernel_launch: hipFuncSetAttribute failed\n"); grid = -1; return; }
        if (hipOccupancyMaxActiveBlocksPerMultiprocessor(&per_cu, (const void*)fwd_megakernel, NWAVES * 64, LDS_BYTES) != hipSuccess || per_cu < 1) {
            fprintf(stderr, "kernel_launch: occupancy query reports %d workgroups per CU\n", per_cu); (void)hipGetLastError(); grid = -1; return; }
        grid = cus;
    }
    if (grid < 0) return;
    if (hipMemsetAsync((char*)d_ws + WS_CTL, 0, CTL_ZERO_BYTES, stream) != hipSuccess) { fprintf(stderr, "kernel_launch: memset failed\n"); return; }
    Args a{};
    for (int i = 0; i < 23; ++i) a.in[i] = (const float*)d_in[i];
    a.out = (float*)d_out; a.ws = (unsigned char*)d_ws;
    hipLaunchKernelGGL(fwd_megakernel, dim3(grid), dim3(NWAVES * 64), LDS_BYTES, stream, a);
    const hipError_t le = hipPeekAtLastError();
    if (le != hipSuccess) fprintf(stderr, "kernel_launch: launch failed: %s\n", hipGetErrorName(le));
}
```

```cpp
#include <hip/hip_runtime.h>
#include <cstdio>
#include <cstdint>

#define GAS __attribute__((address_space(1)))
#define LAS __attribute__((address_space(3)))
typedef unsigned short bf16;
typedef short bf16x8 __attribute__((ext_vector_type(8)));
typedef short s16x4 __attribute__((ext_vector_type(4)));
typedef float f32x4 __attribute__((ext_vector_type(4)));
typedef float f32x2 __attribute__((ext_vector_type(2)));
typedef float f32x16 __attribute__((ext_vector_type(16)));
typedef unsigned u32x4 __attribute__((ext_vector_type(4)));
typedef unsigned u32x2 __attribute__((ext_vector_type(2)));

constexpr int DM = 1024, SEQ = 16384, CTX = 256, ROWS = SEQ + CTX, DFF = 2816, NMODV = 9 * DM;
constexpr int NCH = ROWS / 64;
constexpr float EPS = 1e-6f;
constexpr int KVP = 1280, KVH = 160;
constexpr int QP = 768, QH = 96;

constexpr size_t MiB = 1u << 20;
constexpr size_t WS_CTL = 0, CTL_ZERO_BYTES = 64 * 1024;
constexpr size_t WS_MOD = 1 * MiB;
constexpr size_t WS_ROPE = 1 * MiB + 128 * 1024;
constexpr size_t WS_W1IN = 2 * MiB;
constexpr size_t WS_W1OUT = WS_W1IN + 11 * MiB;
constexpr size_t WS_W2IN = WS_W1OUT + 5 * MiB + 512 * 1024;
constexpr size_t WS_W2OUT = WS_W2IN + 11 * MiB;
constexpr size_t WS_WIN = WS_W2OUT + 5 * MiB + 512 * 1024;
constexpr size_t WS_WQB = WS_WIN + 4 * MiB;
constexpr size_t WS_WKVB = WS_WQB + 384 * 1024;
constexpr size_t WS_WOUT = WS_WKVB + 512 * 1024;
constexpr size_t WS_A = 42 * MiB;
constexpr size_t WS_QN = WS_A;
constexpr size_t WS_KVN = WS_A + 8 * MiB;
constexpr size_t WS_MIX = WS_A;
constexpr size_t WS_B = WS_A + (size_t)ROWS * DM * 2;
constexpr size_t WS_ZQ = WS_B;
constexpr size_t WS_Z1F = WS_ZQ + (size_t)ROWS * 256 * 2;
constexpr size_t WS_Q = WS_B;
constexpr size_t WS_C = WS_Z1F + (size_t)ROWS * 256 * 4;
constexpr size_t WS_ZGQK = WS_C;
constexpr size_t WS_ZGV = WS_ZGQK + (size_t)ROWS * 512 * 2;
constexpr size_t WS_LS = WS_C;
constexpr size_t WS_ZGG = WS_ZGV + (size_t)ROWS * 512 * 2;
constexpr size_t WS_KV = WS_ZGG + (size_t)ROWS * 512 * 2;
constexpr size_t WS_QT = WS_KV + (size_t)ROWS * KVP * 2;
constexpr size_t WS_KT = WS_QT + (size_t)2 * ROWS * 256 * 2;
constexpr size_t WS_KTT = WS_KT + (size_t)2 * ROWS * 256 * 2;
constexpr size_t WS_VT = WS_KTT + (size_t)2 * ROWS * 256 * 2;
constexpr size_t WS_AUX = WS_VT + (size_t)ROWS * 512 * 2;
constexpr size_t AUX_N = (size_t)2 * NCH * 256;
constexpr size_t WS_AUX_END = WS_AUX + 3 * AUX_N * 4;
constexpr size_t WS_ACT = WS_B;
constexpr size_t WS_Y = 164 * MiB;
constexpr size_t WS_SLAB = 230 * MiB;
constexpr int NSPLIT = 11;
constexpr size_t CTL_CTXCNT = 16384;
constexpr size_t WS_END = 256 * MiB;
static_assert(WS_WOUT + 2 * MiB <= WS_A, "weights");
static_assert(WS_KVN + (size_t)ROWS * 256 * 2 <= WS_B, "qn/kvn in A");
static_assert(WS_Q + (size_t)SEQ * QP * 2 <= WS_C, "Q in B");
static_assert(WS_LS + (size_t)8 * NCH * 8192 * 2 <= WS_ZGG, "LS in C");
static_assert(WS_AUX_END <= WS_END, "aux");
static_assert(WS_ACT + (size_t)ROWS * DFF * 2 <= WS_Y && WS_Y + (size_t)ROWS * DM * 4 <= WS_END, "ffn map");
static_assert(WS_MIX + (size_t)SEQ * DM * 2 <= WS_Y, "mix below y");

typedef __bf16 bf16x2_t __attribute__((ext_vector_type(2)));
__device__ __forceinline__ unsigned cvt_pk_bf16(float lo, float hi) { f32x2 v = {lo, hi}; bf16x2_t b = __builtin_convertvector(v, bf16x2_t); return __builtin_bit_cast(unsigned, b); }
__device__ __forceinline__ unsigned f2bf(float f) { unsigned u = __builtin_bit_cast(unsigned, f); return (u + 0x7fffu + ((u >> 16) & 1u)) >> 16; }
__device__ __forceinline__ float bf2f(unsigned short b) { return __builtin_bit_cast(float, (unsigned)b << 16); }
__device__ __forceinline__ float bflo(unsigned w) { return __builtin_bit_cast(float, w << 16); }
__device__ __forceinline__ float bfhi(unsigned w) { return __builtin_bit_cast(float, w & 0xffff0000u); }
__device__ __forceinline__ float fast_silu(float a) { return a * __builtin_amdgcn_rcpf(1.0f + __builtin_amdgcn_exp2f(-a * 1.4426950408889634f)); }
template <int M> __device__ __forceinline__ float swz_xor(float v) { return __builtin_bit_cast(float, __builtin_amdgcn_ds_swizzle(__builtin_bit_cast(int, v), (M << 10) | 0x1f)); }
__device__ __forceinline__ float half_sum(float v) {
    v += swz_xor<1>(v); v += swz_xor<2>(v); v += swz_xor<4>(v); v += swz_xor<8>(v); v += swz_xor<16>(v); return v;
}
__device__ __forceinline__ float wave_sum(float v) {
    v = half_sum(v);
    auto rr = __builtin_amdgcn_permlane32_swap(__float_as_uint(v), __float_as_uint(v), false, false);
    return __uint_as_float(rr[0]) + __uint_as_float(rr[1]);
}
__device__ __forceinline__ int lane_id_opaque() { int l; asm volatile("v_mbcnt_lo_u32_b32 %0, -1, 0\n\tv_mbcnt_hi_u32_b32 %0, -1, %0" : "=v"(l)); return l; }
#define LDS_WAIT() asm volatile("s_waitcnt lgkmcnt(0)" ::: "memory")
#define VM_WAIT() asm volatile("s_waitcnt vmcnt(0)" ::: "memory")

namespace pg8 {
typedef unsigned short bf16_t;
constexpr int BM = 256, BK = 64, HALF = 128, HTB = HALF * BK * 2, STAGE_BYTES = 8 * HTB, NXCD = 8, WGM = 8;
__host__ __device__ __forceinline__ int lds_byte(int r, int c) { const int st = (r >> 4) * 2 + (c >> 5), rr = r & 15, cc = c & 31, ob = rr * 64 + cc * 2; return st * 1024 + (ob ^ (((ob >> 9) & 1) << 5)); }
__host__ __device__ __forceinline__ void stage_rc(int b, int& R, int& C) { const int st = b / 1024, sb = b % 1024, swz = sb ^ (((sb >> 9) & 1) << 5); R = (st >> 1) * 16 + swz / 64; C = (st & 1) * 32 + (swz % 64) / 2; }

struct Unit { int pm, pn; };
struct OneUnit { bool has; int pn;
    __device__ bool next(int i, Unit& u) const { if (i > 0 || !has) return false; u.pm = 0; u.pn = pn; return true; } };
struct Gemm { const bf16_t* A; const bf16_t* Bt; int M, N, K, lda, ldb; };

struct StaticOrder {
    int nM, nN, nwg, G, c;
    __host__ __device__ void init(int M, int N, int G_, int c_) { nM = M / BM; nN = N / BM; nwg = nM * nN; G = G_; c = c_; }
    __host__ __device__ bool next(int i, Unit& u) const {
        const long L = (long)i * G + c; if (L >= nwg) return false;
        int wgid = (int)L; { const int q = nwg / NXCD, r = nwg % NXCD, xcd = wgid % NXCD, off = wgid / NXCD; wgid = (xcd < r ? xcd * (q + 1) : r * (q + 1) + (xcd - r) * q) + off; }
        const int nig = WGM * nN, gid = wgid / nig, fm = gid * WGM, gsz = (nM - fm) < WGM ? (nM - fm) : WGM;
        u.pm = fm + ((wgid % nig) % gsz); u.pn = (wgid % nig) / gsz; return true;
    }
};

typedef f32x4 Acc[2][2][4][2];

struct EpiF32 {
    __device__ __forceinline__ void done(const Unit&, int) const {}
    float* C; int ldc;
    __device__ __forceinline__ void operator()(const Acc& acc, const Unit& u, int wr, int wc, int fr, int fq) const {
        const int row0 = u.pm * BM + wr * 64 + fr, col0 = u.pn * BM + wc * 32 + 4 * fq;
#pragma unroll
        for (int ai = 0; ai < 2; ++ai)
#pragma unroll
            for (int m = 0; m < 4; ++m) { float* rowp = C + (size_t)(row0 + ai * HALF + m * 16) * ldc + col0;
#pragma unroll
                for (int bj = 0; bj < 2; ++bj)
#pragma unroll
                    for (int n = 0; n < 2; ++n) *(f32x4*)(rowp + bj * HALF + n * 16) = acc[ai][bj][m][n]; }
    }
};
struct EpiSwiGLU {
    bf16_t* O; int ldo; unsigned* cnt;
    __device__ __forceinline__ void done(const Unit& u, int lane) const {
        if (cnt != nullptr && u.pm == 0) { asm volatile("s_waitcnt vmcnt(0)" ::: "memory");
            if (lane == 0) __hip_atomic_fetch_add(cnt, 1u, __ATOMIC_RELAXED, __HIP_MEMORY_SCOPE_AGENT); } }
    __device__ __forceinline__ void operator()(const Acc& acc, const Unit& u, int wr, int wc, int fr, int fq) const {
        const int row0 = u.pm * BM + wr * 64 + fr, col0 = u.pn * HALF + wc * 32 + 4 * fq;
        const bool wt = cnt != nullptr && u.pm == 0;
#pragma unroll
        for (int ai = 0; ai < 2; ++ai)
#pragma unroll
            for (int m = 0; m < 4; ++m) { bf16_t* rowp = O + (size_t)(row0 + ai * HALF + m * 16) * ldo + col0;
#pragma unroll
                for (int n = 0; n < 2; ++n) { const f32x4 a = acc[ai][0][m][n], b = acc[ai][1][m][n];
                    u32x2 w; w.x = cvt_pk_bf16(fast_silu(a[0]) * b[0], fast_silu(a[1]) * b[1]); w.y = cvt_pk_bf16(fast_silu(a[2]) * b[2], fast_silu(a[3]) * b[3]);
                    if (wt) __hip_atomic_store((unsigned long long*)(rowp + n * 16), ((unsigned long long)w.y << 32) | w.x, __ATOMIC_RELAXED, __HIP_MEMORY_SCOPE_AGENT);
                    else *(u32x2*)(rowp + n * 16) = w; } }
    }
};
struct EpiZ {
    __device__ __forceinline__ void done(const Unit&, int) const {}
    bf16_t *Zq, *Zgqk, *Zgv, *Zgg; float* Z1f;
    __device__ __forceinline__ void operator()(const Acc& acc, const Unit& u, int wr, int wc, int fr, int fq) const {
        const int row0 = u.pm * BM + wr * 64 + fr, cl = wc * 32 + 4 * fq, pn = u.pn;
        if (pn == 1) {
#pragma unroll
            for (int ai = 0; ai < 2; ++ai)
#pragma unroll
                for (int m = 0; m < 4; ++m) { float* rowp = Z1f + (size_t)(row0 + ai * HALF + m * 16) * 256 + cl;
#pragma unroll
                    for (int bj = 0; bj < 2; ++bj)
#pragma unroll
                        for (int n = 0; n < 2; ++n) *(f32x4*)(rowp + bj * HALF + n * 16) = acc[ai][bj][m][n]; }
        } else {
            bf16_t* base; int ld, cb;
            if (pn == 0) { base = Zq; ld = 256; cb = 0; }
            else if (pn < 4) { base = Zgqk; ld = 512; cb = (pn - 2) * 256; }
            else if (pn < 6) { base = Zgv; ld = 512; cb = (pn - 4) * 256; }
            else { base = Zgg; ld = 512; cb = (pn - 6) * 256; }
#pragma unroll
            for (int ai = 0; ai < 2; ++ai)
#pragma unroll
                for (int m = 0; m < 4; ++m) { bf16_t* rowp = base + (size_t)(row0 + ai * HALF + m * 16) * ld + cb + cl;
#pragma unroll
                    for (int bj = 0; bj < 2; ++bj)
#pragma unroll
                        for (int n = 0; n < 2; ++n) { const f32x4 v = acc[ai][bj][m][n]; u32x2 w; w.x = cvt_pk_bf16(v[0], v[1]); w.y = cvt_pk_bf16(v[2], v[3]);
                            *(u32x2*)(rowp + bj * HALF + n * 16) = w; } }
        }
    }
};
struct EpiQ {
    __device__ __forceinline__ void done(const Unit&, int) const {}
    bf16_t* Q; float qscale;
    __device__ __forceinline__ void operator()(const Acc& acc, const Unit& u, int wr, int wc, int fr, int fq) const {
        const int row0 = u.pm * BM + wr * 64 + fr, col0 = u.pn * BM + wc * 32 + 4 * fq;
#pragma unroll
        for (int ai = 0; ai < 2; ++ai)
#pragma unroll
            for (int m = 0; m < 4; ++m) { bf16_t* rowp = Q + (size_t)(row0 + ai * HALF + m * 16) * QP + col0;
#pragma unroll
                for (int bj = 0; bj < 2; ++bj)
#pragma unroll
                    for (int n = 0; n < 2; ++n) { const f32x4 v = acc[ai][bj][m][n] * qscale; u32x2 w; w.x = cvt_pk_bf16(v[0], v[1]); w.y = cvt_pk_bf16(v[2], v[3]);
                        *(u32x2*)(rowp + bj * HALF + n * 16) = w; } }
    }
};
struct EpiKV {
    __device__ __forceinline__ void done(const Unit&, int) const {}
    bf16_t* KV;
    __device__ __forceinline__ void operator()(const Acc& acc, const Unit& u, int wr, int wc, int fr, int fq) const {
        const int row0 = u.pm * BM + wr * 64 + fr, col0 = u.pn * BM + wc * 32 + 4 * fq;
#pragma unroll
        for (int bj = 0; bj < 2; ++bj)
#pragma unroll
            for (int n = 0; n < 2; ++n) { const int c = col0 + bj * HALF + n * 16, h = c >> 7, part = (c >> 6) & 1, idx = c & 63, dc = h * KVH + (part ? 96 + idx : idx);
#pragma unroll
                for (int ai = 0; ai < 2; ++ai)
#pragma unroll
                    for (int m = 0; m < 4; ++m) { const int t = row0 + ai * HALF + m * 16; const f32x4 v = acc[ai][bj][m][n];
                        u32x2 w; w.x = cvt_pk_bf16(v[0], v[1]); w.y = cvt_pk_bf16(v[2], v[3]);
                        *(u32x2*)(KV + (size_t)t * KVP + dc) = w; } }
    }
};

template <class Epi, bool ALIGN_EPI, class Sched = StaticOrder>
__device__ __forceinline__ void gemm_phase(LAS unsigned char* lds, const Gemm g, const Sched& S, const Epi& E, int wave) {
    const int wid = wave, lane = lane_id_opaque(), tid = wid * 64 + lane, wr = wid >> 2, wc = wid & 3, fr = lane & 15, fq = lane >> 4;
    const int K = g.K, nt = K / BK;
    unsigned voffA[2], voffB[2];
#pragma unroll
    for (int i = 0; i < 2; ++i) { int R, C; stage_rc(tid * 16 + i * 8192, R, C);
        voffA[i] = (unsigned)(R * g.lda + C) * 2u; voffB[i] = (unsigned)(R * g.ldb + C) * 2u; }
    const size_t kstep = (size_t)(BK * 2);
    const size_t hstepA = (size_t)HALF * g.lda * 2, hstepB = (size_t)HALF * g.ldb * 2;
    const size_t tstepA = 2 * hstepA, tstepB = 2 * hstepB;
    const unsigned ldsw = (unsigned)wid * 1024u;
    const int aoff = lds_byte(wr * 64 + fr, fq * 8), boff = lds_byte(wc * 32 + fr, fq * 8);
#define PG8_SA(b, h) (((b) * 2 + (h)) * HTB)
#define PG8_SB(b, h) ((4 + (b) * 2 + (h)) * HTB)
#define PG8_STAGE(bufoff, gbase, voff) do { _Pragma("unroll") for (int _i = 0; _i < 2; ++_i) \
        __builtin_amdgcn_global_load_lds((const unsigned*)((const char*)(gbase) + (voff)[_i]), (LAS unsigned*)(lds + (bufoff) + ldsw + _i * 8192), 16, 0, 0); } while (0)
#define PG8_LDA(dst, b, h) do { _Pragma("unroll") for (int m = 0; m < 4; ++m) _Pragma("unroll") for (int k = 0; k < 2; ++k) dst[m][k] = *(const LAS bf16x8*)(lds + PG8_SA(b, h) + aoff + m * 2048 + k * 1024); } while (0)
#define PG8_LDB(dst, b, h) do { _Pragma("unroll") for (int n = 0; n < 2; ++n) _Pragma("unroll") for (int k = 0; k < 2; ++k) dst[n][k] = *(const LAS bf16x8*)(lds + PG8_SB(b, h) + boff + n * 2048 + k * 1024); } while (0)
#define PG8_MMA(ai, bj, At, Bt) do { __builtin_amdgcn_s_setprio(1); _Pragma("unroll") for (int m = 0; m < 4; ++m) _Pragma("unroll") for (int n = 0; n < 2; ++n) _Pragma("unroll") for (int k = 0; k < 2; ++k) \
        acc[ai][bj][m][n] = __builtin_amdgcn_mfma_f32_16x16x32_bf16(Bt[n][k], At[m][k], acc[ai][bj][m][n], 0, 0, 0); __builtin_amdgcn_s_setprio(0); } while (0)
#define PG8_WAIT_V(n) asm volatile("s_waitcnt vmcnt(" #n ")" ::: "memory")
#define PG8_WAIT_L(n) asm volatile("s_waitcnt lgkmcnt(" #n ")" ::: "memory")
#define PG8_BAR __builtin_amdgcn_s_barrier()
#define PG8_SCHED __builtin_amdgcn_sched_barrier(0)
    Unit cur, nxt; int ui = 0;
    if (!S.next(0, cur)) return;
    Acc acc;
#pragma unroll
    for (int a = 0; a < 2; ++a)
#pragma unroll
        for (int b = 0; b < 2; ++b)
#pragma unroll
            for (int m = 0; m < 4; ++m)
#pragma unroll
                for (int n = 0; n < 2; ++n) acc[a][b][m][n] = (f32x4){0.f, 0.f, 0.f, 0.f};
    bf16x8 At[4][2], B0[2][2], B1[2][2];
    const char* cA = (const char*)g.A + (size_t)cur.pm * tstepA; const char* cB = (const char*)g.Bt + (size_t)cur.pn * tstepB;
    PG8_STAGE(PG8_SB(0, 0), cB, voffB); PG8_STAGE(PG8_SB(0, 1), cB + hstepB, voffB); PG8_STAGE(PG8_SA(0, 0), cA, voffA); PG8_STAGE(PG8_SA(0, 1), cA + hstepA, voffA);
    if (wr == 1) PG8_BAR;
    PG8_WAIT_V(2); PG8_BAR;
    PG8_STAGE(PG8_SB(1, 0), cB + kstep, voffB); PG8_STAGE(PG8_SA(1, 0), cA + kstep, voffA); PG8_STAGE(PG8_SB(1, 1), cB + hstepB + kstep, voffB);
    PG8_WAIT_V(6); PG8_BAR;
    for (;;) {
        const bool has_next = S.next(ui + 1, nxt);
        const char* nA = has_next ? (const char*)g.A + (size_t)nxt.pm * tstepA : cA; const char* nB = has_next ? (const char*)g.Bt + (size_t)nxt.pn * tstepB : cB;
        for (int t = 0; t < nt; t += 2) {
            const bool last = (t == nt - 2);
            const char* a1 = cA + (size_t)(t + 1) * kstep;
            const char* a2 = last ? nA : cA + (size_t)(t + 2) * kstep; const char* b2 = last ? nB : cB + (size_t)(t + 2) * kstep;
            const char* a3 = a2 + kstep; const char* b3 = b2 + kstep;
            PG8_LDB(B0, 0, 0); PG8_LDB(B1, 0, 1); PG8_SCHED; PG8_LDA(At, 0, 0); PG8_STAGE(PG8_SA(1, 1), a1 + hstepA, voffA);
            PG8_WAIT_V(8); PG8_WAIT_L(0); PG8_BAR; PG8_MMA(0, 0, At, B0); PG8_MMA(0, 1, At, B1); PG8_BAR; PG8_SCHED;
            PG8_LDA(At, 0, 1); PG8_STAGE(PG8_SB(0, 0), b2, voffB); PG8_STAGE(PG8_SB(0, 1), b2 + hstepB, voffB); PG8_STAGE(PG8_SA(0, 0), a2, voffA);
            PG8_WAIT_V(8); PG8_WAIT_L(0); PG8_BAR; PG8_MMA(1, 0, At, B0); PG8_MMA(1, 1, At, B1); PG8_BAR; PG8_SCHED;
            PG8_LDB(B0, 1, 0); PG8_LDB(B1, 1, 1); PG8_SCHED; PG8_LDA(At, 1, 0); PG8_STAGE(PG8_SA(0, 1), a2 + hstepA, voffA);
            PG8_WAIT_V(8); PG8_WAIT_L(0); PG8_BAR; PG8_MMA(0, 0, At, B0); PG8_MMA(0, 1, At, B1); PG8_BAR; PG8_SCHED;
            PG8_LDA(At, 1, 1); PG8_STAGE(PG8_SB(1, 0), b3, voffB); PG8_STAGE(PG8_SB(1, 1), b3 + hstepB, voffB); PG8_STAGE(PG8_SA(1, 0), a3, voffA);
            PG8_WAIT_V(8); PG8_WAIT_L(0); PG8_BAR; PG8_MMA(1, 0, At, B0); PG8_MMA(1, 1, At, B1); PG8_BAR; PG8_SCHED;
        }
        if constexpr (ALIGN_EPI) { if (wr == 0) PG8_BAR; }
        { const int l2 = lane_id_opaque(); E(acc, cur, wr, wc, l2 & 15, l2 >> 4); E.done(cur, l2); }
        if (!has_next) break;
#pragma unroll
        for (int a = 0; a < 2; ++a)
#pragma unroll
            for (int b = 0; b < 2; ++b)
#pragma unroll
                for (int m = 0; m < 4; ++m)
#pragma unroll
                    for (int n = 0; n < 2; ++n) acc[a][b][m][n] = (f32x4){0.f, 0.f, 0.f, 0.f};
        cur = nxt; cA = nA; cB = nB; ++ui;
        if constexpr (ALIGN_EPI) { if (wr == 1) PG8_BAR; }
    }
    PG8_WAIT_V(0);
    if constexpr (!ALIGN_EPI) { if (wr == 0) PG8_BAR; }
    PG8_BAR;
#undef PG8_SA
#undef PG8_SB
#undef PG8_STAGE
#undef PG8_LDA
#undef PG8_LDB
#undef PG8_MMA
#undef PG8_WAIT_V
#undef PG8_WAIT_L
#undef PG8_BAR
#undef PG8_SCHED
}
}

#ifndef ATT_V2
#define ATT_V2 1
#endif
#if ATT_V2
#define ATT_QSCALE (0.10206207261596575f * 1.4426950408889634f)
#else
#define ATT_QSCALE 1.0f
#endif
namespace att {
constexpr int NW = 8, QBLK = 32, KVBLK = 64;
constexpr float SCALE = 0.10206207261596575f;
constexpr float THR = 8.f;
constexpr int SHM_V = 16384, SHM_K = 16384, SHM_ATTN = 2 * SHM_V + 2 * SHM_K + NW * 64 * 4;
#define KSWZ(row, colB) ((row) * 256 + ((colB) ^ (((row) & 7) << 4)))
#define SBAR() __builtin_amdgcn_sched_barrier(0)
__device__ __forceinline__ int crow(int r, int hi) { return (r & 3) + 8 * (r >> 2) + 4 * hi; }

__device__ __forceinline__ void partialSM(f32x16& p0, f32x16& p1, float& m_reg, float& mn, float& alpha) {
  constexpr float C = SCALE * 1.4426950408889634f;
  float pmax = p0[0];
#pragma unroll
  for (int r = 1; r < 16; ++r) pmax = fmaxf(pmax, p0[r]);
#pragma unroll
  for (int r = 0; r < 16; ++r) pmax = fmaxf(pmax, p1[r]);
  { auto rr = __builtin_amdgcn_permlane32_swap(__float_as_uint(pmax), __float_as_uint(pmax), false, false);
    pmax = fmaxf(__uint_as_float(rr[0]), __uint_as_float(rr[1])); }
  if (__builtin_expect(__all(pmax - m_reg <= THR / SCALE), 1)) { mn = m_reg; alpha = 1.f; }
  else { mn = fmaxf(m_reg, pmax); alpha = __builtin_amdgcn_exp2f((m_reg - mn) * C); m_reg = mn; }
  float mnC = -mn * C;
#pragma unroll
  for (int r = 0; r < 16; ++r) p0[r] = fmaf(p0[r], C, mnC);
#pragma unroll
  for (int r = 0; r < 16; ++r) p1[r] = fmaf(p1[r], C, mnC);
#pragma unroll
  for (int r = 0; r < 16; ++r) p0[r] = __builtin_amdgcn_exp2f(p0[r]);
}
__device__ __forceinline__ void finishSM(f32x16& p0, f32x16& p1, float alpha, float& l_reg, bf16x8& pa0, bf16x8& pa1, bf16x8& pa2, bf16x8& pa3) {
#pragma unroll
  for (int r = 0; r < 16; ++r) p1[r] = __builtin_amdgcn_exp2f(p1[r]);
  float ps = 0;
#pragma unroll
  for (int r = 0; r < 16; ++r) ps += p0[r];
#pragma unroll
  for (int r = 0; r < 16; ++r) ps += p1[r];
  { auto rr = __builtin_amdgcn_permlane32_swap(__float_as_uint(ps), __float_as_uint(ps), false, false);
    ps = __uint_as_float(rr[0]) + __uint_as_float(rr[1]); }
  l_reg = l_reg * alpha + ps;
#define PK4(P, BASE, OUT) do { unsigned a0 = cvt_pk_bf16(P[BASE + 0], P[BASE + 1]), a1 = cvt_pk_bf16(P[BASE + 2], P[BASE + 3]);   \
    unsigned b0 = cvt_pk_bf16(P[BASE + 4], P[BASE + 5]), b1 = cvt_pk_bf16(P[BASE + 6], P[BASE + 7]);                              \
    auto r0 = __builtin_amdgcn_permlane32_swap(a0, b0, false, false); auto r1 = __builtin_amdgcn_permlane32_swap(a1, b1, false, false); \
    u32x4 w = {r0[0], r1[0], r0[1], r1[1]}; OUT = __builtin_bit_cast(bf16x8, w); } while (0)
  PK4(p0, 0, pa0); PK4(p0, 8, pa1); PK4(p1, 0, pa2); PK4(p1, 8, pa3);
#undef PK4
}
__device__ __forceinline__ void qkt(f32x16& p0, f32x16& p1, const LAS char* Ks, const bf16x8* qr, int r32, int hi) {
  p0 = f32x16{}; p1 = f32x16{};
#pragma unroll
  for (int d0 = 0; d0 < 6; ++d0) { int cb = (d0 * 16 + hi * 8) * 2;
    bf16x8 b0 = *reinterpret_cast<const LAS bf16x8*>(Ks + KSWZ(r32, cb));
    bf16x8 b1 = *reinterpret_cast<const LAS bf16x8*>(Ks + KSWZ(32 + r32, cb));
    p0 = __builtin_amdgcn_mfma_f32_32x32x16_bf16(b0, qr[d0], p0, 0, 0, 0);
    p1 = __builtin_amdgcn_mfma_f32_32x32x16_bf16(b1, qr[d0], p1, 0, 0, 0); }
}
__device__ __forceinline__ int v_st(int k, int c) { const int kk = (k & ~0xC) | ((k & 4) << 1) | ((k & 8) >> 1); return ((kk >> 3) * 4 + (c >> 5)) * 512 + ((kk & 7) * 32 + (c & 31)) * 2; }
__device__ __forceinline__ int v_rd_base(int lane) { return ((lane & 3) << 3) | (((lane >> 2) & 3) << 6) | (((lane >> 4) & 1) << 5) | (((lane >> 5) & 1) << 8); }
constexpr int v_rd_off(int d0, int ks, int half) { return d0 * 512 + ks * 4096 + half * 2048; }
template <int OFF> __device__ __forceinline__ s16x4 tr_read(int vb) {
  s16x4 r; asm volatile("ds_read_b64_tr_b16 %0, %1 offset:%2" : "=&v"(r) : "v"(vb), "i"(OFF) : "memory"); return r;
}
template <int D0> __device__ __forceinline__ void pv_one(f32x16& od, int vb, bf16x8 pa0, bf16x8 pa1, bf16x8 pa2, bf16x8 pa3) {
  const s16x4 l0 = tr_read<v_rd_off(D0, 0, 0)>(vb), h0 = tr_read<v_rd_off(D0, 0, 1)>(vb), l1 = tr_read<v_rd_off(D0, 1, 0)>(vb), h1 = tr_read<v_rd_off(D0, 1, 1)>(vb);
  const s16x4 l2 = tr_read<v_rd_off(D0, 2, 0)>(vb), h2 = tr_read<v_rd_off(D0, 2, 1)>(vb), l3 = tr_read<v_rd_off(D0, 3, 0)>(vb), h3 = tr_read<v_rd_off(D0, 3, 1)>(vb);
  asm volatile("s_waitcnt lgkmcnt(0)" ::: "memory"); SBAR();
#define PK(L, H) (bf16x8){L[0], L[1], L[2], L[3], H[0], H[1], H[2], H[3]}
  od = __builtin_amdgcn_mfma_f32_32x32x16_bf16(pa0, PK(l0, h0), od, 0, 0, 0);
  od = __builtin_amdgcn_mfma_f32_32x32x16_bf16(pa1, PK(l1, h1), od, 0, 0, 0);
  od = __builtin_amdgcn_mfma_f32_32x32x16_bf16(pa2, PK(l2, h2), od, 0, 0, 0);
  od = __builtin_amdgcn_mfma_f32_32x32x16_bf16(pa3, PK(l3, h3), od, 0, 0, 0);
#undef PK
}
__device__ __forceinline__ void pv_d0(f32x16* o, int vb, bf16x8 pa0, bf16x8 pa1, bf16x8 pa2, bf16x8 pa3) {
  pv_one<0>(o[0], vb, pa0, pa1, pa2, pa3); pv_one<1>(o[1], vb, pa0, pa1, pa2, pa3);
}

__device__ __forceinline__ void attn_unit(const bf16* __restrict__ Qb, const bf16* __restrict__ KVh, bf16* __restrict__ Ob, int seq, LAS char* lds, int t0, const f32x2* __restrict__ tab, int wave) {
  const int wid = wave, lane = lane_id_opaque(), tid = wid * 64 + lane, r32 = lane & 31, hi = lane >> 5;
  LAS char* V_lds = lds; LAS char* K_lds = lds + 2 * SHM_V;
  LAS float* ws = (LAS float*)(lds + 2 * SHM_V + 2 * SHM_K) + wid * 64; LAS float* li_l = ws; LAS float* al_l = ws + 32;
  float m_reg = -1e30f, l_reg = 0; f32x16 o[2] = {}; bf16x8 qr[6];
  const bf16* Qw = Qb + (long)(wid * QBLK + r32) * QP + hi * 8;
#pragma unroll
  for (int d0 = 0; d0 < 6; ++d0) qr[d0] = *reinterpret_cast<const bf16x8*>(Qw + d0 * 16);
  {
    const int t = t0 + wid * QBLK + r32;
#pragma unroll
    for (int a = 0; a < 2; ++a) { const int pos = a ? (t & 63) : (t >> 6); const u32x4 w = __builtin_bit_cast(u32x4, qr[4 + a]); u32x4 o;
#pragma unroll
      for (int p = 0; p < 4; ++p) { const f32x2 cs = tab[pos * 8 + 4 * hi + p]; const float x1 = bflo(w[p]), x2 = bfhi(w[p]);
        o[p] = cvt_pk_bf16(x1 * cs.x - x2 * cs.y, x2 * cs.x + x1 * cs.y); }
      qr[4 + a] = __builtin_bit_cast(bf16x8, o); } }
  int goff[3], loff[3];
#pragma unroll
  for (int i = 0; i < 3; ++i) { int q = tid + 512 * i; if (q >= 1280) q -= 1280; const int key = q / 20, cc = q % 20;
    goff[i] = key * KVP + cc * 8;
    loff[i] = cc < 12 ? (2 * SHM_V + KSWZ(key, cc * 16)) : v_st(key, (cc - 12) * 8); }
  const bool w3 = tid < 256;
  const int vb0 = (int)(uintptr_t)V_lds + v_rd_base(lane);
  struct { bf16x8 c[3]; } sr_[2];
#define SLOAD(i, k0) do { _Pragma("unroll") for (int _j = 0; _j < 3; ++_j) sr_[i].c[_j] = *reinterpret_cast<const bf16x8*>(KVh + (long)(k0) * KVP + goff[_j]); } while (0)
#define SWRITE(b, i) do { *(LAS bf16x8*)(lds + (b) * SHM_V + loff[0]) = sr_[i].c[0]; *(LAS bf16x8*)(lds + (b) * SHM_V + loff[1]) = sr_[i].c[1]; \
    if (w3) *(LAS bf16x8*)(lds + (b) * SHM_V + loff[2]) = sr_[i].c[2]; } while (0)
#define SWAIT() asm volatile("s_waitcnt vmcnt(3)" ::: "memory")
#define RESC(a) do { if (__any((a) < 1.f)) { if (hi == 0) al_l[r32] = (a); asm volatile("s_waitcnt lgkmcnt(0)" ::: "memory"); \
    _Pragma("unroll") for (int d = 0; d < 2; ++d) _Pragma("unroll") for (int r = 0; r < 16; ++r) o[d][r] *= al_l[crow(r, hi)]; } } while (0)
  f32x16 pA0, pA1, pB0, pB1; float mnA, mnB, alA, alB; bf16x8 pa0, pa1, pa2, pa3; const int NT = seq / KVBLK;
  constexpr int SE = 0, SO = 1;
  SLOAD(SE, 0); asm volatile("s_waitcnt vmcnt(0)" ::: "memory"); SWRITE(0, SE); __syncthreads();
  qkt(pA0, pA1, K_lds, qr, r32, hi); partialSM(pA0, pA1, m_reg, mnA, alA);
  SLOAD(SO, KVBLK); if (2 < NT) SLOAD(SE, 2 * KVBLK);
  SWAIT(); SWRITE(1, SO); __syncthreads();
  for (int j = 1; j + 1 < NT; j += 2) {
    SBAR(); qkt(pB0, pB1, K_lds + SHM_K, qr, r32, hi);
    finishSM(pA0, pA1, alA, l_reg, pa0, pa1, pa2, pa3); SBAR();
    SLOAD(SO, (j + 2) * KVBLK); SBAR();
    pv_d0(o, vb0, pa0, pa1, pa2, pa3); partialSM(pB0, pB1, m_reg, mnB, alB);
    __syncthreads(); SWAIT(); SWRITE(0, SE);
    RESC(alB); __syncthreads();
    SBAR(); qkt(pA0, pA1, K_lds, qr, r32, hi);
    finishSM(pB0, pB1, alB, l_reg, pa0, pa1, pa2, pa3); SBAR();
    if (j + 3 < NT) SLOAD(SE, (j + 3) * KVBLK); SBAR();
    pv_d0(o, vb0 + SHM_V, pa0, pa1, pa2, pa3); partialSM(pA0, pA1, m_reg, mnA, alA);
    __syncthreads(); SWAIT(); SWRITE(1, SO);
    RESC(alA); __syncthreads();
  }
  SBAR(); qkt(pB0, pB1, K_lds + SHM_K, qr, r32, hi);
  finishSM(pA0, pA1, alA, l_reg, pa0, pa1, pa2, pa3); SBAR();
  pv_d0(o, vb0, pa0, pa1, pa2, pa3); partialSM(pB0, pB1, m_reg, mnB, alB);
  __syncthreads(); RESC(alB);
  finishSM(pB0, pB1, alB, l_reg, pa0, pa1, pa2, pa3); SBAR();
  pv_d0(o, vb0 + SHM_V, pa0, pa1, pa2, pa3);
  if (hi == 0) li_l[r32] = l_reg; asm volatile("s_waitcnt lgkmcnt(0)" ::: "memory");
  float rli[16];
#pragma unroll
  for (int r = 0; r < 16; ++r) rli[r] = __builtin_amdgcn_rcpf(li_l[crow(r, hi)]);
  bf16* Ow = Ob + (long)(wid * QBLK) * DM;
#pragma unroll
  for (int r = 0; r < 16; ++r) { int orow = crow(r, hi);
#pragma unroll
    for (int d0 = 0; d0 < 2; ++d0) Ow[(long)orow * DM + d0 * 32 + r32] = (bf16)f2bf(o[d0][r] * rli[r]); }
  __syncthreads();
#undef SLOAD
#undef SWRITE
#undef SWAIT
#undef RESC
}
}


namespace att2 {
constexpr int NW = 8, QBLK = 32, QB = 256, KVBLK = 64, NT = ROWS / KVBLK;
__device__ __forceinline__ int crow(int r, int hi) { return (r & 3) + 8 * (r >> 2) + 4 * hi; }
#define SBAR() __builtin_amdgcn_sched_barrier(0)
constexpr int NSLOT = 3, VSLOTB = 8192, KSLOTB = 16384;
constexpr int LDS_K = 0, LDS_V = NSLOT * KSLOTB, LDS_WS = LDS_V + NSLOT * VSLOTB, LDS_OST = LDS_WS + NW * 64 * 4, LDS_BYTES2 = LDS_OST + NW * 4096;
constexpr float C2 = 0.10206207261596575f * 1.4426950408889634f;
__device__ __forceinline__ void glds16(const void* gsrc, unsigned lds_dst) { unsigned keep;
  asm volatile("s_mov_b32 %0, m0\n\ts_mov_b32 m0, %2\n\ts_nop 0\n\tglobal_load_lds_dwordx4 %1, off\n\ts_mov_b32 m0, %0" : "=&s"(keep) : "v"(gsrc), "s"(lds_dst) : "memory"); }
__device__ __forceinline__ float max3f(float a, float b, float c) { float r; asm("v_max3_f32 %0, %1, %2, %3" : "=v"(r) : "v"(a), "v"(b), "v"(c)); return r; }
__device__ __forceinline__ float max2f(float a, float b) { float r; asm("v_max_f32_e32 %0, %1, %2" : "=v"(r) : "v"(a), "v"(b)); return r; }
__device__ __forceinline__ float fadd_s(float a, float b) { float r; asm("v_add_f32_e32 %0, %1, %2" : "=v"(r) : "v"(a), "v"(b)); return r; }
__device__ __forceinline__ float fsub_s(float a, float b) { float r; asm("v_sub_f32_e32 %0, %1, %2" : "=v"(r) : "v"(a), "v"(b)); return r; }
#define WAIT_BAR(N) asm volatile("s_waitcnt vmcnt(" #N ") lgkmcnt(0)\n\ts_barrier" ::: "memory")
typedef LAS const char* lds_cptr;
typedef short v4i16_t __attribute__((ext_vector_type(4)));
__device__ __forceinline__ void qkt0(f32x16& p0, f32x16& p1, lds_cptr Kslot, const bf16x8* qr, const f32x16& negm, int r32, int hi) {
  lds_cptr kb = Kslot + hi * 1024 + r32 * 16;
#pragma unroll
  for (int d0 = 0; d0 < 6; ++d0) {
    const bf16x8 b0 = *reinterpret_cast<const LAS bf16x8*>(kb + d0 * 2048);
    const bf16x8 b1 = *reinterpret_cast<const LAS bf16x8*>(kb + d0 * 2048 + 512);
    if (d0 == 0) { p0 = __builtin_amdgcn_mfma_f32_32x32x16_bf16(b0, qr[0], negm, 0, 0, 0); p1 = __builtin_amdgcn_mfma_f32_32x32x16_bf16(b1, qr[0], negm, 0, 0, 0); }
    else { p0 = __builtin_amdgcn_mfma_f32_32x32x16_bf16(b0, qr[d0], p0, 0, 0, 0); p1 = __builtin_amdgcn_mfma_f32_32x32x16_bf16(b1, qr[d0], p1, 0, 0, 0); } }
}
__device__ __forceinline__ void kload2(bf16x8* kf, lds_cptr kp, int j) { kf[2 * j] = *(const LAS bf16x8*)(kp + j * 2048); kf[2 * j + 1] = *(const LAS bf16x8*)(kp + j * 2048 + 512); }
__device__ __forceinline__ s16x4 vtr(lds_cptr p) { return __builtin_bit_cast(s16x4, __builtin_amdgcn_ds_read_tr16_b64_v4i16((LAS v4i16_t*)p)); }
__device__ __forceinline__ float rowmax(const f32x16& p0, const f32x16& p1) {
  float a = max3f(p0[0], p0[1], p1[0]), b = max3f(p0[2], p0[3], p1[1]); a = max3f(a, p1[2], p1[3]);
#pragma unroll
  for (int r = 4; r < 16; r += 4) { a = max3f(a, p0[r], p0[r + 1]); b = max3f(b, p0[r + 2], p0[r + 3]); a = max3f(a, p1[r], p1[r + 1]); b = max3f(b, p1[r + 2], p1[r + 3]); }
  const float m = max2f(a, b);
  auto rr = __builtin_amdgcn_permlane32_swap(__float_as_uint(m), __float_as_uint(m), false, false);
  return max2f(__uint_as_float(rr[0]), __uint_as_float(rr[1]));
}
__device__ __forceinline__ void pv(f32x16* o, int vb, bf16x8 pa0, bf16x8 pa1, bf16x8 pa2, bf16x8 pa3) {
#pragma unroll
  for (int d0 = 0; d0 < 2; ++d0) { s16x4 lo[4], hi[4];
#pragma unroll
    for (int ks = 0; ks < 4; ++ks) {
      asm volatile("ds_read_b64_tr_b16 %0,%1 offset:%c2" : "=&v"(lo[ks]) : "v"(vb), "i"(d0 * 4096 + ks * 1024) : "memory");
      asm volatile("ds_read_b64_tr_b16 %0,%1 offset:%c2" : "=&v"(hi[ks]) : "v"(vb), "i"(d0 * 4096 + ks * 1024 + 512) : "memory"); }
    asm volatile("s_waitcnt lgkmcnt(0)" ::: "memory"); SBAR();
#define PK(k) (bf16x8){lo[k][0], lo[k][1], lo[k][2], lo[k][3], hi[k][0], hi[k][1], hi[k][2], hi[k][3]}
    o[d0] = __builtin_amdgcn_mfma_f32_32x32x16_bf16(pa0, PK(0), o[d0], 0, 0, 0);
    o[d0] = __builtin_amdgcn_mfma_f32_32x32x16_bf16(pa1, PK(1), o[d0], 0, 0, 0);
    o[d0] = __builtin_amdgcn_mfma_f32_32x32x16_bf16(pa2, PK(2), o[d0], 0, 0, 0);
    o[d0] = __builtin_amdgcn_mfma_f32_32x32x16_bf16(pa3, PK(3), o[d0], 0, 0, 0);
#undef PK
  }
}
template <int THRL> __device__ __forceinline__ void attn_unit(int h, int q0, const bf16* Q, const bf16* __restrict__ KV, bf16* O, char* shm, const f32x2* __restrict__ tab, int wave) {
  const int lane = lane_id_opaque(), r32 = lane & 31, hi = lane >> 5; const int wid = wave;
  const bf16* Qw = Q + (long)(q0 + wid * QBLK) * QP + h * QH;
  const bf16* Kh = KV + h * KVH; const bf16* Vh = KV + h * KVH + 96;
  const unsigned lds0 = (unsigned)(uintptr_t)shm;
  float* wsf = (float*)(shm + LDS_WS) + wid * 64;
  const bf16* ksrc0 = Kh + (long)lane * KVP + wid * 8; const bf16* ksrc1 = ksrc0 + 64;
  const bf16* vsrc = Vh + (long)(16 * (wid & 3) + (lane >> 2)) * KVP + (wid >> 2) * 32 + (lane & 3) * 8;
  const unsigned kdst = lds0 + LDS_K + wid * 1024, vdst = lds0 + LDS_V + wid * 1024;
#define DMA_K(t, vsl) do { glds16(ksrc0 + (long)(t) * KVBLK * KVP, (unsigned)__builtin_amdgcn_readfirstlane(kdst + 2 * (vsl))); glds16(ksrc1 + (long)(t) * KVBLK * KVP, (unsigned)__builtin_amdgcn_readfirstlane(kdst + 8192 + 2 * (vsl))); } while (0)
#define DMA_V(t, vsl) glds16(vsrc + (long)(t) * KVBLK * KVP, (unsigned)__builtin_amdgcn_readfirstlane(vdst + (vsl)))
  const int vb0 = (int)(lds0 + LDS_V) + ((lane >> 4) & 1) * 32 + (lane & 3) * 8 + (4 * hi + ((lane & 15) >> 2)) * 64;
  bf16x8 kf[12];
  const lds_cptr shm3 = (lds_cptr)(LAS char*)(uintptr_t)lds0; const lds_cptr kp0 = shm3 + LDS_K + hi * 1024 + r32 * 16; const lds_cptr vp0 = shm3 + LDS_V + ((lane >> 4) & 1) * 32 + (lane & 3) * 8 + (4 * hi + ((lane & 15) >> 2)) * 64;
  DMA_K(0, 0); DMA_V(0, 0); DMA_K(1, VSLOTB);
  bf16x8 qr[6];
#pragma unroll
  for (int d0 = 0; d0 < 6; ++d0) qr[d0] = *reinterpret_cast<const bf16x8*>(&Qw[(long)r32 * QP + d0 * 16 + hi * 8]);
  { const int t = q0 + wid * QBLK + r32;
#pragma unroll
    for (int a = 0; a < 2; ++a) { const int pos = a ? (t & 63) : (t >> 6); const u32x4 w = __builtin_bit_cast(u32x4, qr[4 + a]); u32x4 ow;
#pragma unroll
      for (int p = 0; p < 4; ++p) { const f32x2 cs = tab[pos * 8 + 4 * hi + p]; const float x1 = bflo(w[p]), x2 = bfhi(w[p]);
        ow[p] = cvt_pk_bf16(x1 * cs.x - x2 * cs.y, x2 * cs.x + x1 * cs.y); }
      qr[4 + a] = __builtin_bit_cast(bf16x8, ow); } }
  float mhat = 0.f, l_reg = 0.f; f32x16 o[2]; o[0] = f32x16{}; o[1] = f32x16{}; f32x16 negm = f32x16{}; asm volatile("" : "+v"(negm));
  bool resc = false;
#define START(P0, P1) do { const float rm = rowmax(P0, P1); resc = false; \
    { const float dl = rm; mhat = fadd_s(mhat, dl); \
      _Pragma("unroll") for (int r = 0; r < 16; ++r) { P0[r] = fsub_s(P0[r], dl); P1[r] = fsub_s(P1[r], dl); } \
      _Pragma("unroll") for (int r = 0; r < 16; ++r) negm[r] = -mhat; asm volatile("" : "+v"(negm)); } \
    _Pragma("unroll") for (int r = 0; r < 16; ++r) P0[r] = __builtin_amdgcn_exp2f(P0[r]); } while (0)
#define RESC() do { if (resc) { asm volatile("s_waitcnt lgkmcnt(0)" ::: "memory"); \
      _Pragma("unroll") for (int d_ = 0; d_ < 2; ++d_) _Pragma("unroll") for (int r = 0; r < 16; ++r) o[d_][r] *= wsf[crow(r, hi)]; } } while (0)
  f32x16 pA0, pA1, pB0, pB1;
  int sl_prev = 0, sl_cur = 0, sl_next = VSLOTB;
#define ROT() do { sl_prev = sl_cur; sl_cur = sl_next; sl_next = (sl_next == (NSLOT - 1) * VSLOTB) ? 0 : sl_next + VSLOTB; } while (0)
  DMA_K(2, 2 * VSLOTB);
  WAIT_BAR(2);
  qkt0(pA0, pA1, shm3 + LDS_K, qr, negm, r32, hi); asm volatile("s_nop 15\n\ts_nop 7" : "+v"(pA0), "+v"(pA1));
  START(pA0, pA1);
  _Pragma("unroll") for (int r = 0; r < 16; ++r) pA1[r] = __builtin_amdgcn_exp2f(pA1[r]);
  WAIT_BAR(0);
  DMA_K(3, 0); DMA_V(1, VSLOTB);
  ROT();
  kload2(kf, kp0 + 2 * sl_cur, 0); kload2(kf, kp0 + 2 * sl_cur, 1); kload2(kf, kp0 + 2 * sl_cur, 2); kload2(kf, kp0 + 2 * sl_cur, 3); kload2(kf, kp0 + 2 * sl_cur, 4); kload2(kf, kp0 + 2 * sl_cur, 5);
  WAIT_BAR(3);
  s16x4 vlo[8], vhi[8]; u32x4 pw0, pw1, pw2, pw3;
#define PKW(P, B) cvt_pk_bf16(P[B], P[B + 1])
#define PAF(k) __builtin_bit_cast(bf16x8, pw##k)
#define VFR(i) (bf16x8){vlo[i][0], vlo[i][1], vlo[i][2], vlo[i][3], vhi[i][0], vhi[i][1], vhi[i][2], vhi[i][3]}
#define PIN(x) asm volatile("" : "+v"(x))
#define MX3(a, b, c) __builtin_fmaxf(__builtin_fmaxf((a), (b)), (c))
#define GAPA(MF, A0, A1, A2, W0, PW) do { MF; sacc += A0; sacc += A1; sacc += A2; PIN(sacc); W0; PIN(PW); SBAR(); } while (0)
#define GAPA2(MF, A0, A1, A2, W0, W1, PW) do { MF; sacc += A0; sacc += A1; sacc += A2; PIN(sacc); W0; W1; PIN(PW); SBAR(); } while (0)
#define GAPA3(MF, W0, W1, PW) do { MF; W0; W1; PIN(PW); SBAR(); } while (0)
#define EX(v) __builtin_amdgcn_exp2f(v)
#define GAPB(MF, X, B) do { MF; X[B] = EX(X[B]); X[B + 1] = EX(X[B + 1]); X[B + 2] = EX(X[B + 2]); X[B + 3] = EX(X[B + 3]); PIN(X); SBAR(); } while (0)
#define VRD(i) do { vlo[i] = vtr(vp_ + (((i) >> 2) * 4096 + ((i) & 3) * 1024)); vhi[i] = vtr(vp_ + (((i) >> 2) * 4096 + ((i) & 3) * 1024 + 512)); } while (0)
#define KRD(G, j) do { if (G) { kload2(kf, kp0 + 2 * sl_next, j); SBAR(); } } while (0)
#define MFM(a, b, c) __builtin_amdgcn_mfma_f32_32x32x16_bf16(a, b, c, 0, 0, 0)
#define STEP(C0, C1, P0, P1, t, GK, GV, GL) do { SBAR(); \
    const lds_cptr vp_ = vp0 + sl_prev; \
    VRD(0); SBAR(); float sacc = (P0[0] + P0[1]); \
    GAPA(C0 = MFM(kf[0], qr[0], negm), P0[2], P0[3], P0[4], pw0[0] = PKW(P0, 0), pw0); \
    VRD(4); SBAR(); GAPA(C1 = MFM(kf[1], qr[0], negm), P0[5], P0[6], P0[7], pw0[1] = PKW(P0, 2), pw0); \
    VRD(1); SBAR(); GAPA(C0 = MFM(kf[2], qr[1], C0), P0[8], P0[9], P0[10], pw0[2] = PKW(P0, 4), pw0); \
    VRD(5); SBAR(); GAPA(C1 = MFM(kf[3], qr[1], C1), P0[11], P0[12], P0[13], pw0[3] = PKW(P0, 6), pw0); \
    VRD(2); SBAR(); GAPA(C0 = MFM(kf[4], qr[2], C0), P0[14], P0[15], P1[0], pw1[0] = PKW(P0, 8), pw1); \
    VRD(6); SBAR(); GAPA(C1 = MFM(kf[5], qr[2], C1), P1[1], P1[2], P1[3], pw1[1] = PKW(P0, 10), pw1); \
    VRD(3); SBAR(); GAPA(C0 = MFM(kf[6], qr[3], C0), P1[4], P1[5], P1[6], pw1[2] = PKW(P0, 12), pw1); \
    VRD(7); SBAR(); GAPA(C1 = MFM(kf[7], qr[3], C1), P1[7], P1[8], P1[9], pw1[3] = PKW(P0, 14), pw1); \
    GAPA2(C0 = MFM(kf[8], qr[4], C0), P1[10], P1[11], P1[12], pw2[0] = PKW(P1, 0), pw2[1] = PKW(P1, 2), pw2); \
    GAPA2(C1 = MFM(kf[9], qr[4], C1), P1[13], P1[14], P1[15], pw2[2] = PKW(P1, 4), pw2[3] = PKW(P1, 6), pw2); \
    GAPA3(C0 = MFM(kf[10], qr[5], C0), pw3[0] = PKW(P1, 8), pw3[1] = PKW(P1, 10), pw3); \
    GAPA3(C1 = MFM(kf[11], qr[5], C1), pw3[2] = PKW(P1, 12), pw3[3] = PKW(P1, 14), pw3); \
    l_reg += sacc; \
    if (GK) { DMA_K((t) + 3, sl_cur); } if (GV) { DMA_V((t) + 1, sl_next); } \
    { float a = MX3(C0[0], C0[1], C1[0]), b = MX3(C0[2], C0[3], C1[1]); a = MX3(a, C1[2], C1[3]); \
      _Pragma("unroll") for (int r = 4; r < 16; r += 4) { a = MX3(a, C0[r], C0[r + 1]); b = MX3(b, C0[r + 2], C0[r + 3]); a = MX3(a, C1[r], C1[r + 1]); b = MX3(b, C1[r + 2], C1[r + 3]); } \
      float rm = __builtin_fmaxf(a, b); { auto rr = __builtin_amdgcn_permlane32_swap(__float_as_uint(rm), __float_as_uint(rm), false, false); rm = __builtin_fmaxf(__uint_as_float(rr[0]), __uint_as_float(rr[1])); } \
      resc = false; \
      if (__builtin_expect(__any(rm > (float)THRL), 0)) { const float dl = __builtin_fmaxf(rm, 0.f); mhat += dl; \
        _Pragma("unroll") for (int r = 0; r < 16; ++r) { C0[r] -= dl; C1[r] -= dl; } \
        _Pragma("unroll") for (int r = 0; r < 16; ++r) negm[r] = -mhat; asm volatile("" : "+v"(negm)); \
        const float f = __builtin_amdgcn_exp2f(-dl); l_reg *= f; if (hi == 0) wsf[r32] = f; resc = true; } } \
    SBAR(); \
    GAPB(o[0] = MFM(PAF(0), VFR(0), o[0]), C0, 0); \
    KRD(GL, 0); GAPB(o[1] = MFM(PAF(0), VFR(4), o[1]), C0, 4); \
    KRD(GL, 1); GAPB(o[0] = MFM(PAF(1), VFR(1), o[0]), C0, 8); \
    KRD(GL, 2); GAPB(o[1] = MFM(PAF(1), VFR(5), o[1]), C0, 12); \
    KRD(GL, 3); GAPB(o[0] = MFM(PAF(2), VFR(2), o[0]), C1, 0); \
    KRD(GL, 4); GAPB(o[1] = MFM(PAF(2), VFR(6), o[1]), C1, 4); \
    KRD(GL, 5); GAPB(o[0] = MFM(PAF(3), VFR(3), o[0]), C1, 8); \
    GAPB(o[1] = MFM(PAF(3), VFR(7), o[1]), C1, 12); \
    } while (0)
  int t = 1;
  for (; t + 4 < NT; t += 2) {
    STEP(pB0, pB1, pA0, pA1, t, true, true, true);     WAIT_BAR(3); RESC(); ROT();
    STEP(pA0, pA1, pB0, pB1, t + 1, true, true, true); WAIT_BAR(3); RESC(); ROT();
  }
  STEP(pB0, pB1, pA0, pA1, NT - 3, false, true, true);  WAIT_BAR(1); RESC(); ROT();
  STEP(pA0, pA1, pB0, pB1, NT - 2, false, true, true);  WAIT_BAR(0); RESC(); ROT();
  STEP(pB0, pB1, pA0, pA1, NT - 1, false, false, false); RESC();
  { float sacc = pB0[0] + pB0[1];
    _Pragma("unroll") for (int r = 2; r < 16; ++r) sacc += pB0[r];
    _Pragma("unroll") for (int r = 0; r < 16; ++r) sacc += pB1[r];
    l_reg += sacc;
    pw0 = (u32x4){PKW(pB0, 0), PKW(pB0, 2), PKW(pB0, 4), PKW(pB0, 6)}; pw1 = (u32x4){PKW(pB0, 8), PKW(pB0, 10), PKW(pB0, 12), PKW(pB0, 14)};
    pw2 = (u32x4){PKW(pB1, 0), PKW(pB1, 2), PKW(pB1, 4), PKW(pB1, 6)}; pw3 = (u32x4){PKW(pB1, 8), PKW(pB1, 10), PKW(pB1, 12), PKW(pB1, 14)};
    SBAR(); pv(o, vb0 + sl_cur, PAF(0), PAF(1), PAF(2), PAF(3)); }
  { auto rr = __builtin_amdgcn_permlane32_swap(__float_as_uint(l_reg), __float_as_uint(l_reg), false, false); l_reg = __uint_as_float(rr[0]) + __uint_as_float(rr[1]); }
  if (hi == 0) wsf[32 + r32] = l_reg; asm volatile("s_waitcnt lgkmcnt(0)" ::: "memory");
  float rli[16];
#pragma unroll
  for (int r = 0; r < 16; ++r) rli[r] = __builtin_amdgcn_rcpf(wsf[32 + crow(r, hi)]);
  bf16* Ow = O + (long)(q0 + wid * QBLK) * DM + h * 64;
  { bf16* stg = (bf16*)(shm + LDS_OST) + wid * 2048;
#pragma unroll
    for (int r = 0; r < 16; ++r) { const int orow = crow(r, hi);
#pragma unroll
      for (int d0 = 0; d0 < 2; ++d0) stg[orow * 64 + d0 * 32 + r32] = (bf16)f2bf(o[d0][r] * rli[r]); }
    asm volatile("s_waitcnt lgkmcnt(0)" ::: "memory");
#pragma unroll
    for (int i = 0; i < 4; ++i) { const int row = i * 8 + (lane >> 3), ch = lane & 7; const u32x4 v = *(const u32x4*)(stg + row * 64 + ch * 8); *(u32x4*)(Ow + (long)row * DM + ch * 8) = v; } }
  asm volatile("s_waitcnt vmcnt(0) lgkmcnt(0)\n\ts_barrier" ::: "memory");
#undef DMA_K
#undef DMA_V
#undef START
#undef RESC
#undef ROT
#undef PKW
#undef PAF
#undef VFR
#undef PIN
#undef MX3
#undef GAPA
#undef GAPA2
#undef GAPA3
#undef EX
#undef GAPB
#undef VRD
#undef KRD
#undef MFM
#undef STEP
}
#undef SBAR
#undef WAIT_BAR
}

typedef GAS unsigned gu32;
#define RLX_AGENT __ATOMIC_RELAXED, __HIP_MEMORY_SCOPE_AGENT
#define XB_TMO      128
#define XB_XCNT(j)  (256  + 64 * (j))
#define XB_XSUB(j)  (1280 + 64 * (j))
#define XB_XGEN(j)  (2304 + 64 * (j))
#define XB_TOP      3328
#define XB_TOPGEN   3392
#define XCD_BAR_WORDS 3456
#define XB_SPIN_CAP (1u << 21)
__device__ __forceinline__ unsigned xb_ld(unsigned* p)              { return __hip_atomic_load(p, __ATOMIC_RELAXED, __HIP_MEMORY_SCOPE_AGENT); }
__device__ __forceinline__ unsigned xb_add(unsigned* p, unsigned v) { return __hip_atomic_fetch_add(p, v, __ATOMIC_RELAXED, __HIP_MEMORY_SCOPE_AGENT); }
__device__ __forceinline__ unsigned xb_xcc_id() { return (unsigned)__builtin_amdgcn_s_getreg((3 << 11) | 20) & 0xFu; }
#define XB_CODE 192
#define XB_SPIN(cond, bar, code) do { unsigned _sp = 0; while (cond) { __builtin_amdgcn_s_sleep(1); \
    if ((++_sp & 255u) == 0u) { if (xb_ld(&(bar)[XB_TMO])) break; if (_sp > XB_SPIN_CAP) { atomicCAS(&(bar)[XB_CODE], 0u, (unsigned)(code)); atomicAdd(&(bar)[XB_TMO], 1u); break; } } } } while (0)
struct XcdBarrier { unsigned* bar; unsigned x; volatile LAS unsigned* st; };
__device__ __forceinline__ XcdBarrier xcd_barrier_post(unsigned* bar, volatile LAS unsigned* st, int tid) {
    XcdBarrier b; b.bar = bar; b.x = xb_xcc_id(); b.st = st;
    if (tid == 0) (void)xb_add(&bar[XB_XCNT(b.x)], 1u);
    return b;
}
__device__ __forceinline__ void xcd_barrier_complete(unsigned* bar, unsigned x, unsigned& nloc, unsigned& nx) {
    const unsigned G = gridDim.x * gridDim.y * gridDim.z;
    unsigned sum, cnt, mine, sp = 0u;
    for (;;) {
        sum = 0u; cnt = 0u; mine = 0u;
#pragma unroll
        for (unsigned j = 0; j < 16; ++j) { const unsigned c = xb_ld(&bar[XB_XCNT(j)]); sum += c; cnt += (c > 0u) ? 1u : 0u; mine = (j == x) ? c : mine; }
        if (sum == G) break;
        __builtin_amdgcn_s_sleep(1);
        if ((++sp & 255u) == 0u) { if (xb_ld(&bar[XB_TMO])) break; if (sp > XB_SPIN_CAP) { atomicCAS(&bar[XB_CODE], 0u, 1u); atomicAdd(&bar[XB_TMO], 1u); break; } }
    }
    nloc = mine > 0u ? mine : 1u; nx = cnt > 0u ? cnt : 1u;
}
__device__ __forceinline__ void xcd_barrier(const XcdBarrier& b, unsigned seq, int tid) {
    asm volatile("s_waitcnt vmcnt(0)" ::: "memory");
    __syncthreads();
    if (tid == 0) {
        unsigned* bar = b.bar;
        __builtin_amdgcn_s_waitcnt(0);
        unsigned nloc = b.st[0], nx = b.st[1];
        if (nloc == 0u) { xcd_barrier_complete(bar, b.x, nloc, nx); b.st[0] = nloc; b.st[1] = nx; }
        const unsigned old = xb_add(&bar[XB_XSUB(b.x)], 1u);
        const unsigned gen = old / nloc;
        if (old + 1u == (gen + 1u) * nloc) {
            __builtin_amdgcn_fence(__ATOMIC_RELEASE, "agent");
            asm volatile("s_waitcnt vmcnt(0)" ::: "memory");
            const unsigned og = xb_add(&bar[XB_TOP], 1u);
            const unsigned tg = og / nx;
            if (og + 1u == (tg + 1u) * nx) xb_add(&bar[XB_TOPGEN], 1u);
            else XB_SPIN(xb_ld(&bar[XB_TOPGEN]) == tg, bar, 10u * seq + 2u);
            __builtin_amdgcn_fence(__ATOMIC_ACQUIRE, "agent");
            xb_add(&bar[XB_XGEN(b.x)], 1u);
            asm volatile("s_waitcnt vmcnt(0)" ::: "memory");
        } else {
            XB_SPIN(xb_ld(&bar[XB_XGEN(b.x)]) == gen, bar, 10u * seq + 3u);
            __builtin_amdgcn_fence(__ATOMIC_ACQUIRE, "agent");
            asm volatile("s_waitcnt vmcnt(0)" ::: "memory");
        }
    }
    __syncthreads();
}

constexpr int NWAVES = 8;
constexpr int RING_OFF = 0, RING_BYTES = 131072;
constexpr int LDSCTL_OFF = RING_BYTES, MISC_OFF = LDSCTL_OFF + 320;
constexpr int LDS_BYTES = 147456;
static_assert(att::SHM_ATTN <= RING_BYTES, "attention LDS");

struct Frame {
    LAS unsigned char* lds;
    volatile LAS unsigned* MISC;
    int tid, lane, wave, vcu, G;
    const float* in[23]; float* out; unsigned char* ws;
};
enum { I_X = 0, I_C, I_CTX, I_CCTX, I_WADA, I_BADA, I_NPRE, I_NPOST, I_F1IN, I_F1OUT, I_F2IN, I_F2OUT, I_WIN, I_QNORM, I_WQB, I_KVNORM, I_WKVB,
       I_WAF, I_BAF, I_WAB, I_BAB, I_GNORM, I_WOUT };

template <class Map>
__device__ __forceinline__ void transpose_item(const float* W, int Ns, bf16* WT, int ldd, LAS float* scr, int k0, int n0, int lane, Map srcmap) {
    const int sc = srcmap(n0 + (lane & 31));
    float tv[32];
#pragma unroll
    for (int i = 0; i < 32; ++i) { const int kk = 2 * i + (lane >> 5); tv[i] = sc >= 0 ? W[(size_t)(k0 + kk) * Ns + sc] : 0.f; }
#pragma unroll
    for (int i = 0; i < 32; ++i) { const int kk = 2 * i + (lane >> 5); scr[kk * 33 + (lane & 31)] = tv[i]; }
    LDS_WAIT(); asm volatile("" ::: "memory");
    const int c = lane & 7;
#pragma unroll
    for (int j = 0; j < 4; ++j) { const int n = (lane >> 3) + 8 * j; const LAS float* s = scr + (8 * c) * 33 + n;
        u32x4 o; o.x = cvt_pk_bf16(s[0 * 33], s[1 * 33]); o.y = cvt_pk_bf16(s[2 * 33], s[3 * 33]); o.z = cvt_pk_bf16(s[4 * 33], s[5 * 33]); o.w = cvt_pk_bf16(s[6 * 33], s[7 * 33]);
        *(GAS u32x4*)(WT + (size_t)(n0 + n) * ldd + k0 + 8 * c) = o; }
    LDS_WAIT(); asm volatile("" ::: "memory");
}
struct MapId { __device__ int operator()(int n) const { return n; } };
struct MapFfnIn { __device__ int operator()(int n) const { const int pn = n >> 8, c = n & 255; return c < 128 ? 128 * pn + c : DFF + 128 * pn + (c - 128); } };
struct MapWin { __device__ int operator()(int n) const {
    if (n < 416) return n;
    if (n < 448) return 1952 + (n - 416);
    if (n < 512) return -1;
    if (n < 768) return 416 + (n - 512);
    if (n < 1024) return 672 + (n - 768);
    if (n < 1536) return 928 + (n - 1024);
    return 1440 + (n - 1536); } };
struct MapWqb { __device__ int operator()(int n) const { const int h = n / QH, j = n % QH; if (j < 64) return h * QH + j;
    const int jj = j - 64, i = jj >> 1, p = jj & 1, a = i >> 3, f = i & 7; return h * QH + 64 + 16 * a + 8 * p + f; } };

__device__ __forceinline__ void p0_prologue(Frame& F) {
    LAS float* scr = (LAS float*)(F.lds + RING_OFF + F.wave * 16384);
    const int gw = F.vcu * NWAVES + F.wave, NGW = F.G * NWAVES;
    for (int idx = F.vcu * 512 + F.tid; idx < 2048; idx += F.G * 512) {
        const int pos = idx >> 3, f = idx & 7;
        const float invf = f == 0 ? 1.0f : f == 1 ? 0.31622776601683794f : f == 2 ? 0.1f : f == 3 ? 0.031622776601683794f : f == 4 ? 0.01f : f == 5 ? 0.0031622776601683794f : f == 6 ? 0.001f : 0.00031622776601683794f;
        const float ang = (float)pos * invf;
        double t = (double)ang * 0.15915494309189535; t -= floor(t);
        const float tf = (float)t;
        f32x2 cs; cs.x = __builtin_amdgcn_cosf(tf); cs.y = __builtin_amdgcn_sinf(tf);
        ((f32x2*)(F.ws + WS_ROPE))[idx] = cs;
    }
    if (F.vcu < 144) {
        LAS float* sl = (LAS float*)(F.lds + 100 * 1024);
        LAS float* red = (LAS float*)(F.lds + 108 * 1024);
        for (int i = F.tid; i < 2048; i += 512) { const float v = i < 1024 ? F.in[I_C][i] : F.in[I_CCTX][i - 1024]; sl[i] = v / (1.0f + expf(-v)); }
        __syncthreads();
        for (int u = F.vcu; u < 144; u += F.G) {
            const int cq = F.tid & 15, kg = F.tid >> 4;
            const float* Wp = F.in[I_WADA] + (size_t)u * 64 + cq * 4;
            f32x4 al = {0.f, 0.f, 0.f, 0.f}, ac = {0.f, 0.f, 0.f, 0.f};
#pragma unroll 8
            for (int i = 0; i < 32; ++i) { const int k = kg + 32 * i; const f32x4 w = *(const f32x4*)(Wp + (size_t)k * NMODV); al += w * sl[k]; ac += w * sl[1024 + k]; }
            *(LAS f32x4*)(red + kg * 128 + cq * 4) = al; *(LAS f32x4*)(red + kg * 128 + 64 + cq * 4) = ac;
            __syncthreads();
            if (F.tid < 128) { float s = 0.f;
#pragma unroll
                for (int g = 0; g < 32; ++g) s += red[g * 128 + F.tid];
                const int ty = F.tid >> 6, col = u * 64 + (F.tid & 63);
                ((float*)(F.ws + WS_MOD))[ty * NMODV + col] = s + F.in[I_BADA][col]; }
            __syncthreads();
        }
    }
    constexpr int I_1IN = 16 * 176, I_1OUT = 44 * 32, I_WN = 16 * 64, I_QB = 4 * 24, I_KVB = 2 * 32, I_OUT = 16 * 32;
    constexpr int NITEMS = 2 * I_1IN + 2 * I_1OUT + I_WN + I_QB + I_KVB + I_OUT;
    for (int it = gw; it < NITEMS; it += NGW) {
        int r = it;
        if (r < I_1IN) { transpose_item(F.in[I_F1IN], 2 * DFF, (bf16*)(F.ws + WS_W1IN), DM, scr, 64 * (r / 176), 32 * (r % 176), F.lane, MapFfnIn()); continue; } r -= I_1IN;
        if (r < I_1IN) { transpose_item(F.in[I_F2IN], 2 * DFF, (bf16*)(F.ws + WS_W2IN), DM, scr, 64 * (r / 176), 32 * (r % 176), F.lane, MapFfnIn()); continue; } r -= I_1IN;
        if (r < I_1OUT) { transpose_item(F.in[I_F1OUT], DM, (bf16*)(F.ws + WS_W1OUT), DFF, scr, 64 * (r / 32), 32 * (r % 32), F.lane, MapId()); continue; } r -= I_1OUT;
        if (r < I_1OUT) { transpose_item(F.in[I_F2OUT], DM, (bf16*)(F.ws + WS_W2OUT), DFF, scr, 64 * (r / 32), 32 * (r % 32), F.lane, MapId()); continue; } r -= I_1OUT;
        if (r < I_WN) { transpose_item(F.in[I_WIN], 1984, (bf16*)(F.ws + WS_WIN), DM, scr, 64 * (r / 64), 32 * (r % 64), F.lane, MapWin()); continue; } r -= I_WN;
        if (r < I_QB) { transpose_item(F.in[I_WQB], QP, (bf16*)(F.ws + WS_WQB), 256, scr, 64 * (r / 24), 32 * (r % 24), F.lane, MapWqb()); continue; } r -= I_QB;
        if (r < I_KVB) { transpose_item(F.in[I_WKVB], 1024, (bf16*)(F.ws + WS_WKVB), 256, scr, 64 * (r / 32), 32 * (r % 32), F.lane, MapId()); continue; } r -= I_KVB;
        transpose_item(F.in[I_WOUT], DM, (bf16*)(F.ws + WS_WOUT), DM, scr, 64 * (r / 32), 32 * (r % 32), F.lane, MapId());
    }
    for (int i = F.vcu * 512 + F.tid; i < 1024 * 16; i += F.G * 512) { const int n = i >> 4, c = i & 15;
        *(GAS u32x4*)((bf16*)(F.ws + WS_WKVB) + (size_t)n * 256 + 128 + c * 8) = (u32x4){0u, 0u, 0u, 0u}; }
}

struct NormArgs { const float* src; const float* y; float* resout; bf16* hout; const float* gate; const float* shift; const float* scale; int nsl; };
template <int NR>
__device__ __forceinline__ void norm_rows(int lane, const NormArgs (&a)[NR], int nvalid, float gsc, const float* gpost, const float* gpre, size_t sstride) {
    f32x4 v[NR][4]; f32x4 yv[NR][4];
#pragma unroll
    for (int k = 0; k < NR; ++k) if (k < nvalid) {
#pragma unroll
        for (int j = 0; j < 4; ++j) v[k][j] = *((const f32x4*)a[k].src + lane + 64 * j);
        if (a[k].y) {
#pragma unroll
            for (int j = 0; j < 4; ++j) yv[k][j] = *((const f32x4*)a[k].y + lane + 64 * j); } }
#pragma unroll
    for (int k = 0; k < NR; ++k) if (k < nvalid) {
        if (a[k].y) { float s = 0.f;
#pragma unroll
            for (int j = 0; j < 4; ++j) { for (int sl = 1; sl < a[k].nsl; ++sl) yv[k][j] += *((const f32x4*)(a[k].y + sl * sstride) + lane + 64 * j);
                s += (yv[k][j].x * yv[k][j].x + yv[k][j].y * yv[k][j].y) + (yv[k][j].z * yv[k][j].z + yv[k][j].w * yv[k][j].w); }
            const float rstd = 1.0f / sqrtf(wave_sum(s) * (1.f / DM) + EPS);
#pragma unroll
            for (int j = 0; j < 4; ++j) { const f32x4 g = *((const f32x4*)a[k].gate + lane + 64 * j), p = *((const f32x4*)gpost + lane + 64 * j);
                v[k][j] = v[k][j] + (yv[k][j] * rstd) * p * g * gsc; } }
        if (a[k].resout) {
#pragma unroll
            for (int j = 0; j < 4; ++j) *((f32x4*)a[k].resout + lane + 64 * j) = v[k][j]; }
        if (a[k].hout) { float s = 0.f;
#pragma unroll
            for (int j = 0; j < 4; ++j) s += (v[k][j].x * v[k][j].x + v[k][j].y * v[k][j].y) + (v[k][j].z * v[k][j].z + v[k][j].w * v[k][j].w);
            const float rstd = 1.0f / sqrtf(wave_sum(s) * (1.f / DM) + EPS);
#pragma unroll
            for (int j = 0; j < 4; ++j) { const f32x4 g = *((const f32x4*)gpre + lane + 64 * j), sh = *((const f32x4*)a[k].shift + lane + 64 * j), sc = *((const f32x4*)a[k].scale + lane + 64 * j);
                const f32x4 h = (v[k][j] * rstd) * g * (sc + 1.0f) + sh;
                u32x2 w; w.x = cvt_pk_bf16(h.x, h.y); w.y = cvt_pk_bf16(h.z, h.w);
                *((u32x2*)a[k].hout + lane + 64 * j) = w; } } }
}

__device__ __forceinline__ void mixer_rows4(Frame& F, int rowb) {
    const int lane = lane_id_opaque();
    const bf16* Zq = (const bf16*)(F.ws + WS_ZQ); const float* Z1f = (const float*)(F.ws + WS_Z1F);
    bf16* KV = (bf16*)(F.ws + WS_KV);
    const bool lat = rowb >= CTX;
    u32x2 qw[4]; f32x4 cv[4]; float x1[4], x2[4];
    const int pi = lane & 15, pa = pi >> 3, pf = pi & 7;
#pragma unroll
    for (int k = 0; k < 4; ++k) { const size_t row = (size_t)(rowb + k);
        qw[k] = lat ? *((const u32x2*)(Zq + row * 256) + lane) : (u32x2){0u, 0u};
        cv[k] = lane < 32 ? *((const f32x4*)(Z1f + row * 256) + lane) : (f32x4){0.f, 0.f, 0.f, 0.f};
        x1[k] = Z1f[row * 256 + 128 + 16 * pa + pf]; x2[k] = Z1f[row * 256 + 128 + 16 * pa + 8 + pf]; }
    const f32x4 gq = *((const f32x4*)F.in[I_QNORM] + lane);
    const f32x4 gk = lane < 32 ? *((const f32x4*)F.in[I_KVNORM] + lane) : (f32x4){0.f, 0.f, 0.f, 0.f};
#pragma unroll
    for (int k = 0; k < 4; ++k) { const int row = rowb + k;
        if (lat) {
            const float a = bflo(qw[k].x), b = bfhi(qw[k].x), c = bflo(qw[k].y), d = bfhi(qw[k].y);
            const float rstd = 1.0f / sqrtf(wave_sum((a * a + b * b) + (c * c + d * d)) * (1.f / 256.f) + EPS);
            u32x2 o; o.x = cvt_pk_bf16(a * rstd * gq.x, b * rstd * gq.y); o.y = cvt_pk_bf16(c * rstd * gq.z, d * rstd * gq.w);
            *((u32x2*)((bf16*)(F.ws + WS_QN) + (size_t)(row - CTX) * 256) + lane) = o; }
        {
            const f32x4 v = cv[k];
            const float rstd = 1.0f / sqrtf(wave_sum((v.x * v.x + v.y * v.y) + (v.z * v.z + v.w * v.w)) * (1.f / 128.f) + EPS);
            u32x2 o; o.x = cvt_pk_bf16(v.x * rstd * gk.x, v.y * rstd * gk.y); o.y = cvt_pk_bf16(v.z * rstd * gk.z, v.w * rstd * gk.w);
            *((u32x2*)((bf16*)(F.ws + WS_KVN) + (size_t)row * 256) + lane) = o; }
        if (lane < 16) {
            float o1 = x1[k], o2 = x2[k];
            if (lat) { const int t = row - CTX, pos = pa ? (t & 63) : (t >> 6); const f32x2 cs = ((const f32x2*)(F.ws + WS_ROPE))[pos * 8 + pf];
                o1 = x1[k] * cs.x - x2[k] * cs.y; o2 = x2[k] * cs.x + x1[k] * cs.y; }
            const unsigned pk = cvt_pk_bf16(o1, o2);
#pragma unroll
            for (int h = 0; h < 8; ++h) *(unsigned*)(KV + (size_t)row * KVP + h * KVH + 64 + 2 * pi) = pk; } }
}

template <int DIR>
__device__ __forceinline__ void gla_prep_qk(Frame& F, int cn, int h, LAS float* gal) {
    const int lane = lane_id_opaque(), c = h * 64 + lane;
    const float* wa = F.in[DIR ? I_WAB : I_WAF]; const float bb = F.in[DIR ? I_BAB : I_BAF][c];
    const int row0 = cn * 64;
    {
        const float* gp = (const float*)(F.ws + WS_Z1F) + (size_t)(row0 + lane) * 256 + 160 + 16 * DIR;
#pragma unroll
        for (int q4 = 0; q4 < 4; ++q4) *(LAS f32x4*)(gal + lane * 16 + q4 * 4) = *(const f32x4*)(gp + q4 * 4);
    }
    float w[16];
#pragma unroll
    for (int r = 0; r < 16; ++r) w[r] = wa[r * 256 + c];
    LDS_WAIT(); asm volatile("" ::: "memory");
    const bf16* Zg = (const bf16*)(F.ws + WS_ZGQK);
    float Gs[64]; float G = 0.f;
#pragma unroll
    for (int s = 0; s < 64; ++s) { const int i = DIR ? 63 - s : s;
        float lg = bb;
#pragma unroll
        for (int q4 = 0; q4 < 4; ++q4) { const f32x4 g4 = *(const LAS f32x4*)(gal + i * 16 + q4 * 4);
            lg = fmaf(g4.x, w[4 * q4], lg); lg = fmaf(g4.y, w[4 * q4 + 1], lg); lg = fmaf(g4.z, w[4 * q4 + 2], lg); lg = fmaf(g4.w, w[4 * q4 + 3], lg); }
        const float la = (fminf(lg, 0.f) - __logf(1.0f + __expf(-fabsf(lg)))) * (1.0f / 16.0f);
        G += la; Gs[i] = G; }
    const float Glast = G, Gref = DIR ? Gs[32] : Gs[31];
    const size_t aidx = ((size_t)DIR * NCH + cn) * 256 + c;
    float* aux = (float*)(F.ws + WS_AUX);
    aux[aidx] = __expf(Glast); aux[AUX_N + aidx] = __expf(Glast - Gref); aux[2 * AUX_N + aidx] = __expf(Gref);
    bf16* Qt = (bf16*)(F.ws + WS_QT) + (size_t)DIR * ROWS * 256; bf16* Kt = (bf16*)(F.ws + WS_KT) + (size_t)DIR * ROWS * 256;
    bf16* KtT = (bf16*)(F.ws + WS_KTT) + (((size_t)DIR * NCH + cn) * 256 + c) * 64;
#pragma unroll
    for (int hf = 0; hf < 2; ++hf) { unsigned short qv[32], kv[32];
#pragma unroll
        for (int t = 0; t < 32; ++t) { const size_t ro = (size_t)(row0 + hf * 32 + t); qv[t] = Zg[ro * 512 + c]; kv[t] = Zg[ro * 512 + 256 + c]; }
#pragma unroll
        for (int g8 = 0; g8 < 4; ++g8) { float kt[8];
#pragma unroll
            for (int t = 0; t < 8; ++t) { const int i = hf * 32 + g8 * 8 + t; const size_t ro = (size_t)(row0 + i);
                const float qt = bf2f(qv[g8 * 8 + t]) * 0.125f * __expf(Gs[i] - Gref); kt[t] = bf2f(kv[g8 * 8 + t]) * __expf(Gref - Gs[i]);
                Qt[ro * 256 + c] = (bf16)f2bf(qt); Kt[ro * 256 + c] = (bf16)f2bf(kt[t]); }
            u32x4 o; o.x = cvt_pk_bf16(kt[0], kt[1]); o.y = cvt_pk_bf16(kt[2], kt[3]); o.z = cvt_pk_bf16(kt[4], kt[5]); o.w = cvt_pk_bf16(kt[6], kt[7]);
            *(u32x4*)(KtT + hf * 32 + g8 * 8) = o; } }
    LDS_WAIT(); asm volatile("" ::: "memory");
}
__device__ __forceinline__ void gla_prep_v(Frame& F, int cn, int grp) {
    const int col = grp * 64 + lane_id_opaque();
    const bf16* Zv = (const bf16*)(F.ws + WS_ZGV) + (size_t)cn * 64 * 512 + col;
    bf16* vT = (bf16*)(F.ws + WS_VT) + ((size_t)cn * 512 + col) * 64;
    unsigned short e[64];
#pragma unroll
    for (int t = 0; t < 64; ++t) e[t] = Zv[(size_t)t * 512];
#pragma unroll
    for (int g8 = 0; g8 < 8; ++g8) { u32x4 o; o.x = e[8 * g8 + 0] | ((unsigned)e[8 * g8 + 1] << 16); o.y = e[8 * g8 + 2] | ((unsigned)e[8 * g8 + 3] << 16);
        o.z = e[8 * g8 + 4] | ((unsigned)e[8 * g8 + 5] << 16); o.w = e[8 * g8 + 6] | ((unsigned)e[8 * g8 + 7] << 16);
        *(u32x4*)(vT + g8 * 8) = o; }
}

__device__ __forceinline__ void gla_pass_l(Frame& F, int task) {
    const int lane = lane_id_opaque(), r = lane & 31, hi = lane >> 5;
    const int cn = task % NCH, dh = task / NCH, h = dh & 3, dir = dh >> 2;
    const bf16* vTp = (const bf16*)(F.ws + WS_VT) + ((size_t)cn * 512 + h * 128) * 64;
    const bf16* kTp = (const bf16*)(F.ws + WS_KTT) + (((size_t)dir * NCH + cn) * 256 + h * 64) * 64;
    bf16* Lp = (bf16*)(F.ws + WS_LS) + (((size_t)(dir * 4 + h) * NCH + cn) * 128) * 64;
    bf16x8 bfr[2][4];
#pragma unroll
    for (int nt = 0; nt < 2; ++nt)
#pragma unroll
        for (int s = 0; s < 4; ++s) bfr[nt][s] = *(const bf16x8*)(kTp + (32 * nt + r) * 64 + 16 * s + 8 * hi);
#pragma unroll
    for (int mt = 0; mt < 4; ++mt) { bf16x8 afr[4]; bf16* pm = Lp + (4 * hi) * 64 + r + (32 * mt) * 64;
#pragma unroll
        for (int s = 0; s < 4; ++s) afr[s] = *(const bf16x8*)(vTp + (32 * mt + r) * 64 + 16 * s + 8 * hi);
#pragma unroll
        for (int nt = 0; nt < 2; ++nt) { f32x16 acc = {};
#pragma unroll
            for (int s = 0; s < 4; ++s) acc = __builtin_amdgcn_mfma_f32_32x32x16_bf16(afr[s], bfr[nt][s], acc, 0, 0, 0);
#pragma unroll
            for (int rg = 0; rg < 16; ++rg) pm[((rg & 3) + 8 * (rg >> 2)) * 64 + 32 * nt] = (bf16)f2bf(acc[rg]); } }
}

__device__ __forceinline__ void gla_pass_s(Frame& F) {
    const float* aux = (const float*)(F.ws + WS_AUX);
    for (int el = F.vcu * 256 + F.tid; F.tid < 256 && el < 65536; el += F.G * 256) {
        const int d = el & 63, e = (el >> 6) & 127, dh = el >> 13, h = dh & 3, dir = dh >> 2;
        bf16* Lp = (bf16*)(F.ws + WS_LS) + ((size_t)dh * NCH * 128 + e) * 64 + d;
        const float* ap = aux + (size_t)dir * NCH * 256 + h * 64 + d;
        float S = 0.f;
        for (int p0 = 0; p0 < NCH; p0 += 10) { float lv[10], dc[10], sc[10], er[10]; int cn[10];
#pragma unroll
            for (int u = 0; u < 10; ++u) { const int p = p0 + u; cn[u] = dir ? (p < 4 ? 3 - p : 263 - p) : p;
                lv[u] = bf2f(Lp[(size_t)cn[u] * 8192]); dc[u] = ap[cn[u] * 256]; sc[u] = ap[AUX_N + cn[u] * 256]; er[u] = ap[2 * AUX_N + cn[u] * 256]; }
#pragma unroll
            for (int u = 0; u < 10; ++u) { Lp[(size_t)cn[u] * 8192] = (bf16)f2bf(S * er[u]); S = dc[u] * S + sc[u] * lv[u]; } }
    }
}

template <int DIR, int IT>
__device__ __forceinline__ void gla_o_dir(Frame& F, f32x16 (&o)[4], int h, int cn, int r, int hi) {
    const size_t row0 = (size_t)cn * 64;
    const bf16* Qp = (const bf16*)(F.ws + WS_QT) + ((size_t)DIR * ROWS + row0) * 256 + h * 64;
    const bf16* Kp = (const bf16*)(F.ws + WS_KT) + ((size_t)DIR * ROWS + row0) * 256 + h * 64;
    const bf16* Sp = (const bf16*)(F.ws + WS_LS) + (((size_t)(DIR * 4 + h) * NCH + cn) * 128) * 64;
    const bf16* vTp = (const bf16*)(F.ws + WS_VT) + ((size_t)cn * 512 + h * 128) * 64;
    bf16x8 qf[4];
#pragma unroll
    for (int s = 0; s < 4; ++s) qf[s] = *(const bf16x8*)(Qp + (size_t)(32 * IT + r) * 256 + 16 * s + 8 * hi);
#pragma unroll
    for (int jt = 0; jt < 2; ++jt) {
        if (DIR == 0 ? (jt > IT) : (jt < IT)) continue;
        bf16x8 kf[4];
#pragma unroll
        for (int s = 0; s < 4; ++s) kf[s] = *(const bf16x8*)(Kp + (size_t)(32 * jt + r) * 256 + 16 * s + 8 * hi);
        f32x16 X = {};
#pragma unroll
        for (int s = 0; s < 4; ++s) X = __builtin_amdgcn_mfma_f32_32x32x16_bf16(kf[s], qf[s], X, 0, 0, 0);
        if (jt == IT) {
#pragma unroll
            for (int rg = 0; rg < 16; ++rg) { const int j = att::crow(rg, hi); const bool keep = DIR == 0 ? (j <= r) : (j >= r); X[rg] = keep ? X[rg] : 0.f; } }
        bf16x8 xa[2];
#pragma unroll
        for (int s2 = 0; s2 < 2; ++s2) { u32x4 w; w.x = cvt_pk_bf16(X[8 * s2 + 0], X[8 * s2 + 1]); w.y = cvt_pk_bf16(X[8 * s2 + 2], X[8 * s2 + 3]);
            w.z = cvt_pk_bf16(X[8 * s2 + 4], X[8 * s2 + 5]); w.w = cvt_pk_bf16(X[8 * s2 + 6], X[8 * s2 + 7]); xa[s2] = __builtin_bit_cast(bf16x8, w); }
#pragma unroll
        for (int nt = 0; nt < 4; ++nt)
#pragma unroll
            for (int s2 = 0; s2 < 2; ++s2) { const bf16* vp = vTp + (size_t)(32 * nt + r) * 64 + 32 * jt + 16 * s2 + 4 * hi;
                const u32x2 lo = *(const u32x2*)vp, hi8 = *(const u32x2*)(vp + 8);
                const u32x4 bw = {lo.x, lo.y, hi8.x, hi8.y};
                o[nt] = __builtin_amdgcn_mfma_f32_32x32x16_bf16(xa[s2], __builtin_bit_cast(bf16x8, bw), o[nt], 0, 0, 0); }
    }
#pragma unroll
    for (int nt = 0; nt < 4; ++nt)
#pragma unroll
        for (int s = 0; s < 4; ++s) { const bf16x8 sf = *(const bf16x8*)(Sp + (size_t)(32 * nt + r) * 64 + 16 * s + 8 * hi);
            o[nt] = __builtin_amdgcn_mfma_f32_32x32x16_bf16(qf[s], sf, o[nt], 0, 0, 0); }
}
template <int IT>
__device__ __forceinline__ void gla_pass_o(Frame& F, int h, int cn) {
    const int lane = lane_id_opaque(), r = lane & 31, hi = lane >> 5;
    f32x16 o[4];
#pragma unroll
    for (int nt = 0; nt < 4; ++nt) o[nt] = f32x16{};
    gla_o_dir<0, IT>(F, o, h, cn, r, hi);
    gla_o_dir<1, IT>(F, o, h, cn, r, hi);
    const bf16* Zgg = (const bf16*)(F.ws + WS_ZGG); bf16* mix = (bf16*)(F.ws + WS_MIX);
    float gn[4];
#pragma unroll
    for (int nt = 0; nt < 4; ++nt) gn[nt] = F.in[I_GNORM][32 * nt + r];
#pragma unroll
    for (int rg = 0; rg < 16; ++rg) {
        float ss = 0.f;
#pragma unroll
        for (int nt = 0; nt < 4; ++nt) ss += o[nt][rg] * o[nt][rg];
        ss = half_sum(ss);
        const float rstd = 1.0f / sqrtf(ss * (1.f / 128.f) + EPS);
        const int i = 32 * IT + att::crow(rg, hi); const size_t row = (size_t)cn * 64 + i;
#pragma unroll
        for (int nt = 0; nt < 4; ++nt) { const int e = 32 * nt + r; const float gg = bf2f(Zgg[row * 512 + h * 128 + e]);
            const float val = o[nt][rg] * rstd * gn[nt] * (gg / (1.0f + expf(-gg)));
            mix[(row - CTX) * DM + 512 + h * 128 + e] = (bf16)f2bf(val); } }
}

#ifndef PHM
#define PHM 0xFFFF
#endif
#define PH(k) ((PHM >> (k)) & 1)
struct Args { const float* in[23]; float* out; unsigned char* ws; };
__global__ void __launch_bounds__(NWAVES * 64, 2) fwd_megakernel(Args args) {
    extern __shared__ __attribute__((aligned(16))) unsigned char lds[];
    Frame F;
    F.lds = (LAS unsigned char*)lds;
    F.MISC = (volatile LAS unsigned*)(F.lds + MISC_OFF);
    F.wave = __builtin_amdgcn_readfirstlane((int)threadIdx.x >> 6); F.lane = lane_id_opaque(); F.tid = F.wave * 64 + F.lane;
    F.G = gridDim.x; { const int bx = blockIdx.x; F.vcu = (F.G % 8 == 0) ? (bx % 8) * (F.G / 8) + bx / 8 : bx; }
#pragma unroll
    for (int i = 0; i < 23; ++i) F.in[i] = args.in[i];
    F.out = args.out; F.ws = args.ws;
    for (int u = F.tid; u < (LDS_BYTES - LDSCTL_OFF) / 4; u += NWAVES * 64) ((LAS unsigned*)(F.lds + LDSCTL_OFF))[u] = 0u;
    __syncthreads();
    XcdBarrier bar = xcd_barrier_post((unsigned*)(F.ws + WS_CTL), F.MISC + 8, F.tid);
unsigned bseq = 0;
#ifdef TIMEPH
#define TSTAMP(k) do { if (blockIdx.x == 0 && F.tid == 0) ((unsigned long long*)(F.ws + WS_CTL + 32768))[k] = __builtin_amdgcn_s_memrealtime(); } while (0)
#else
#define TSTAMP(k) do { } while (0)
#endif
#define GRID_BAR() do { ++bseq; { const int l_ = lane_id_opaque(); xcd_barrier(bar, bseq, F.wave * 64 + l_); } F.lane = lane_id_opaque(); F.tid = F.wave * 64 + F.lane; TSTAMP(bseq); } while (0)
    const int gw = F.vcu * NWAVES + F.wave, NGW = F.G * NWAVES;
    const float* modl = (const float*)(F.ws + WS_MOD); const float* modc = modl + NMODV;
    bf16* hA = (bf16*)(F.ws + WS_A); float* Y = (float*)(F.ws + WS_Y);
    const float* npre = F.in[I_NPRE]; const float* npost = F.in[I_NPOST];
    LAS unsigned char* ring = F.lds + RING_OFF;

    TSTAMP(0);
    if (PH(0)) p0_prologue(F);
    GRID_BAR();
    if (PH(1)) for (int row0 = gw; row0 < ROWS; row0 += 2 * NGW) { NormArgs na[2]; int nv = 0;
#pragma unroll
        for (int k = 0; k < 2; ++k) { const int row = row0 + k * NGW; if (row < ROWS) { nv = k + 1; const bool isc = row < CTX; const float* md = isc ? modc : modl;
            na[k] = NormArgs{isc ? F.in[I_CTX] + (size_t)row * DM : F.in[I_X] + (size_t)(row - CTX) * DM, nullptr, nullptr, hA + (size_t)row * DM, nullptr, md, md + DM, 1}; } else na[k] = na[0]; }
        norm_rows<2>(lane_id_opaque(), na, nv, 0.f, nullptr, npre, 0); }
    GRID_BAR();
    if (PH(2)) { unsigned* ccnt = (unsigned*)(F.ws + WS_CTL + CTL_CTXCNT);
      { const int cj = (int)blockIdx.x - (F.G >> 1);
        if (cj >= 0 && cj < 22) { pg8::Gemm g0{hA, (const bf16*)(F.ws + WS_W1IN), CTX, 2 * DFF, DM, DM, DM}; pg8::OneUnit S0{true, cj};
          pg8::EpiSwiGLU E0{(bf16*)(F.ws + WS_ACT), DFF, ccnt};
          pg8::gemm_phase<pg8::EpiSwiGLU, false, pg8::OneUnit>(ring, g0, S0, E0, F.wave); } }
      { pg8::Gemm g{hA + (size_t)CTX * DM, (const bf16*)(F.ws + WS_W1IN), SEQ, 2 * DFF, DM, DM, DM}; pg8::StaticOrder S; S.init(SEQ, 2 * DFF, F.G, (int)blockIdx.x);
        pg8::EpiSwiGLU E{(bf16*)(F.ws + WS_ACT) + (size_t)CTX * DFF, DFF, nullptr};
        pg8::gemm_phase<pg8::EpiSwiGLU, true>(ring, g, S, E, F.wave); }
      for (int j = F.G - 1 - (int)blockIdx.x; j < 4 * NSPLIT; j += F.G) { const int pn = j & 3, sp = j >> 2;
          if (F.wave == 0) { unsigned sp_ = 0; while (xb_ld(ccnt) < 22u * 8u) { __builtin_amdgcn_s_sleep(2); if (++sp_ > XB_SPIN_CAP) break; }
              __builtin_amdgcn_fence(__ATOMIC_ACQUIRE, "agent"); asm volatile("s_waitcnt vmcnt(0)" ::: "memory"); }
          __syncthreads();
          pg8::Gemm g2{(const bf16*)(F.ws + WS_ACT) + sp * 256, (const bf16*)(F.ws + WS_W1OUT) + sp * 256, 256, DM, 256, DFF, DFF}; pg8::OneUnit S2{true, pn};
          pg8::EpiF32 E2{(float*)(F.ws + WS_SLAB) + (size_t)sp * 256 * DM, DM};
          pg8::gemm_phase<pg8::EpiF32, false, pg8::OneUnit>(ring, g2, S2, E2, F.wave); } }
    GRID_BAR();
    if (PH(3)) { pg8::Gemm g{(const bf16*)(F.ws + WS_ACT) + (size_t)CTX * DFF, (const bf16*)(F.ws + WS_W1OUT), SEQ, DM, DFF, DFF, DFF}; pg8::StaticOrder S; S.init(SEQ, DM, F.G, (int)blockIdx.x);
      pg8::EpiF32 E{Y + (size_t)CTX * DM, DM};
      pg8::gemm_phase<pg8::EpiF32, true>(ring, g, S, E, F.wave); }
    GRID_BAR();
    if (PH(4)) for (int row0 = gw; row0 < ROWS; row0 += 2 * NGW) { NormArgs na[2]; int nv = 0;
#pragma unroll
        for (int k = 0; k < 2; ++k) { const int row = row0 + k * NGW; if (row < ROWS) { nv = k + 1; const bool isc = row < CTX; const float* md = isc ? modc : modl;
            na[k] = NormArgs{isc ? F.in[I_CTX] + (size_t)row * DM : F.in[I_X] + (size_t)(row - CTX) * DM, isc ? (const float*)(F.ws + WS_SLAB) + (size_t)row * DM : Y + (size_t)row * DM,
                             isc ? nullptr : F.out + (size_t)(row - CTX) * DM, hA + (size_t)row * DM, md + 2 * DM, md + 3 * DM, md + 4 * DM, isc ? NSPLIT : 1}; } else na[k] = na[0]; }
        norm_rows<2>(lane_id_opaque(), na, nv, 0.5f, npost, npre + DM, (size_t)256 * DM); }
    GRID_BAR();
#if defined(STOPAT) && STOPAT == 4
    return;
#endif
    if (PH(5)) { pg8::Gemm g{hA, (const bf16*)(F.ws + WS_WIN), ROWS, 2048, DM, DM, DM}; pg8::StaticOrder S; S.init(ROWS, 2048, F.G, (int)blockIdx.x);
      pg8::EpiZ E{(bf16*)(F.ws + WS_ZQ), (bf16*)(F.ws + WS_ZGQK), (bf16*)(F.ws + WS_ZGV), (bf16*)(F.ws + WS_ZGG), (float*)(F.ws + WS_Z1F)};
      pg8::gemm_phase<pg8::EpiZ, true>(ring, g, S, E, F.wave); }
    GRID_BAR();
    if (PH(6)) for (int rb = gw * 4; rb < ROWS; rb += NGW * 4) mixer_rows4(F, rb);
    if (PH(6)) { LAS float* gal = (LAS float*)(ring + F.wave * 4096);
        for (int t = gw; t < 16 * NCH; t += NGW) { const int cn = t % NCH, sub = t / NCH;
            if (sub < 4) gla_prep_qk<0>(F, cn, sub, gal); else if (sub < 8) gla_prep_qk<1>(F, cn, sub - 4, gal); else gla_prep_v(F, cn, sub - 8); } }
    GRID_BAR();
    if (PH(7)) { pg8::Gemm g{(const bf16*)(F.ws + WS_QN), (const bf16*)(F.ws + WS_WQB), SEQ, QP, 256, 256, 256}; pg8::StaticOrder S; S.init(SEQ, QP, F.G, (int)blockIdx.x);
      pg8::EpiQ E{(bf16*)(F.ws + WS_Q), ATT_QSCALE};
      pg8::gemm_phase<pg8::EpiQ, true>(ring, g, S, E, F.wave); }
    if (PH(7)) { pg8::Gemm g{(const bf16*)(F.ws + WS_KVN), (const bf16*)(F.ws + WS_WKVB), ROWS, 1024, 256, 256, 256}; pg8::StaticOrder S; S.init(ROWS, 1024, F.G, (int)((blockIdx.x + 64) % F.G));
      pg8::EpiKV E{(bf16*)(F.ws + WS_KV)};
      pg8::gemm_phase<pg8::EpiKV, true>(ring, g, S, E, F.wave); }
    if (PH(8)) for (int t = gw; t < 8 * NCH; t += NGW) gla_pass_l(F, t);
    GRID_BAR();
#if defined(STOPAT) && STOPAT == 6
    { const bf16* Qp = (const bf16*)(F.ws + WS_Q); const bf16* KVp = (const bf16*)(F.ws + WS_KV);
      for (size_t i = (size_t)blockIdx.x * 512 + F.tid; i < (size_t)SEQ * DM; i += (size_t)F.G * 512) { const size_t t = i >> 10; const int c = (int)(i & 1023);
        F.out[i] = c < 768 ? bf2f(Qp[t * QP + c]) : bf2f(KVp[(t + CTX) * KVP + (c - 768)]) + bf2f(KVp[(t + CTX) * KVP + 256 + (c - 768)]) + bf2f(KVp[t * KVP + 1024 + (c - 768)]); } }
    return;
#endif
#if defined(STOPAT) && STOPAT == 7
    { const bf16* Qt = (const bf16*)(F.ws + WS_QT); const bf16* Kt = (const bf16*)(F.ws + WS_KT); const bf16* KtT = (const bf16*)(F.ws + WS_KTT); const bf16* vT = (const bf16*)(F.ws + WS_VT);
      const bf16* LS = (const bf16*)(F.ws + WS_LS); const float* aux = (const float*)(F.ws + WS_AUX);
      for (size_t i = (size_t)blockIdx.x * 512 + F.tid; i < (size_t)SEQ * DM; i += (size_t)F.G * 512) { const size_t t = i >> 10; const int c = (int)(i & 1023);
        float v;
        if (c < 256) v = bf2f(Qt[t * 256 + c]) + bf2f(Qt[((size_t)ROWS + t) * 256 + c]);
        else if (c < 512) v = bf2f(Kt[t * 256 + c - 256]) + bf2f(Kt[((size_t)ROWS + t) * 256 + c - 256]);
        else if (c < 768) v = bf2f(KtT[i]) + bf2f(vT[i >> 1]);
        else v = bf2f(LS[i]) + bf2f(LS[i + (size_t)SEQ * DM]) + aux[i % (3 * AUX_N)];
        F.out[i] = v; } }
    return;
#endif
    if (PH(9)) gla_pass_s(F);
    TSTAMP(20);
#if ATT_V2
    if (PH(10)) for (int u = F.vcu; u < 512; u += F.G) {
        const int h = (u & 255) >> 5, qb = (u & 31) + 32 * (u >> 8);
        att2::attn_unit<8>(h, qb * 256, (const bf16*)(F.ws + WS_Q), (const bf16*)(F.ws + WS_KV), (bf16*)(F.ws + WS_MIX), (char*)lds + RING_OFF, (const f32x2*)(F.ws + WS_ROPE), F.wave);
    }
#else
    if (PH(10)) for (int u = F.vcu; u < 512; u += F.G) {
        const int h = (u & 255) >> 5, qb = (u & 31) + 32 * (u >> 8);
        att::attn_unit((const bf16*)(F.ws + WS_Q) + (size_t)qb * 256 * QP + h * QH, (const bf16*)(F.ws + WS_KV) + h * KVH,
                       (bf16*)(F.ws + WS_MIX) + (size_t)qb * 256 * DM + h * 64, ROWS, (LAS char*)ring, qb * 256, (const f32x2*)(F.ws + WS_ROPE), F.wave);
    }
#endif
    GRID_BAR();
#if defined(STOPAT) && STOPAT == 9
    { const bf16* LS = (const bf16*)(F.ws + WS_LS);
      for (size_t i = (size_t)blockIdx.x * 512 + F.tid; i < (size_t)SEQ * DM; i += (size_t)F.G * 512) F.out[i] = bf2f(LS[i]); }
    return;
#endif
    if (PH(11)) for (int t = gw; t < 8 * (NCH - 4); t += NGW) { const int h = (t >> 1) & 3, cn = 4 + (t >> 3); if (t & 1) gla_pass_o<1>(F, h, cn); else gla_pass_o<0>(F, h, cn); }
    GRID_BAR();
#if defined(STOPAT) && STOPAT == 8
    { const bf16* mixp = (const bf16*)(F.ws + WS_MIX);
      for (size_t i = (size_t)blockIdx.x * 512 + F.tid; i < (size_t)SEQ * DM; i += (size_t)F.G * 512) F.out[i] = bf2f(mixp[i]); }
    return;
#endif
    if (PH(12)) { pg8::Gemm g{(const bf16*)(F.ws + WS_MIX), (const bf16*)(F.ws + WS_WOUT), SEQ, DM, DM, DM, DM}; pg8::StaticOrder S; S.init(SEQ, DM, F.G, (int)blockIdx.x);
      pg8::EpiF32 E{Y, DM};
      pg8::gemm_phase<pg8::EpiF32, true>(ring, g, S, E, F.wave); }
    GRID_BAR();
    if (PH(13)) for (int row0 = gw; row0 < SEQ; row0 += 2 * NGW) { NormArgs na[2];
#pragma unroll
        for (int k = 0; k < 2; ++k) { const int row = row0 + k * NGW; float* hr = F.out + (size_t)row * DM;
            na[k] = NormArgs{hr, Y + (size_t)row * DM, hr, hA + (size_t)row * DM, modl + 5 * DM, modl + 6 * DM, modl + 7 * DM, 1}; }
        norm_rows<2>(lane_id_opaque(), na, 2, 1.0f, npost + DM, npre + 2 * DM, 0); }
    GRID_BAR();
    if (PH(14)) { pg8::Gemm g{hA, (const bf16*)(F.ws + WS_W2IN), SEQ, 2 * DFF, DM, DM, DM}; pg8::StaticOrder S; S.init(SEQ, 2 * DFF, F.G, (int)blockIdx.x);
      pg8::EpiSwiGLU E{(bf16*)(F.ws + WS_ACT), DFF, nullptr};
      pg8::gemm_phase<pg8::EpiSwiGLU, true>(ring, g, S, E, F.wave); }
    GRID_BAR();
#ifdef DIAG
    GRID_BAR();
    for (int row = gw; row < SEQ; row += NGW) { float* hr = F.out + (size_t)row * DM;
        for (int j = 0; j < 4; ++j) *((f32x4*)hr + F.lane + 64 * j) = (f32x4){0.f, 0.f, 0.f, 0.f}; }
    GRID_BAR();
    if (blockIdx.x == 0 && F.tid == 0) { unsigned* bw = (unsigned*)(F.ws + WS_CTL);
        const unsigned code = xb_ld(&bw[XB_CODE]), tmo = xb_ld(&bw[XB_TMO]);
        unsigned val = DIAG == 0 ? code : DIAG == 1 ? tmo : DIAG == 2 ? (unsigned)F.G : DIAG == 3 ? F.MISC[8] : F.MISC[9];
        F.out[(size_t)(gw) * DM] = 1.0e6f * (float)(val + 1u); }
    return;
#endif
    if (PH(15)) { pg8::Gemm g{(const bf16*)(F.ws + WS_ACT), (const bf16*)(F.ws + WS_W2OUT), SEQ, DM, DFF, DFF, DFF}; pg8::StaticOrder S; S.init(SEQ, DM, F.G, (int)blockIdx.x);
      pg8::EpiF32 E{Y, DM};
      pg8::gemm_phase<pg8::EpiF32, true>(ring, g, S, E, F.wave); }
    GRID_BAR();
    for (int row0 = gw; row0 < SEQ; row0 += 2 * NGW) { NormArgs na[2];
#pragma unroll
        for (int k = 0; k < 2; ++k) { const int row = row0 + k * NGW; float* hr = F.out + (size_t)row * DM;
            na[k] = NormArgs{hr, Y + (size_t)row * DM, hr, nullptr, modl + 8 * DM, nullptr, nullptr, 1}; }
        norm_rows<2>(lane_id_opaque(), na, 2, 0.5f, npost + 2 * DM, nullptr, 0); }
#ifdef TIMEPH
    TSTAMP(15);
    GRID_BAR();
    if (blockIdx.x == 0) { volatile unsigned long long* ts = (volatile unsigned long long*)(F.ws + WS_CTL + 32768);
        const unsigned long long d = TIMEPH < 0 ? 10000ull : ts[TIMEPH_B] - ts[TIMEPH];
        long n = (long)((double)d * 0.01 * TIMEPH_K); if (n > 330000) n = 330000;
        for (long i = F.tid; i < n; i += 512) F.out[i] += 0.05f; }
#endif
}

extern "C" void kernel_launch(void* const* d_in, const int* in_sizes, int n_in, void* d_out, int out_size, void* d_ws, size_t ws_size, hipStream_t stream) {
    static int grid = 0;
    if (grid == 0) {
        if (n_in != 23 || in_sizes[0] != SEQ * DM || out_size != SEQ * DM || ws_size < WS_END) {
            fprintf(stderr, "kernel_launch: unexpected shapes: n_in %d in0 %d out %d ws %zu\n", n_in, n_in > 0 ? in_sizes[0] : -1, out_size, ws_size); grid = -1; return; }
        int dev = 0, cus = 0, per_cu = 0;
        if (hipGetDevice(&dev) != hipSuccess || hipDeviceGetAttribute(&cus, hipDeviceAttributeMultiprocessorCount, dev) != hipSuccess) { fprintf(stderr, "kernel_launch: device query failed\n"); grid = -1; return; }
        if (hipFuncSetAttribute((const void*)fwd_megakernel, hipFuncAttributeMaxDynamicSharedMemorySize, LDS_BYTES) != hipSuccess) { fprintf(stderr, "kernel_launch: hipFuncSetAttribute failed\n"); grid = -1; return; }
        if (hipOccupancyMaxActiveBlocksPerMultiprocessor(&per_cu, (const void*)fwd_megakernel, NWAVES * 64, LDS_BYTES) != hipSuccess || per_cu < 1) {
            fprintf(stderr, "kernel_launch: occupancy query reports %d workgroups per CU\n", per_cu); (void)hipGetLastError(); grid = -1; return; }
        grid = cus;
    }
    if (grid < 0) return;
    if (hipMemsetAsync((char*)d_ws + WS_CTL, 0, CTL_ZERO_BYTES, stream) != hipSuccess) { fprintf(stderr, "kernel_launch: memset failed\n"); return; }
    Args a{};
    for (int i = 0; i < 23; ++i) a.in[i] = (const float*)d_in[i];
    a.out = (float*)d_out; a.ws = (unsigned char*)d_ws;
    hipLaunchKernelGGL(fwd_megakernel, dim3(grid), dim3(NWAVES * 64), LDS_BYTES, stream, a);
    const hipError_t le = hipPeekAtLastError();
    if (le != hipSuccess) fprintf(stderr, "kernel_launch: launch failed: %s\n", hipGetErrorName(le));
}
```
